# Optimizing an MI355X kernel written in HIP

```python
import jax, jax.numpy as jnp
from jax import lax
import numpy as np

D_MODEL = 1024
BATCH = 16
SEQ = 256
DEPTH = 1
DEC_BATCH = 2
DEC_SEQ = 2048
PAST_LEN = 256

GRID_W = 64
MLA_HEADS = 8
Q_LORA = 384
KV_LORA = 256
QK_NOPE = 64
QK_ROPE = 32
V_DIM = 64
QK_SCALE = (QK_NOPE + QK_ROPE) ** -0.5
QBLK = 128
ROPE_BASE = 10000.0
HG_HEADS = 8
HG_DK = 64
HG_DV = 64
CHUNK = 16
D_FF = 2816
EPS = 1e-6
N_MOD = 9
MLA_W = MLA_HEADS * V_DIM
HG_KW = HG_HEADS * HG_DK
HG_W = HG_HEADS * HG_DV
IN_SPLITS = (Q_LORA, KV_LORA, QK_ROPE, HG_KW, HG_KW, HG_KW, HG_W, HG_W, D_MODEL, D_MODEL)
D_IN = Q_LORA + KV_LORA + QK_ROPE + 3 * HG_KW + 2 * HG_W + 2 * D_MODEL

kernel_name = "hybrid_mla_hgrn2_prefix_dit_step"


def rmsnorm(x, g):
    xf = x.astype(jnp.float32)
    xf = xf * lax.rsqrt(jnp.mean(xf * xf, axis=-1, keepdims=True) + EPS)
    return (xf * g.astype(jnp.float32)).astype(x.dtype)


def modulate(x, g, shift, scale):
    return rmsnorm(x, g) * (1.0 + scale) + shift


def swiglu(h, w1, w3, w2):
    return (jax.nn.silu(h @ w1) * (h @ w3)) @ w2


def axial_rope(x):
    T = x.shape[1]
    rows = T // GRID_W
    row = jnp.repeat(jnp.arange(rows), GRID_W).astype(jnp.float32)
    col = jnp.tile(jnp.arange(GRID_W), rows).astype(jnp.float32)
    half = QK_ROPE // 2
    quarter = half // 2
    inv = ROPE_BASE ** (-jnp.arange(quarter, dtype=jnp.float32) / quarter)
    shape = (1, T) + (1,) * (x.ndim - 3) + (quarter,)

    def rot(xa, pos):
        ang = pos[:, None] * inv
        c = jnp.cos(ang).reshape(shape).astype(x.dtype)
        s = jnp.sin(ang).reshape(shape).astype(x.dtype)
        x1, x2 = xa[..., :quarter], xa[..., quarter:]
        return jnp.concatenate([x1 * c - x2 * s, x2 * c + x1 * s], axis=-1)

    return jnp.concatenate([rot(x[..., :half], row), rot(x[..., half:], col)], axis=-1)


def mla_attention(q_nope, q_rope, k_nope, k_rope, v):
    B, Tq = q_nope.shape[:2]
    nb = Tq // QBLK

    def block(qs):
        qn, qr = qs
        s = jnp.einsum('bqhd,bkhd->bhqk', qn, k_nope) + jnp.einsum('bqhr,bkr->bhqk', qr, k_rope)
        p = jax.nn.softmax(s.astype(jnp.float32) * QK_SCALE, axis=-1).astype(v.dtype)
        return jnp.einsum('bhqk,bkhd->bqhd', p, v)

    qn = q_nope.reshape(B, nb, QBLK, MLA_HEADS, QK_NOPE).transpose(1, 0, 2, 3, 4)
    qr = q_rope.reshape(B, nb, QBLK, MLA_HEADS, QK_ROPE).transpose(1, 0, 2, 3, 4)
    o = lax.map(block, (qn, qr))
    return o.transpose(1, 0, 2, 3, 4).reshape(B, Tq, MLA_HEADS * V_DIM)


def hgrn2_chunked(q, k, logf, v, s0):
    B, T, H, DK = q.shape
    DV = v.shape[-1]
    n = T // CHUNK
    qc = q.reshape(B, n, CHUNK, H, DK)
    kc = k.reshape(B, n, CHUNK, H, DK)
    vc = v.reshape(B, n, CHUNK, H, DV)
    b = jnp.cumsum(logf.reshape(B, n, CHUNK, H, DK), axis=2)
    mask = jnp.tril(jnp.ones((CHUNK, CHUNK), dtype=bool))[:, :, None, None]
    diff = b[:, :, :, None] - b[:, :, None, :]
    decay = jnp.where(mask, jnp.exp(jnp.where(mask, diff, 0.0)), 0.0)
    A = jnp.einsum('bntshk,bnthk,bnshk->bnhts', decay, qc, kc)
    o_intra = jnp.einsum('bnhts,bnshv->bnthv', A, vc)
    g = b[:, :, -1]
    dS = jnp.einsum('bnshk,bnshv->bnhkv', kc * jnp.exp(g[:, :, None] - b), vc)

    def step(S, inp):
        gj, dSj = inp
        return jnp.exp(gj)[..., None] * S + dSj, S

    s_final, S_prev = lax.scan(step, s0.astype(jnp.float32),
                               (g.transpose(1, 0, 2, 3), dS.transpose(1, 0, 2, 3, 4)))
    S_prev = S_prev.transpose(1, 0, 2, 3, 4)
    o_inter = jnp.einsum('bnthk,bnhkv->bnthv', qc * jnp.exp(b), S_prev)
    return (o_intra + o_inter).reshape(B, T, H, DV), s_final


def token_mixer(h, cache, lb, w_in, q_norm_g, w_qb, kv_norm_g, w_kvb, w_up_attn, hg_norm_g, w_up_rec, w_out):
    B, T, _ = h.shape
    f32 = jnp.float32
    split_idx = [int(i) for i in np.cumsum(IN_SPLITS)[:-1]]
    qc, kvc, kr, hq, hf_f, hf_b, hi, hgate, ga, gr = jnp.split(h @ w_in, split_idx, axis=-1)

    q = (rmsnorm(qc, q_norm_g) @ w_qb).reshape(B, T, MLA_HEADS, QK_NOPE + QK_ROPE)
    q_nope, q_rope = q[..., :QK_NOPE], q[..., QK_NOPE:]
    ckv = rmsnorm(kvc, kv_norm_g)
    if cache is None:
        ckv_all, kr_all = ckv, kr
        s0 = jnp.zeros((B, 2, HG_HEADS, HG_DK, HG_DV), f32)
    else:
        cache_ckv, cache_kr, cache_state = cache
        q_rope = axial_rope(q_rope)
        ckv_all = jnp.concatenate([cache_ckv, ckv], axis=1)
        kr_all = jnp.concatenate([cache_kr, axial_rope(kr)], axis=1)
        s0 = cache_state.astype(f32)
    kv = (ckv_all @ w_kvb).reshape(B, ckv_all.shape[1], MLA_HEADS, QK_NOPE + V_DIM)
    o_attn = mla_attention(q_nope, q_rope, kv[..., :QK_NOPE], kr_all, kv[..., QK_NOPE:])

    heads = lambda t, d: t.reshape(B, T, HG_HEADS, d).astype(f32)
    flip = lambda t: jnp.flip(t, axis=1)
    q_h = jax.nn.silu(heads(hq, HG_DK))
    v_h = heads(hi, HG_DV)
    lb_h = lb.reshape(2, HG_HEADS, HG_DK)
    f_fw = lb_h[0] + (1.0 - lb_h[0]) * jax.nn.sigmoid(heads(hf_f, HG_DK))
    f_bw = lb_h[1] + (1.0 - lb_h[1]) * jax.nn.sigmoid(heads(hf_b, HG_DK))
    o_fw, s_fw = hgrn2_chunked(q_h, 1.0 - f_fw, jnp.log(f_fw), v_h, s0[:, 0])
    o_bw, s_bw = hgrn2_chunked(flip(q_h), flip(1.0 - f_bw), flip(jnp.log(f_bw)), flip(v_h), s0[:, 1])
    o_rec = rmsnorm(o_fw + flip(o_bw), hg_norm_g) * jax.nn.silu(heads(hgate, HG_DV))
    o_rec = o_rec.reshape(B, T, HG_W).astype(h.dtype)

    merged = jax.nn.sigmoid(ga) * (o_attn @ w_up_attn) + jax.nn.sigmoid(gr) * (o_rec @ w_up_rec)
    out = merged @ w_out
    if cache is None:
        return out, (ckv, kr, jnp.stack([s_fw, s_bw], axis=1).astype(h.dtype))
    return out, None


def trunk_layer(x, mod, cache, lb, norm_g, ffn1, ffn2, mixer_w):
    m = [mod[:, i][:, None, :] for i in range(N_MOD)]
    x = x + 0.5 * m[2] * swiglu(modulate(x, norm_g[0], m[0], m[1]), *ffn1)
    mix, ctx = token_mixer(modulate(x, norm_g[1], m[3], m[4]), cache, lb, *mixer_w)
    x = x + m[5] * mix
    x = x + 0.5 * m[8] * swiglu(modulate(x, norm_g[2], m[6], m[7]), *ffn2)
    return x, ctx


def setup_inputs(seed: int = 0) -> dict:
    key = jax.random.key(seed)
    ks = list(jax.random.split(key, 32))
    D = D_MODEL

    def nrm(shape, s=1.0):
        return s * jax.random.normal(ks.pop(), shape, jnp.float32)

    def gain(shape):
        return 1.0 + nrm(shape, 0.1)

    return {
        "x_prompt": nrm((BATCH, SEQ, D)),
        "x_sample": nrm((DEC_BATCH, DEC_SEQ, D)),
        "cache_ckv": nrm((DEC_BATCH, DEPTH, PAST_LEN, KV_LORA)),
        "cache_krope": nrm((DEC_BATCH, DEPTH, PAST_LEN, QK_ROPE)),
        "state_hgrn": nrm((DEC_BATCH, DEPTH, 2, HG_HEADS, HG_DK, HG_DV), 0.5),
        "c": nrm((DEC_BATCH, D)),
        "c_ctx": nrm((D,)),
        "w_ada": nrm((DEPTH, D, N_MOD * D), 0.5 * D ** -0.5),
        "b_ada": nrm((DEPTH, N_MOD * D), 0.01),
        "norm_g": gain((DEPTH, 3, D)),
        "ffn1_w1": nrm((DEPTH, D, D_FF), D ** -0.5),
        "ffn1_w3": nrm((DEPTH, D, D_FF), D ** -0.5),
        "ffn1_w2": nrm((DEPTH, D_FF, D), D_FF ** -0.5),
        "ffn2_w1": nrm((DEPTH, D, D_FF), D ** -0.5),
        "ffn2_w3": nrm((DEPTH, D, D_FF), D ** -0.5),
        "ffn2_w2": nrm((DEPTH, D_FF, D), D_FF ** -0.5),
        "w_in": nrm((DEPTH, D, D_IN), D ** -0.5),
        "q_norm_g": gain((DEPTH, Q_LORA)),
        "w_qb": nrm((DEPTH, Q_LORA, MLA_HEADS * (QK_NOPE + QK_ROPE)), Q_LORA ** -0.5),
        "kv_norm_g": gain((DEPTH, KV_LORA)),
        "w_kvb": nrm((DEPTH, KV_LORA, MLA_HEADS * (QK_NOPE + V_DIM)), KV_LORA ** -0.5),
        "w_up_attn": nrm((DEPTH, MLA_W, D), MLA_W ** -0.5),
        "hg_gamma": nrm((2, DEPTH + 1, HG_KW), 0.5),
        "hg_norm_g": gain((DEPTH, HG_DV)),
        "w_up_rec": nrm((DEPTH, HG_W, D), HG_W ** -0.5),
        "w_out": nrm((DEPTH, D, D), D ** -0.5),
        "final_g": gain((D,)),
    }


def reference(x_prompt, x_sample, cache_ckv, cache_krope, state_hgrn, c, c_ctx, w_ada, b_ada, norm_g,
              ffn1_w1, ffn1_w3, ffn1_w2, ffn2_w1, ffn2_w3, ffn2_w2, w_in, q_norm_g, w_qb, kv_norm_g, w_kvb,
              w_up_attn, hg_gamma, hg_norm_g, w_up_rec, w_out, final_g):
    lb_all = jnp.cumsum(jax.nn.softmax(hg_gamma.astype(jnp.float32), axis=1), axis=1)
    xp, xs = x_prompt, x_sample
    new_ckv, new_kr, new_st = [], [], []
    for l in range(DEPTH):
        mod_p = (jax.nn.silu(c_ctx) @ w_ada[l] + b_ada[l]).reshape(1, N_MOD, D_MODEL)
        mod_s = (jax.nn.silu(c) @ w_ada[l] + b_ada[l]).reshape(c.shape[0], N_MOD, D_MODEL)
        ffn1 = (ffn1_w1[l], ffn1_w3[l], ffn1_w2[l])
        ffn2 = (ffn2_w1[l], ffn2_w3[l], ffn2_w2[l])
        mixer_w = (w_in[l], q_norm_g[l], w_qb[l], kv_norm_g[l], w_kvb[l], w_up_attn[l],
                   hg_norm_g[l], w_up_rec[l], w_out[l])
        lb = lb_all[:, l]
        xp, (ckv, kr, st) = trunk_layer(xp, mod_p, None, lb, norm_g[l], ffn1, ffn2, mixer_w)
        new_ckv.append(ckv)
        new_kr.append(kr)
        new_st.append(st)
        xs, _ = trunk_layer(xs, mod_s, (cache_ckv[:, l], cache_krope[:, l], state_hgrn[:, l]), lb,
                            norm_g[l], ffn1, ffn2, mixer_w)
    y_prompt = rmsnorm(xp, final_g)
    y_sample = rmsnorm(xs, final_g)
    new_ckv_arr = jnp.stack(new_ckv, axis=1)
    new_kr_arr = jnp.stack(new_kr, axis=1)
    new_st_arr = jnp.stack(new_st, axis=1)
    return (y_prompt, y_sample, new_ckv_arr, new_kr_arr, new_st_arr)
```

```cpp
#include <hip/hip_runtime.h>
#include <hip/hip_cooperative_groups.h>
#include <cstdio>
#include <cstdint>
namespace cg = cooperative_groups;

#define LAS __attribute__((address_space(3)))
typedef unsigned short bf16_t;
typedef short bf16x8 __attribute__((ext_vector_type(8)));
typedef float f32x4 __attribute__((ext_vector_type(4)));
typedef float f32x2 __attribute__((ext_vector_type(2)));
typedef unsigned u32x4 __attribute__((ext_vector_type(4)));
typedef unsigned u32x2 __attribute__((ext_vector_type(2)));

constexpr int D = 1024, NTOK = 8192, NCTX = 4096, DFF = 2816;
constexpr int DIN = 5280, DIN_P = 5376;
constexpr float EPS = 1e-6f;
constexpr int NTHR = 512;
constexpr int LDS_BYTES = 147456;
constexpr int LDS_X = 131072;

constexpr size_t OY = 0, OCKV = 8388608, OKR = 9437184, OST = 9568256;

constexpr size_t MiB = 1u << 20;
constexpr size_t WS_MOD = 0;
constexpr size_t WS_LB = 512 * 1024;
constexpr size_t WS_RQ = 640 * 1024;
constexpr size_t WS_RKV = 704 * 1024;
constexpr size_t WS_BAR = 768 * 1024;
constexpr size_t WS_SLOC = 1 * MiB;
constexpr size_t WS_GDEC = 5 * MiB;
constexpr size_t WS_W1A = 6 * MiB;
constexpr size_t WS_W1B = 17 * MiB;
constexpr size_t WS_W2A = 23 * MiB;
constexpr size_t WS_W2B = 34 * MiB;
constexpr size_t WS_WIN = 40 * MiB;
constexpr size_t WS_WQB = 51 * MiB;
constexpr size_t WS_WKVB = 52 * MiB;
constexpr size_t WS_WUP = 53 * MiB;
constexpr size_t WS_WOUT = 55 * MiB;
constexpr size_t WS_XN = 57 * MiB;
constexpr size_t WS_OFW = 61 * MiB;
constexpr size_t WS_OBW = 153 * MiB;
constexpr size_t WS_SENT = 57 * MiB;
constexpr size_t WS_X = 73 * MiB;
constexpr size_t WS_PART = 105 * MiB;
constexpr size_t WS_HFF = 169 * MiB;
constexpr size_t WS_GATE = 105 * MiB;
constexpr size_t WS_O = 137 * MiB;
constexpr size_t WS_T = 169 * MiB;
constexpr size_t WS_QC = 153 * MiB;
constexpr size_t WS_KVC = 159 * MiB;
constexpr size_t WS_FF = 165 * MiB;
constexpr size_t WS_FB = 181 * MiB;
constexpr size_t WS_HQ = 197 * MiB;
constexpr size_t WS_HV = 205 * MiB;
constexpr size_t WS_HG = 213 * MiB;
constexpr size_t WS_Q = 221 * MiB;
constexpr size_t WS_KN = 233 * MiB;
constexpr size_t WS_VT = 242 * MiB;
constexpr size_t WS_KRP = 251 * MiB;
constexpr size_t WS_END = 252 * MiB;

typedef __bf16 nbf16x2 __attribute__((ext_vector_type(2)));
__device__ __forceinline__ unsigned pk2(float lo, float hi) { f32x2 v = {lo, hi}; return __builtin_bit_cast(unsigned, __builtin_convertvector(v, nbf16x2)); }
__device__ __forceinline__ float bflo(unsigned w) { return __uint_as_float(w << 16); }
__device__ __forceinline__ float bfhi(unsigned w) { return __uint_as_float(w & 0xffff0000u); }
__device__ __forceinline__ float sigmf(float x) { return __builtin_amdgcn_rcpf(1.f + __builtin_amdgcn_exp2f(-1.4426950408889634f * x)); }
__device__ __forceinline__ float siluf(float x) { return x * sigmf(x); }
__device__ __forceinline__ float wave_sum(float v) {
#pragma unroll
    for (int o = 1; o < 64; o <<= 1) v += __shfl_xor(v, o);
    return v;
}
__device__ __forceinline__ f32x4 rope4(f32x4 x, float pos, int fq) {
    f32x4 p, o;
#pragma unroll
    for (int j = 0; j < 4; ++j) p[j] = __shfl_xor(x[j], 32);
    const bool lo = fq < 2;
    const bool hi4 = (fq & 1) != 0;
    const float inv0 = hi4 ? 0.01f : 1.0f, inv1 = hi4 ? 0.0031622776601683794f : 0.31622776601683794f,
                inv2 = hi4 ? 0.001f : 0.1f, inv3 = hi4 ? 0.00031622776601683794f : 0.031622776601683794f;
    const float iv[4] = {inv0, inv1, inv2, inv3};
#pragma unroll
    for (int j = 0; j < 4; ++j) {
        float rev = pos * iv[j] * 0.15915494309189535f;
        rev -= rintf(rev);
        const float s = __builtin_amdgcn_sinf(rev), c = __builtin_amdgcn_cosf(rev);
        o[j] = lo ? (x[j] * c - p[j] * s) : (x[j] * c + p[j] * s);
    }
    return o;
}

namespace pg8 {
constexpr int BM = 256, BK = 64, HALF = 128, HTB = HALF * BK * 2, STAGE_BYTES = 8 * HTB, NXCD = 8, WGM = 8;
__device__ __forceinline__ int lds_byte(int r, int c) { const int st = (r >> 4) * 2 + (c >> 5), rr = r & 15, cc = c & 31, ob = rr * 64 + cc * 2; return st * 1024 + (ob ^ (((ob >> 9) & 1) << 5)); }
__device__ __forceinline__ void stage_rc(int b, int& R, int& C) { const int st = b / 1024, sb = b % 1024, swz = sb ^ (((sb >> 9) & 1) << 5); R = (st >> 1) * 16 + swz / 64; C = (st & 1) * 32 + (swz % 64) / 2; }

struct Unit { int pm, pn, z; };
struct Gemm { const bf16_t* A; const bf16_t* Bt; int lda, ldb, K; size_t zA, zB; };

__device__ __forceinline__ void order_unit(int L, int nM, int nN, Unit& u) {
    const int nwg = nM * nN;
    u.z = L / nwg; int wgid = L - u.z * nwg;
    { const int q = nwg / NXCD, r = nwg % NXCD, xcd = wgid % NXCD, off = wgid / NXCD; wgid = (xcd < r ? xcd * (q + 1) : r * (q + 1) + (xcd - r) * q) + off; }
    const int nig = WGM * nN, gid = wgid / nig, fm = gid * WGM, gsz = (nM - fm) < WGM ? (nM - fm) : WGM;
    u.pm = fm + ((wgid % nig) % gsz); u.pn = (wgid % nig) / gsz;
}
struct GridOrder {
    int nM, nN, nZ, G, c, zpm;
    __device__ __forceinline__ bool next(int i, Unit& u) const {
        const int L = i * G + c; if (L >= nM * nN * nZ) return false;
        order_unit(L, nM, nN, u); if (zpm > 0) u.z = u.pm >= zpm ? 1 : 0; return true;
    }
};
struct SingleOrder {
    Unit u0;
    __device__ __forceinline__ bool next(int i, Unit& u) const { if (i != 0) return false; u = u0; return true; }
};

template <class Epi, class Sched>
__device__ __forceinline__ void gemm_phase(LAS unsigned char* lds, const Gemm g, const Sched& S, const Epi& E) {
    const int tid = threadIdx.x, wid = __builtin_amdgcn_readfirstlane(tid >> 6), lane = tid & 63, wr = wid >> 2, wc = wid & 3, fr = lane & 15, fq = lane >> 4;
    int K_ = g.K; asm volatile("" : "+s"(K_));
    const int nt = K_ / BK;
    unsigned voffA[2], voffB[2];
#pragma unroll
    for (int i = 0; i < 2; ++i) { int R, C; stage_rc(tid * 16 + i * 8192, R, C);
        voffA[i] = (unsigned)(R * g.lda + C) * 2u; voffB[i] = (unsigned)(R * g.ldb + C) * 2u; }
    const size_t kstep = (size_t)(BK * 2);
    const size_t hstepA = (size_t)HALF * g.lda * 2, hstepB = (size_t)HALF * g.ldb * 2;
    const size_t tstepA = 2 * hstepA, tstepB = 2 * hstepB;
    const unsigned ldsw = (unsigned)wid * 1024u;
    const int aoff = lds_byte(wr * 64 + fr, fq * 8), boff = lds_byte(wc * 32 + fr, fq * 8);
#define PG8_SA(b, h) (((b) * 2 + (h)) * HTB)
#define PG8_SB(b, h) ((4 + (b) * 2 + (h)) * HTB)
#define PG8_STAGE(bufoff, gbase, voff) do { _Pragma("unroll") for (int _i = 0; _i < 2; ++_i) \
        __builtin_amdgcn_global_load_lds((const unsigned*)((const char*)(gbase) + (voff)[_i]), (LAS unsigned*)(lds + (bufoff) + ldsw + _i * 8192), 16, 0, 0); } while (0)
#define PG8_LDA(dst, b, h) do { _Pragma("unroll") for (int m = 0; m < 4; ++m) _Pragma("unroll") for (int k = 0; k < 2; ++k) dst[m][k] = *(const LAS bf16x8*)(lds + PG8_SA(b, h) + aoff + m * 2048 + k * 1024); } while (0)
#define PG8_LDB(dst, b, h) do { _Pragma("unroll") for (int n = 0; n < 2; ++n) _Pragma("unroll") for (int k = 0; k < 2; ++k) dst[n][k] = *(const LAS bf16x8*)(lds + PG8_SB(b, h) + boff + n * 2048 + k * 1024); } while (0)
#define PG8_MMA(ai, bj, At, Bt) do { __builtin_amdgcn_s_setprio(1); _Pragma("unroll") for (int m = 0; m < 4; ++m) _Pragma("unroll") for (int n = 0; n < 2; ++n) _Pragma("unroll") for (int k = 0; k < 2; ++k) \
        acc[ai][bj][m][n] = __builtin_amdgcn_mfma_f32_16x16x32_bf16(Bt[n][k], At[m][k], acc[ai][bj][m][n], 0, 0, 0); __builtin_amdgcn_s_setprio(0); } while (0)
#define PG8_WAIT_V(n) asm volatile("s_waitcnt vmcnt(" #n ")" ::: "memory")
#define PG8_WAIT_L(n) asm volatile("s_waitcnt lgkmcnt(" #n ")" ::: "memory")
#define PG8_BAR __builtin_amdgcn_s_barrier()
#define PG8_SCHED __builtin_amdgcn_sched_barrier(0)
    Unit cur, nxt; int ui = 0;
    if (!S.next(0, cur)) return;
    f32x4 acc[2][2][4][2];
#pragma unroll
    for (int a = 0; a < 2; ++a)
#pragma unroll
        for (int b = 0; b < 2; ++b)
#pragma unroll
            for (int m = 0; m < 4; ++m)
#pragma unroll
                for (int n = 0; n < 2; ++n) acc[a][b][m][n] = (f32x4){0.f, 0.f, 0.f, 0.f};
    bf16x8 At[4][2], B0[2][2], B1[2][2];
    const char* cA = (const char*)g.A + (size_t)cur.z * g.zA + (size_t)cur.pm * tstepA;
    const char* cB = (const char*)g.Bt + (size_t)cur.z * g.zB + (size_t)cur.pn * tstepB;
    PG8_STAGE(PG8_SB(0, 0), cB, voffB); PG8_STAGE(PG8_SA(0, 0), cA, voffA); PG8_STAGE(PG8_SB(0, 1), cB + hstepB, voffB); PG8_STAGE(PG8_SA(0, 1), cA + hstepA, voffA);
    if (wr == 1) PG8_BAR;
    PG8_WAIT_V(4); PG8_BAR;
    PG8_STAGE(PG8_SB(1, 0), cB + kstep, voffB); PG8_STAGE(PG8_SA(1, 0), cA + kstep, voffA); PG8_STAGE(PG8_SB(1, 1), cB + hstepB + kstep, voffB);
    PG8_WAIT_V(6); PG8_BAR;
    for (;;) {
        const bool has_next = S.next(ui + 1, nxt);
        const char* nA = has_next ? (const char*)g.A + (size_t)nxt.z * g.zA + (size_t)nxt.pm * tstepA : cA;
        const char* nB = has_next ? (const char*)g.Bt + (size_t)nxt.z * g.zB + (size_t)nxt.pn * tstepB : cB;
        for (int t = 0; t < nt; t += 2) {
            const bool last = (t == nt - 2);
            const char* a1 = cA + (size_t)(t + 1) * kstep;
            const char* a2 = last ? nA : cA + (size_t)(t + 2) * kstep; const char* b2 = last ? nB : cB + (size_t)(t + 2) * kstep;
            const char* a3 = a2 + kstep; const char* b3 = b2 + kstep;
            PG8_LDB(B0, 0, 0); PG8_SCHED; PG8_LDA(At, 0, 0); PG8_STAGE(PG8_SA(1, 1), a1 + hstepA, voffA);
            PG8_WAIT_L(8); PG8_BAR; PG8_WAIT_L(0); PG8_MMA(0, 0, At, B0); PG8_BAR; PG8_SCHED;
            PG8_LDB(B1, 0, 1); PG8_STAGE(PG8_SB(0, 0), b2, voffB);
            PG8_BAR; PG8_WAIT_L(0); PG8_MMA(0, 1, At, B1); PG8_BAR;
            PG8_LDA(At, 0, 1); PG8_STAGE(PG8_SA(0, 0), a2, voffA);
            PG8_BAR; PG8_WAIT_L(0); PG8_MMA(1, 0, At, B0); PG8_BAR; PG8_SCHED;
            PG8_STAGE(PG8_SB(0, 1), b2 + hstepB, voffB);
            PG8_WAIT_V(6); PG8_BAR; PG8_MMA(1, 1, At, B1); PG8_BAR;
            PG8_LDB(B0, 1, 0); PG8_SCHED; PG8_LDA(At, 1, 0); PG8_STAGE(PG8_SA(0, 1), a2 + hstepA, voffA);
            PG8_WAIT_L(8); PG8_BAR; PG8_WAIT_L(0); PG8_MMA(0, 0, At, B0); PG8_BAR; PG8_SCHED;
            PG8_LDB(B1, 1, 1); PG8_STAGE(PG8_SB(1, 0), b3, voffB);
            PG8_BAR; PG8_WAIT_L(0); PG8_MMA(0, 1, At, B1); PG8_BAR;
            PG8_LDA(At, 1, 1); PG8_STAGE(PG8_SA(1, 0), a3, voffA);
            PG8_BAR; PG8_WAIT_L(0); PG8_MMA(1, 0, At, B0); PG8_BAR; PG8_SCHED;
            PG8_STAGE(PG8_SB(1, 1), b3 + hstepB, voffB);
            PG8_WAIT_V(6); PG8_BAR; PG8_MMA(1, 1, At, B1); PG8_BAR;
        }
        E(acc, cur, wr, wc, fr, fq);
        if (!has_next) break;
#pragma unroll
        for (int a = 0; a < 2; ++a)
#pragma unroll
            for (int b = 0; b < 2; ++b)
#pragma unroll
                for (int m = 0; m < 4; ++m)
#pragma unroll
                    for (int n = 0; n < 2; ++n) acc[a][b][m][n] = (f32x4){0.f, 0.f, 0.f, 0.f};
        cur = nxt; cA = nA; cB = nB; ++ui;
    }
    PG8_WAIT_V(0);
    if (wr == 0) PG8_BAR;
    PG8_BAR;
#undef PG8_SA
#undef PG8_SB
#undef PG8_STAGE
#undef PG8_LDA
#undef PG8_LDB
#undef PG8_MMA
#undef PG8_WAIT_V
#undef PG8_WAIT_L
#undef PG8_BAR
#undef PG8_SCHED
}

template <int ACT, bool F32>
__device__ __forceinline__ void tile_store(const f32x4 (&acc)[2][2][4][2], void* dst, int ld, int row0, int col0, const float* lbp) {
    f32x4 lb[2][2];
    if (ACT == 3) {
#pragma unroll
        for (int bj = 0; bj < 2; ++bj)
#pragma unroll
            for (int n = 0; n < 2; ++n) lb[bj][n] = *(const f32x4*)(lbp + bj * HALF + n * 16);
    }
#pragma unroll
    for (int ai = 0; ai < 2; ++ai)
#pragma unroll
        for (int m = 0; m < 4; ++m) {
            const size_t ro = (size_t)(row0 + ai * HALF + m * 16) * ld + col0;
#pragma unroll
            for (int bj = 0; bj < 2; ++bj)
#pragma unroll
                for (int n = 0; n < 2; ++n) {
                    f32x4 v = acc[ai][bj][m][n];
#pragma unroll
                    for (int j = 0; j < 4; ++j) {
                        if (ACT == 1) v[j] = siluf(v[j]);
                        if (ACT == 2) v[j] = sigmf(v[j]);
                        if (ACT == 3) v[j] = lb[bj][n][j] + (1.f - lb[bj][n][j]) * sigmf(v[j]);
                    }
                    if (F32) *(f32x4*)((float*)dst + ro + bj * HALF + n * 16) = v;
                    else { u32x2 w; w.x = pk2(v[0], v[1]); w.y = pk2(v[2], v[3]); *(u32x2*)((bf16_t*)dst + ro + bj * HALF + n * 16) = w; }
                }
            asm volatile("" ::: "memory");
        }
}

struct EpiSwiGLU {
    bf16_t* H;
    __device__ __forceinline__ void operator()(const f32x4 (&acc)[2][2][4][2], const Unit& u_, int wr, int wc, int fr, int fq) const {
        Unit u; u.pm = __builtin_amdgcn_readfirstlane(u_.pm); u.pn = __builtin_amdgcn_readfirstlane(u_.pn); u.z = __builtin_amdgcn_readfirstlane(u_.z); asm volatile("" : "+v"(fr), "+v"(fq), "+s"(u.pm), "+s"(u.pn), "+s"(u.z));
        const int row0 = u.pm * BM + wr * 64 + fr;
#pragma unroll
        for (int ai = 0; ai < 2; ++ai)
#pragma unroll
            for (int m = 0; m < 4; ++m) {
                bf16_t* rp = H + (size_t)(row0 + ai * HALF + m * 16) * DFF + 4 * fq;
#pragma unroll
                for (int bj = 0; bj < 2; ++bj) {
                    const int g = 8 * u.pn + 4 * bj + wc;
                    const f32x4 a = acc[ai][bj][m][0], b = acc[ai][bj][m][1];
                    u32x2 w; w.x = pk2(siluf(a[0]) * b[0], siluf(a[1]) * b[1]); w.y = pk2(siluf(a[2]) * b[2], siluf(a[3]) * b[3]);
                    *(u32x2*)(rp + 16 * g) = w;
                }
                asm volatile("" ::: "memory");
            }
    }
};
struct EpiPart {
    bf16_t* P;
    __device__ __forceinline__ void operator()(const f32x4 (&acc)[2][2][4][2], const Unit& u_, int wr, int wc, int fr, int fq) const {
        Unit u; u.pm = __builtin_amdgcn_readfirstlane(u_.pm); u.pn = __builtin_amdgcn_readfirstlane(u_.pn); u.z = __builtin_amdgcn_readfirstlane(u_.z); asm volatile("" : "+v"(fr), "+v"(fq), "+s"(u.pm), "+s"(u.pn), "+s"(u.z));
        tile_store<0, false>(acc, P + (size_t)u.z * NTOK * D, D, u.pm * BM + wr * 64 + fr, u.pn * BM + wc * 32 + 4 * fq, nullptr);
    }
};
struct EpiUp {
    bf16_t* T; const bf16_t* GATE;
    __device__ __forceinline__ void operator()(const f32x4 (&acc)[2][2][4][2], const Unit& u_, int wr, int wc, int fr, int fq) const {
        Unit u; u.pm = __builtin_amdgcn_readfirstlane(u_.pm); u.pn = __builtin_amdgcn_readfirstlane(u_.pn); u.z = __builtin_amdgcn_readfirstlane(u_.z); asm volatile("" : "+v"(fr), "+v"(fq), "+s"(u.pm), "+s"(u.pn), "+s"(u.z));
        const int row0 = u.pm * BM + wr * 64 + fr, col0 = u.pn * BM + wc * 32 + 4 * fq;
        const size_t zo = (size_t)u.z * NTOK * D;
#pragma unroll
        for (int ai = 0; ai < 2; ++ai)
#pragma unroll
            for (int m = 0; m < 4; ++m) {
                const size_t ro = zo + (size_t)(row0 + ai * HALF + m * 16) * D + col0;
#pragma unroll
                for (int bj = 0; bj < 2; ++bj)
#pragma unroll
                    for (int n = 0; n < 2; ++n) {
                        const u32x2 gw = *(const u32x2*)(GATE + ro + bj * HALF + n * 16);
                        const f32x4 v = acc[ai][bj][m][n];
                        u32x2 w; w.x = pk2(v[0] * bflo(gw.x), v[1] * bfhi(gw.x)); w.y = pk2(v[2] * bflo(gw.y), v[3] * bfhi(gw.y));
                        *(u32x2*)(T + ro + bj * HALF + n * 16) = w;
                    }
                asm volatile("" ::: "memory");
            }
    }
};
struct EpiIn {
    bf16_t *QC, *KVC, *HQ, *HV, *HG, *GATE, *KRP; float *FF, *FB, *KRO; const float* LB;
    __device__ __forceinline__ void operator()(const f32x4 (&acc)[2][2][4][2], const Unit& u_, int wr, int wc, int fr, int fq) const {
        Unit u; u.pm = __builtin_amdgcn_readfirstlane(u_.pm); u.pn = __builtin_amdgcn_readfirstlane(u_.pn); u.z = __builtin_amdgcn_readfirstlane(u_.z); asm volatile("" : "+v"(fr), "+v"(fq), "+s"(u.pm), "+s"(u.pn), "+s"(u.z));
        const int pn = u.pn, row0 = u.pm * BM + wr * 64 + fr, cw = wc * 32 + 4 * fq;
        if (pn == 0) { tile_store<0, false>(acc, QC, 384, row0, cw, nullptr); }
        else if (pn == 2) { tile_store<0, false>(acc, KVC, 256, row0, cw, nullptr); }
        else if (pn == 1) {
#pragma unroll
            for (int ai = 0; ai < 2; ++ai)
#pragma unroll
                for (int m = 0; m < 4; ++m) {
                    const int row = row0 + ai * HALF + m * 16;
#pragma unroll
                    for (int n = 0; n < 2; ++n) { const f32x4 v = acc[ai][0][m][n]; u32x2 w; w.x = pk2(v[0], v[1]); w.y = pk2(v[2], v[3]);
                        *(u32x2*)(QC + (size_t)row * 384 + 256 + cw + n * 16) = w; }
                    if (wc == 0) {
                        f32x4 v0 = acc[ai][1][m][0], v1 = acc[ai][1][m][1];
                        int kidx;
                        if (u.pm >= 16) { const int t = (row - NCTX) & 2047; v0 = rope4(v0, (float)(t >> 6), fq); v1 = rope4(v1, (float)(t & 63), fq);
                            kidx = NCTX + ((row - NCTX) >> 11) * 2304 + 256 + t; }
                        else { kidx = row; *(f32x4*)(KRO + (size_t)row * 32 + 4 * fq) = v0; *(f32x4*)(KRO + (size_t)row * 32 + 16 + 4 * fq) = v1; }
                        u32x2 w; w.x = pk2(v0[0], v0[1]); w.y = pk2(v0[2], v0[3]); *(u32x2*)(KRP + (size_t)kidx * 32 + 4 * fq) = w;
                        w.x = pk2(v1[0], v1[1]); w.y = pk2(v1[2], v1[3]); *(u32x2*)(KRP + (size_t)kidx * 32 + 16 + 4 * fq) = w;
                    }
                    asm volatile("" ::: "memory");
                }
        }
        else if (pn <= 12) {
            const int seg = (pn - 3) >> 1, c0 = ((pn - 3) & 1) * 256 + cw;
            if (seg == 0) tile_store<1, false>(acc, HQ, 512, row0, c0, nullptr);
            else if (seg == 1) tile_store<3, true>(acc, FF, 512, row0, c0, LB + c0);
            else if (seg == 2) tile_store<3, true>(acc, FB, 512, row0, c0, LB + 512 + c0);
            else if (seg == 3) tile_store<0, false>(acc, HV, 512, row0, c0, nullptr);
            else tile_store<1, false>(acc, HG, 512, row0, c0, nullptr);
        }
        else { const int z = (pn - 13) >> 2, c0 = ((pn - 13) & 3) * 256 + cw;
            tile_store<2, false>(acc, GATE + (size_t)z * NTOK * D, D, row0, c0, nullptr); }
    }
};
struct EpiQ {
    bf16_t* Q; const float* rinv;
    __device__ __forceinline__ void operator()(const f32x4 (&acc)[2][2][4][2], const Unit& u_, int wr, int wc, int fr, int fq) const {
        Unit u; u.pm = __builtin_amdgcn_readfirstlane(u_.pm); u.pn = __builtin_amdgcn_readfirstlane(u_.pn); u.z = __builtin_amdgcn_readfirstlane(u_.z); asm volatile("" : "+v"(fr), "+v"(fq), "+s"(u.pm), "+s"(u.pn), "+s"(u.z));
#pragma unroll
        for (int ai = 0; ai < 2; ++ai)
#pragma unroll
            for (int m = 0; m < 4; ++m) {
                const int rl = ai * HALF + wr * 64 + m * 16 + fr, row = u.pm * BM + rl;
                const float ri = rinv[row];
#pragma unroll
                for (int bj = 0; bj < 2; ++bj) {
                    const int g32 = 8 * u.pn + 4 * bj + wc;
                    const f32x4 v0 = acc[ai][bj][m][0] * ri, v1 = acc[ai][bj][m][1] * ri;
                    bf16_t* p = Q + (size_t)row * 768 + g32 * 32 + 4 * fq;
                    u32x2 w; w.x = pk2(v0[0], v0[1]); w.y = pk2(v0[2], v0[3]); *(u32x2*)p = w;
                    w.x = pk2(v1[0], v1[1]); w.y = pk2(v1[2], v1[3]); *(u32x2*)(p + 16) = w;
                }
                asm volatile("" ::: "memory");
            }
    }
};
struct EpiKV {
    bf16_t *KN, *VT; const float* rinv;
    __device__ __forceinline__ void operator()(const f32x4 (&acc)[2][2][4][2], const Unit& u_, int wr, int wc, int fr, int fq) const {
        Unit u; u.pm = __builtin_amdgcn_readfirstlane(u_.pm); u.pn = __builtin_amdgcn_readfirstlane(u_.pn); u.z = 0; asm volatile("" : "+v"(fr), "+v"(fq), "+s"(u.pm), "+s"(u.pn));
        const int pm = u.pm;
        int ab, kidx0;
        if (pm < 16) { ab = pm; kidx0 = pm * 256; }
        else if (pm < 32) { ab = 16 + ((pm - 16) >> 3); kidx0 = NCTX + (ab - 16) * 2304 + 256 + ((pm - 16) & 7) * 256; }
        else { ab = 16 + (pm - 32); kidx0 = NCTX + (ab - 16) * 2304; }
        const int Tk = ab < 16 ? 256 : 2304;
        const int j0 = kidx0 - (ab < 16 ? ab * 256 : NCTX + (ab - 16) * 2304);
#pragma unroll
        for (int bj = 0; bj < 2; ++bj) {
            const int h = 2 * u.pn + bj;
            if (wc < 2) {
                bf16_t* base = KN + (size_t)kidx0 * 512 + h * 64 + wc * 32 + 4 * fq;
#pragma unroll
                for (int ai = 0; ai < 2; ++ai)
#pragma unroll
                    for (int m = 0; m < 4; ++m) {
                        const int rl = ai * HALF + wr * 64 + m * 16 + fr;
                        const float ri = rinv[pm * BM + rl];
#pragma unroll
                        for (int n = 0; n < 2; ++n) {
                            const f32x4 v = acc[ai][bj][m][n] * ri;
                            u32x2 w; w.x = pk2(v[0], v[1]); w.y = pk2(v[2], v[3]);
                            *(u32x2*)(base + (size_t)rl * 512 + n * 16) = w;
                        }
                        asm volatile("" ::: "memory");
                    }
            } else {
                const size_t vb = ab < 16 ? (size_t)(ab * 8 + h) * 64 * 256 : (size_t)16 * 8 * 64 * 256 + (size_t)((ab - 16) * 8 + h) * 64 * 2304;
                bf16_t* base = VT + vb + (size_t)((wc - 2) * 32 + 4 * fq) * Tk + j0;
#pragma unroll
                for (int ai = 0; ai < 2; ++ai)
#pragma unroll
                    for (int m = 0; m < 4; ++m) {
                        const int rl = ai * HALF + wr * 64 + m * 16 + fr;
                        const float ri = rinv[pm * BM + rl];
#pragma unroll
                        for (int n = 0; n < 2; ++n) {
                            const f32x4 v = acc[ai][bj][m][n] * ri;
                            const unsigned w0 = pk2(v[0], v[1]), w1 = pk2(v[2], v[3]);
                            bf16_t* vp = base + (size_t)(n * 16) * Tk + rl;
                            vp[0] = (bf16_t)(w0 & 0xffffu); vp[Tk] = (bf16_t)(w0 >> 16); vp[2 * Tk] = (bf16_t)(w1 & 0xffffu); vp[3 * Tk] = (bf16_t)(w1 >> 16);
                        }
                        asm volatile("" ::: "memory");
                    }
            }
        }
    }
};
}

struct Args { const float* in[27]; float* out; unsigned char* ws; };
enum { I_XP = 0, I_XS, I_CCKV, I_CKR, I_ST, I_C, I_CCTX, I_WADA, I_BADA, I_NORMG, I_F1W1, I_F1W3, I_F1W2, I_F2W1, I_F2W3, I_F2W2, I_WIN, I_QNG, I_WQB, I_KVNG, I_WKVB,
       I_WUPA, I_HGGAMMA, I_HGNG, I_WUPR, I_WOUT, I_FING };

__device__ __forceinline__ int map_row(int mode, int n) {
    if (mode == 1) return 32 * (n >> 4) + (n & 15);
    if (mode == 2) return 32 * (n >> 4) + 16 + (n & 15);
    if (mode == 3) return n < 384 ? n : (n < 640 ? n + 128 : (n < 672 ? n - 256 : n + 96));
    return n;
}
__device__ __forceinline__ void tr_item(const float* W, int K, int N, bf16_t* WT, int mode, const float* ksc, LAS float* scr, int item, int lane) {
    const int nblk = N / 32, kb = item / nblk, nb = item % nblk, k0 = 64 * kb, n0 = 32 * nb;
    float tv[32];
#pragma unroll
    for (int i = 0; i < 32; ++i) { const int kk = 2 * i + (lane >> 5); tv[i] = W[(size_t)(k0 + kk) * N + n0 + (lane & 31)]; }
#pragma unroll
    for (int i = 0; i < 32; ++i) { const int kk = 2 * i + (lane >> 5); float v = tv[i]; if (ksc) v *= ksc[k0 + kk]; scr[kk * 33 + (lane & 31)] = v; }
    asm volatile("s_waitcnt lgkmcnt(0)" ::: "memory");
    const int c = lane & 7;
#pragma unroll
    for (int j = 0; j < 4; ++j) { const int n = (lane >> 3) + 8 * j; const LAS float* s = scr + (8 * c) * 33 + n;
        u32x4 o; o.x = pk2(s[0 * 33], s[1 * 33]); o.y = pk2(s[2 * 33], s[3 * 33]); o.z = pk2(s[4 * 33], s[5 * 33]); o.w = pk2(s[6 * 33], s[7 * 33]);
        *(u32x4*)(WT + (size_t)map_row(mode, n0 + n) * K + k0 + 8 * c) = o; }
    asm volatile("s_waitcnt lgkmcnt(0)" ::: "memory");
}

constexpr int TRI_F = 1408, TRI_IN = 2640, TRI_QB = 144, TRI_KVB = 128, TRI_UP = 256, TRI_OUT = 512;
constexpr int TR_A0 = 0, TR_A1 = 2 * TRI_F;
constexpr int TR_B0 = TR_A1, TR_B1 = TR_B0 + TRI_F + TRI_IN;
constexpr int TR_C0 = TR_B1, TR_C1 = TR_C0 + 3 * TRI_F + TRI_QB + 2 * TRI_KVB + 2 * TRI_UP + TRI_OUT;
__device__ __forceinline__ void tr_range(const Args& a, LAS unsigned char* lds, int lo, int hi, int gw, int nw) {
    const int lane = threadIdx.x & 63, wave = threadIdx.x >> 6;
    unsigned char* ws = a.ws;
    LAS float* scr = (LAS float*)(lds + wave * 8448);
    for (int it = lo + gw; it < hi; it += nw) {
        int r = it;
        if (r < TRI_F) { tr_item(a.in[I_F1W1], 1024, DFF, (bf16_t*)(ws + WS_W1A), 1, nullptr, scr, r, lane); continue; } r -= TRI_F;
        if (r < TRI_F) { tr_item(a.in[I_F1W3], 1024, DFF, (bf16_t*)(ws + WS_W1A), 2, nullptr, scr, r, lane); continue; } r -= TRI_F;
        if (r < TRI_F) { tr_item(a.in[I_F1W2], DFF, 1024, (bf16_t*)(ws + WS_W1B), 0, nullptr, scr, r, lane); continue; } r -= TRI_F;
        if (r < TRI_IN) { tr_item(a.in[I_WIN], 1024, DIN, (bf16_t*)(ws + WS_WIN), 3, nullptr, scr, r, lane); continue; } r -= TRI_IN;
        if (r < TRI_F) { tr_item(a.in[I_F2W1], 1024, DFF, (bf16_t*)(ws + WS_W2A), 1, nullptr, scr, r, lane); continue; } r -= TRI_F;
        if (r < TRI_F) { tr_item(a.in[I_F2W3], 1024, DFF, (bf16_t*)(ws + WS_W2A), 2, nullptr, scr, r, lane); continue; } r -= TRI_F;
        if (r < TRI_F) { tr_item(a.in[I_F2W2], DFF, 1024, (bf16_t*)(ws + WS_W2B), 0, nullptr, scr, r, lane); continue; } r -= TRI_F;
        if (r < TRI_QB) { tr_item(a.in[I_WQB], 384, 768, (bf16_t*)(ws + WS_WQB), 0, a.in[I_QNG], scr, r, lane); continue; } r -= TRI_QB;
        if (r < TRI_KVB) { tr_item(a.in[I_WKVB], 256, 1024, (bf16_t*)(ws + WS_WKVB), 0, a.in[I_KVNG], scr, r, lane); continue; } r -= TRI_KVB;
        if (r < TRI_KVB) { tr_item(a.in[I_WKVB], 256, 1024, (bf16_t*)(ws + WS_WKVB) + 1024 * 256, 0, nullptr, scr, r, lane); continue; } r -= TRI_KVB;
        if (r < TRI_UP) { tr_item(a.in[I_WUPA], 512, 1024, (bf16_t*)(ws + WS_WUP), 0, nullptr, scr, r, lane); continue; } r -= TRI_UP;
        if (r < TRI_UP) { tr_item(a.in[I_WUPR], 512, 1024, (bf16_t*)(ws + WS_WUP) + 1024 * 512, 0, nullptr, scr, r, lane); continue; } r -= TRI_UP;
        tr_item(a.in[I_WOUT], 1024, 1024, (bf16_t*)(ws + WS_WOUT), 0, nullptr, scr, r, lane);
    }
}
__device__ __forceinline__ void tr_in_tail(const Args& a, LAS unsigned char* lds, int nunits, int lo, int hi, int G) {
    const int r = nunits % G, wave = threadIdx.x >> 6;
    if (r == 0) tr_range(a, lds, lo, hi, (int)blockIdx.x * 8 + wave, G * 8);
    else if ((int)blockIdx.x >= r) tr_range(a, lds, lo, hi, ((int)blockIdx.x - r) * 8 + wave, (G - r) * 8);
}

__device__ __forceinline__ void phase_prep(const Args& a, LAS unsigned char* lds, int G) {
    const int tid = threadIdx.x, lane = tid & 63, wave = tid >> 6;
    unsigned char* ws = a.ws;
    for (int nb = blockIdx.x; nb < 72; nb += G) {
        LAS float* sc = (LAS float*)lds;
        for (int i = tid; i < 3072; i += NTHR) { const int s = i >> 10, k = i & 1023; const float v = (s == 0) ? a.in[I_CCTX][k] : a.in[I_C][(s - 1) * 1024 + k]; sc[i] = siluf(v); }
        __syncthreads();
        const float* wp = a.in[I_WADA] + (size_t)(wave * 128) * 9216 + nb * 128 + 2 * lane;
        float a00 = 0.f, a01 = 0.f, a10 = 0.f, a11 = 0.f, a20 = 0.f, a21 = 0.f;
#pragma unroll 32
        for (int kk = 0; kk < 128; ++kk) {
            const f32x2 w = *(const f32x2*)(wp + (size_t)kk * 9216);
            const float s0 = sc[wave * 128 + kk], s1 = sc[1024 + wave * 128 + kk], s2 = sc[2048 + wave * 128 + kk];
            a00 += s0 * w.x; a01 += s0 * w.y; a10 += s1 * w.x; a11 += s1 * w.y; a20 += s2 * w.x; a21 += s2 * w.y;
        }
        LAS float* red = sc + 3072;
        red[(wave * 3 + 0) * 128 + 2 * lane] = a00; red[(wave * 3 + 0) * 128 + 2 * lane + 1] = a01;
        red[(wave * 3 + 1) * 128 + 2 * lane] = a10; red[(wave * 3 + 1) * 128 + 2 * lane + 1] = a11;
        red[(wave * 3 + 2) * 128 + 2 * lane] = a20; red[(wave * 3 + 2) * 128 + 2 * lane + 1] = a21;
        __syncthreads();
        for (int i = tid; i < 384; i += NTHR) { const int s = i >> 7, col = i & 127; float v = a.in[I_BADA][nb * 128 + col];
#pragma unroll
            for (int w = 0; w < 8; ++w) v += red[(w * 3 + s) * 128 + col];
            ((float*)(ws + WS_MOD))[s * 9216 + nb * 128 + col] = v; }
        __syncthreads();
    }
    {
        const int nskip = G >= 144 ? 72 : 0;
        const int gw = ((int)blockIdx.x - nskip) * 8 + wave;
        if (gw >= 0) tr_range(a, lds, TR_A0, TR_A1, gw, (G - nskip) * 8);
    }
    {
        const int gt = blockIdx.x * NTHR + tid, NT = G * NTHR;
        for (int i = gt; i < 1024; i += NT) { const int dir = i >> 9, n = i & 511; const float g0 = a.in[I_HGGAMMA][dir * 1024 + n], g1 = a.in[I_HGGAMMA][dir * 1024 + 512 + n];
            ((float*)(ws + WS_LB))[i] = 1.f / (1.f + __expf(g1 - g0)); }
        for (int i = gt; i < 96 * 1024 / 2; i += NT) ((unsigned*)(ws + WS_WIN) + (size_t)416 * 1024 / 2)[i] = 0u;
        for (int i = gt; i < 512 * 32 / 2; i += NT) { const int e = 2 * i, r = e >> 5, cc = e & 31, b = r >> 8, j = r & 255; const f32x2 v = *(const f32x2*)(a.in[I_CKR] + e);
            *(unsigned*)((bf16_t*)(ws + WS_KRP) + (size_t)(NCTX + b * 2304 + j) * 32 + cc) = pk2(v.x, v.y); }
    }
}

template <int MODE>
__device__ __forceinline__ void phase_norm(const Args& a, int G) {
    const int tid = threadIdx.x, lane = tid & 63, wave = tid >> 6;
    unsigned char* ws = a.ws;
    const float* MOD = (const float*)(ws + WS_MOD);
    bf16_t* X = (bf16_t*)(ws + WS_X);
    const bf16_t* P0 = (const bf16_t*)(ws + WS_PART); const bf16_t* P1 = P0 + (size_t)NTOK * D;
    bf16_t* XN = (bf16_t*)(ws + WS_XN);
    constexpr int GI = MODE == 2 ? 2 : (MODE == 3 ? 5 : 8);
    constexpr float GS = MODE == 3 ? 1.0f : 0.5f;
    constexpr int SH = MODE == 1 ? 0 : (MODE == 2 ? 3 : 6), SC = SH + 1;
    for (int rb = blockIdx.x * 8 + wave; rb < NTOK / 4; rb += G * 8) {
        const int row0 = rb * 4;
        const int s = row0 < NCTX ? 0 : 1 + ((row0 - NCTX) >> 11);
        const float* md = MOD + (size_t)s * 9216;
        f32x4 v[4][4]; float ss[4] = {0.f, 0.f, 0.f, 0.f};
        f32x4 gt[4];
        if (MODE != 1) {
#pragma unroll
            for (int j = 0; j < 4; ++j) gt[j] = *(const f32x4*)(md + GI * 1024 + 4 * lane + 256 * j) * GS;
        }
#pragma unroll
        for (int i = 0; i < 4; ++i) {
            const int row = row0 + i;
            const float* xsrc = row < NCTX ? a.in[I_XP] + (size_t)row * D : a.in[I_XS] + (size_t)(row - NCTX) * D;
#pragma unroll
            for (int j = 0; j < 4; ++j) {
                const int c = 4 * lane + 256 * j;
                if (MODE == 1 || MODE == 2) v[i][j] = *(const f32x4*)(xsrc + c);
                else { const u32x2 xw = *(const u32x2*)(X + (size_t)row * D + c); v[i][j].x = bflo(xw.x); v[i][j].y = bfhi(xw.x); v[i][j].z = bflo(xw.y); v[i][j].w = bfhi(xw.y); }
                if (MODE != 1) {
                    const u32x2 q0 = *(const u32x2*)(P0 + (size_t)row * D + c), q1 = *(const u32x2*)(P1 + (size_t)row * D + c);
                    f32x4 ps; ps.x = bflo(q0.x) + bflo(q1.x); ps.y = bfhi(q0.x) + bfhi(q1.x); ps.z = bflo(q0.y) + bflo(q1.y); ps.w = bfhi(q0.y) + bfhi(q1.y);
                    v[i][j] = v[i][j] + gt[j] * ps;
                }
            }
        }
#pragma unroll
        for (int i = 0; i < 4; ++i) {
#pragma unroll
            for (int j = 0; j < 4; ++j) ss[i] += (v[i][j].x * v[i][j].x + v[i][j].y * v[i][j].y) + (v[i][j].z * v[i][j].z + v[i][j].w * v[i][j].w);
        }
#pragma unroll
        for (int o = 1; o < 64; o <<= 1) {
#pragma unroll
            for (int i = 0; i < 4; ++i) ss[i] += __shfl_xor(ss[i], o);
        }
        float rinv[4];
#pragma unroll
        for (int i = 0; i < 4; ++i) rinv[i] = rsqrtf(ss[i] * (1.f / D) + EPS);
#pragma unroll
        for (int j = 0; j < 4; ++j) {
            const int c = 4 * lane + 256 * j;
            if (MODE == 4) {
                const f32x4 g = *(const f32x4*)(a.in[I_FING] + c);
#pragma unroll
                for (int i = 0; i < 4; ++i) *(f32x4*)(a.out + OY + (size_t)(row0 + i) * D + c) = v[i][j] * rinv[i] * g;
            } else {
                const f32x4 g = *(const f32x4*)(a.in[I_NORMG] + (MODE - 1) * 1024 + c), sh = *(const f32x4*)(md + SH * 1024 + c), sc = *(const f32x4*)(md + SC * 1024 + c);
                const f32x4 gs = g * (1.f + sc);
#pragma unroll
                for (int i = 0; i < 4; ++i) {
                    const f32x4 o = v[i][j] * rinv[i] * gs + sh;
                    u32x2 w; w.x = pk2(o.x, o.y); w.y = pk2(o.z, o.w);
                    *(u32x2*)(XN + (size_t)(row0 + i) * D + c) = w;
                    if (MODE == 2 || MODE == 3) { u32x2 xw; xw.x = pk2(v[i][j].x, v[i][j].y); xw.y = pk2(v[i][j].z, v[i][j].w); *(u32x2*)(X + (size_t)(row0 + i) * D + c) = xw; }
                }
            }
        }
    }
}

constexpr int AT_KN = 0, AT_KR = 8192, AT_VT = 12288, AT_STAGE = 20480;
__device__ __forceinline__ void attn_item(LAS unsigned char* lds, const bf16_t* Q, const bf16_t* KN, const bf16_t* KRP, const bf16_t* VT, bf16_t* O, int ab, int h, int qt) {
    const int tid = threadIdx.x, lane = tid & 63, wave = __builtin_amdgcn_readfirstlane(tid >> 6), fr = lane & 15, fq = lane >> 4;
    const int Tk = ab < 16 ? 256 : 2304;
    const int kbase = ab < 16 ? ab * 256 : NCTX + (ab - 16) * 2304;
    const size_t vbase = ab < 16 ? (size_t)(ab * 8 + h) * 64 * 256 : (size_t)16 * 8 * 64 * 256 + (size_t)((ab - 16) * 8 + h) * 64 * 2304;
    const int qrow = (ab < 16 ? ab * 256 : NCTX + (ab - 16) * 2048) + qt * 128 + wave * 16 + fr;
    bf16x8 qf[3];
#pragma unroll
    for (int ks = 0; ks < 3; ++ks) qf[ks] = *(const bf16x8*)(Q + (size_t)qrow * 768 + h * 96 + ks * 32 + fq * 8);
    if (ab >= 16) {
        const int t = qt * 128 + wave * 16 + fr;
        const float pos = fq < 2 ? (float)(t >> 6) : (float)(t & 63);
        const u32x4 w = __builtin_bit_cast(u32x4, qf[2]);
        u32x4 pw; pw.x = __shfl_xor(w.x, 16); pw.y = __shfl_xor(w.y, 16); pw.z = __shfl_xor(w.z, 16); pw.w = __shfl_xor(w.w, 16);
        const float x[8] = {bflo(w.x), bfhi(w.x), bflo(w.y), bfhi(w.y), bflo(w.z), bfhi(w.z), bflo(w.w), bfhi(w.w)};
        const float pp[8] = {bflo(pw.x), bfhi(pw.x), bflo(pw.y), bfhi(pw.y), bflo(pw.z), bfhi(pw.z), bflo(pw.w), bfhi(pw.w)};
        const float iv[8] = {1.0f, 0.31622776601683794f, 0.1f, 0.031622776601683794f, 0.01f, 0.0031622776601683794f, 0.001f, 0.00031622776601683794f};
        float o[8];
#pragma unroll
        for (int i = 0; i < 8; ++i) {
            float rev = pos * iv[i] * 0.15915494309189535f; rev -= rintf(rev);
            const float s = __builtin_amdgcn_sinf(rev), c = __builtin_amdgcn_cosf(rev);
            o[i] = (fq & 1) ? (x[i] * c + pp[i] * s) : (x[i] * c - pp[i] * s);
        }
        u32x4 ow; ow.x = pk2(o[0], o[1]); ow.y = pk2(o[2], o[3]); ow.z = pk2(o[4], o[5]); ow.w = pk2(o[6], o[7]);
        qf[2] = __builtin_bit_cast(bf16x8, ow);
    }
    const int nt = Tk / 64;
    const int kk = wave * 8 + (lane >> 3), kc = (lane & 7) ^ (kk & 7);
    const char* gk = (const char*)(KN + (size_t)(kbase + kk) * 512 + h * 64 + kc * 8);
    const int rk = (wave & 3) * 16 + (lane >> 2), rc = (lane & 3) ^ ((rk >> 2) & 3);
    const char* gr = (const char*)(KRP + (size_t)(kbase + rk) * 32 + rc * 8);
    const int vd = wave * 8 + (lane >> 3), vc = (lane & 7) ^ (vd & 7);
    const char* gv = (const char*)(VT + vbase + (size_t)vd * Tk + vc * 8);
    const unsigned ldk = AT_KN + wave * 1024, ldr = AT_KR + (wave & 3) * 1024, ldv = AT_VT + wave * 1024;
#define AT_ISSUE(tile, stg) do { const int _t = (tile) < nt ? (tile) : nt - 1; const unsigned _s = (unsigned)(stg) * AT_STAGE; \
        __builtin_amdgcn_global_load_lds((const unsigned*)(gk + (size_t)_t * 65536), (LAS unsigned*)(lds + _s + ldk), 16, 0, 0); \
        __builtin_amdgcn_global_load_lds((const unsigned*)(gr + (size_t)_t * 4096), (LAS unsigned*)(lds + _s + ldr), 16, 0, 0); \
        __builtin_amdgcn_global_load_lds((const unsigned*)(gv + (size_t)_t * 128), (LAS unsigned*)(lds + _s + ldv), 16, 0, 0); } while (0)
    asm volatile("s_waitcnt vmcnt(0) lgkmcnt(0)" ::: "memory");
    __builtin_amdgcn_s_barrier();
    AT_ISSUE(0, 0); AT_ISSUE(1, 1);
    f32x4 oacc[4];
#pragma unroll
    for (int i = 0; i < 4; ++i) oacc[i] = (f32x4){0.f, 0.f, 0.f, 0.f};
    float mrun = -INFINITY, lrun = 0.f;
    const float cs = 0.10206207261596577f * 1.4426950408889634f;
    const int sw7 = fr & 7, sw3 = (fr >> 2) & 3;
    int stg = 0;
    for (int t = 0; t < nt; ++t) {
        asm volatile("s_waitcnt vmcnt(3)" ::: "memory");
        __builtin_amdgcn_s_barrier();
        asm volatile("" ::: "memory");
        { const int s2 = stg >= 1 ? stg - 1 : 2; AT_ISSUE(t + 2, s2); }
        const LAS unsigned char* sb = lds + stg * AT_STAGE;
        f32x4 s[4];
#pragma unroll
        for (int kb = 0; kb < 4; ++kb) {
            s[kb] = (f32x4){0.f, 0.f, 0.f, 0.f};
            const int key = kb * 16 + fr;
#pragma unroll
            for (int ks = 0; ks < 2; ++ks) {
                const bf16x8 kf = *(const LAS bf16x8*)(sb + AT_KN + key * 128 + (((ks * 4 + fq) ^ sw7) * 16));
                s[kb] = __builtin_amdgcn_mfma_f32_16x16x32_bf16(kf, qf[ks], s[kb], 0, 0, 0);
            }
            const bf16x8 kr = *(const LAS bf16x8*)(sb + AT_KR + key * 64 + ((fq ^ sw3) * 16));
            s[kb] = __builtin_amdgcn_mfma_f32_16x16x32_bf16(kr, qf[2], s[kb], 0, 0, 0);
        }
        float mx = fmaxf(fmaxf(s[0][0], s[0][1]), fmaxf(s[0][2], s[0][3]));
#pragma unroll
        for (int kb = 1; kb < 4; ++kb) mx = fmaxf(mx, fmaxf(fmaxf(s[kb][0], s[kb][1]), fmaxf(s[kb][2], s[kb][3])));
        mx = fmaxf(mx, __shfl_xor(mx, 16)); mx = fmaxf(mx, __shfl_xor(mx, 32));
        const float mn = fmaxf(mrun, mx);
        const float alpha = __builtin_amdgcn_exp2f((mrun - mn) * cs);
        mrun = mn;
        const float mc = mn * cs;
        float ps = 0.f;
#pragma unroll
        for (int kb = 0; kb < 4; ++kb)
#pragma unroll
            for (int j = 0; j < 4; ++j) { const float p = __builtin_amdgcn_exp2f(s[kb][j] * cs - mc); s[kb][j] = p; ps += p; }
        lrun = lrun * alpha + ps;
#pragma unroll
        for (int i = 0; i < 4; ++i) oacc[i] = oacc[i] * alpha;
        bf16x8 pf[2];
#pragma unroll
        for (int kp2 = 0; kp2 < 2; ++kp2) {
            u32x4 w; w.x = pk2(s[2 * kp2][0], s[2 * kp2][1]); w.y = pk2(s[2 * kp2][2], s[2 * kp2][3]);
            w.z = pk2(s[2 * kp2 + 1][0], s[2 * kp2 + 1][1]); w.w = pk2(s[2 * kp2 + 1][2], s[2 * kp2 + 1][3]);
            pf[kp2] = __builtin_bit_cast(bf16x8, w);
        }
#pragma unroll
        for (int db = 0; db < 4; ++db)
#pragma unroll
            for (int kp2 = 0; kp2 < 2; ++kp2) {
                const int d = db * 16 + fr, c0 = kp2 * 4 + (fq >> 1);
                const LAS unsigned char* vb = sb + AT_VT + d * 128 + (fq & 1) * 8;
                const u32x2 lo = *(const LAS u32x2*)(vb + ((c0 ^ sw7) * 16)), hi = *(const LAS u32x2*)(vb + (((c0 + 2) ^ sw7) * 16));
                u32x4 w; w.x = lo.x; w.y = lo.y; w.z = hi.x; w.w = hi.y;
                oacc[db] = __builtin_amdgcn_mfma_f32_16x16x32_bf16(__builtin_bit_cast(bf16x8, w), pf[kp2], oacc[db], 0, 0, 0);
            }
        stg = stg == 2 ? 0 : stg + 1;
    }
    asm volatile("s_waitcnt vmcnt(0)" ::: "memory");
    lrun += __shfl_xor(lrun, 16); lrun += __shfl_xor(lrun, 32);
    const float il = 1.f / lrun;
#pragma unroll
    for (int db = 0; db < 4; ++db) {
        u32x2 w; w.x = pk2(oacc[db][0] * il, oacc[db][1] * il); w.y = pk2(oacc[db][2] * il, oacc[db][3] * il);
        *(u32x2*)(O + (size_t)qrow * 512 + h * 64 + db * 16 + fq * 4) = w;
    }
#undef AT_ISSUE
}

typedef short s16x4 __attribute__((ext_vector_type(4)));
constexpr int HW_QE = 0, HW_KE = 2304, HW_KGT = 4608, HW_VT = 7680, HW_EG = 10752, HW_BYTES = 11008;
constexpr int HG_OB = 0, HG_WL = 65536;
__device__ __forceinline__ bf16_t f2bf(float x) { return (bf16_t)(pk2(x, 0.f) & 0xffffu); }
constexpr int HG_RAW = 88064;
template <bool WITH_O>
__device__ __forceinline__ void hgrn_block_scan(f32x4 (&S)[4][4], float& dtot, LAS unsigned char* lds, const bf16_t* HQ, const bf16_t* HV, const float* FF, const float* FB, int row0, int h) {
    const int tid = threadIdx.x, lane = tid & 63, wave = __builtin_amdgcn_readfirstlane(tid >> 6), fr = lane & 15, quad = lane >> 4;
    const bool scanner = wave < 2;
    const int dir = wave & 1;
#define HG_BAR() do { asm volatile("s_waitcnt lgkmcnt(0)" ::: "memory"); __builtin_amdgcn_s_barrier(); asm volatile("" ::: "memory"); } while (0)
    if (!scanner) {
        const int lt = tid - 128;
        const char* lsrc[3]; int ldst[3]; int lstep[3]; bool lval[3];
#pragma unroll
        for (int j = 0; j < 3; ++j) {
            const int i = lt + 384 * j; const int d = (i >> 9) & 1, r = i & 511;
            lval[j] = i < 1024 && (WITH_O || r < 256 || r >= 384);
            int row, dst; const char* s;
            if (r < 256) { row = r >> 4; const int ch = r & 15; s = (const char*)((d ? FB : FF) + (size_t)row0 * 512 + h * 64 + ch * 4); dst = ch * 16; lstep[j] = 2048; }
            else if (r < 384) { const int r2 = r - 256; row = r2 >> 3; const int ch = r2 & 7; s = (const char*)(HQ + (size_t)row0 * 512 + h * 64 + ch * 8); dst = 4096 + ch * 16; lstep[j] = 1024; }
            else { const int r2 = r - 384; row = r2 >> 3; const int ch = r2 & 7; s = (const char*)(HV + (size_t)row0 * 512 + h * 64 + ch * 8); dst = 6144 + ch * 16; lstep[j] = 1024; }
            const int rowbytes = r < 256 ? 256 : 128;
            lsrc[j] = s + (size_t)((d ? 240 : 0) + row) * lstep[j];
            lstep[j] = (d ? -16 : 16) * lstep[j];
            ldst[j] = d * 8192 + dst + (d ? 15 - row : row) * rowbytes;
        }
        u32x4 lnxt[3];
#pragma unroll
        for (int j = 0; j < 3; ++j) if (lval[j]) lnxt[j] = *(const u32x4*)lsrc[j];
#pragma unroll
        for (int j = 0; j < 3; ++j) if (lval[j]) *(LAS u32x4*)(lds + HG_RAW + ldst[j]) = lnxt[j];
#pragma unroll
        for (int j = 0; j < 3; ++j) if (lval[j]) lnxt[j] = *(const u32x4*)(lsrc[j] + (ptrdiff_t)lstep[j]);
        HG_BAR();
        for (int c = 0; c < 16; ++c) {
            if (c + 1 < 16) {
                asm volatile("s_waitcnt vmcnt(0)" ::: "memory");
#pragma unroll
                for (int j = 0; j < 3; ++j) if (lval[j]) *(LAS u32x4*)(lds + HG_RAW + ((c + 1) & 1) * 16384 + ldst[j]) = lnxt[j];
                if (c + 2 < 16) {
#pragma unroll
                    for (int j = 0; j < 3; ++j) if (lval[j]) lnxt[j] = *(const u32x4*)(lsrc[j] + (ptrdiff_t)(c + 2) * lstep[j]);
                }
            }
            HG_BAR();
        }
    } else {
        LAS unsigned char* wl = lds + HG_WL + dir * HW_BYTES;
        LAS unsigned char* qe = wl + HW_QE; LAS unsigned char* ke = wl + HW_KE; LAS unsigned char* kgT = wl + HW_KGT; LAS unsigned char* vT = wl + HW_VT;
        LAS float* eg = (LAS float*)(wl + HW_EG);
        LAS float* obuf = (LAS float*)(lds + HG_OB);
        HG_BAR();
        for (int c = 0; c < 16; ++c) {
            const LAS unsigned char* rb = lds + HG_RAW + (c & 1) * 16384 + dir * 8192;
            float b2 = 0.f; float kreg[16];
            float fin[16]; unsigned qin[16];
#pragma unroll
            for (int s = 0; s < 16; ++s) { fin[s] = *(const LAS float*)(rb + s * 256 + lane * 4);
                if (WITH_O) qin[s] = *(const LAS bf16_t*)(rb + 4096 + s * 128 + lane * 2); }
#pragma unroll
            for (int s = 0; s < 16; ++s) {
                const float fv = fin[s];
                b2 += __log2f(fv);
                const float kin = (1.f - fv) * __builtin_amdgcn_exp2f(-b2);
                kreg[s] = kin;
                if (WITH_O) {
                    *(LAS bf16_t*)(ke + s * 144 + lane * 2) = f2bf(kin);
                    const float qv = __uint_as_float(qin[s] << 16) * __builtin_amdgcn_exp2f(b2);
                    *(LAS bf16_t*)(qe + s * 144 + lane * 2) = f2bf(qv);
                }
            }
            const float egv = __builtin_amdgcn_exp2f(b2);
            eg[lane] = egv; dtot *= egv;
            {
                u32x4 w0, w1;
                w0.x = pk2(kreg[0] * egv, kreg[1] * egv); w0.y = pk2(kreg[2] * egv, kreg[3] * egv); w0.z = pk2(kreg[4] * egv, kreg[5] * egv); w0.w = pk2(kreg[6] * egv, kreg[7] * egv);
                w1.x = pk2(kreg[8] * egv, kreg[9] * egv); w1.y = pk2(kreg[10] * egv, kreg[11] * egv); w1.z = pk2(kreg[12] * egv, kreg[13] * egv); w1.w = pk2(kreg[14] * egv, kreg[15] * egv);
                *(LAS u32x4*)(kgT + lane * 48) = w0; *(LAS u32x4*)(kgT + lane * 48 + 16) = w1;
                unsigned vv[16];
#pragma unroll
                for (int s = 0; s < 16; ++s) vv[s] = *(const LAS bf16_t*)(rb + 6144 + s * 128 + lane * 2);
                u32x4 x0, x1;
                x0.x = vv[0] | (vv[1] << 16); x0.y = vv[2] | (vv[3] << 16); x0.z = vv[4] | (vv[5] << 16); x0.w = vv[6] | (vv[7] << 16);
                x1.x = vv[8] | (vv[9] << 16); x1.y = vv[10] | (vv[11] << 16); x1.z = vv[12] | (vv[13] << 16); x1.w = vv[14] | (vv[15] << 16);
                *(LAS u32x4*)(vT + lane * 48) = x0; *(LAS u32x4*)(vT + lane * 48 + 16) = x1;
            }
            asm volatile("s_waitcnt lgkmcnt(0)" ::: "memory");
            s16x4 bv[4];
#pragma unroll
            for (int vb = 0; vb < 4; ++vb) bv[vb] = *(const LAS s16x4*)(vT + (vb * 16 + fr) * 48 + quad * 8);
            if (WITH_O) {
                f32x4 at = (f32x4){0.f, 0.f, 0.f, 0.f};
#pragma unroll
                for (int kp = 0; kp < 2; ++kp) {
                    const bf16x8 ak = *(const LAS bf16x8*)(ke + fr * 144 + kp * 64 + quad * 16);
                    const bf16x8 bq = *(const LAS bf16x8*)(qe + fr * 144 + kp * 64 + quad * 16);
                    at = __builtin_amdgcn_mfma_f32_16x16x32_bf16(ak, bq, at, 0, 0, 0);
                }
#pragma unroll
                for (int r = 0; r < 4; ++r) at[r] = (quad * 4 + r <= fr) ? at[r] : 0.f;
                u32x2 pw; pw.x = pk2(at[0], at[1]); pw.y = pk2(at[2], at[3]);
                const s16x4 pa = __builtin_bit_cast(s16x4, pw);
                f32x4 o[4];
#pragma unroll
                for (int vb = 0; vb < 4; ++vb) o[vb] = __builtin_amdgcn_mfma_f32_16x16x16bf16_1k(pa, bv[vb], (f32x4){0.f, 0.f, 0.f, 0.f}, 0, 0, 0);
#pragma unroll
                for (int kb = 0; kb < 4; ++kb) {
                    const s16x4 aq = *(const LAS s16x4*)(qe + fr * 144 + kb * 32 + quad * 8);
#pragma unroll
                    for (int vb = 0; vb < 4; ++vb) {
                        u32x2 sw; sw.x = pk2(S[kb][vb][0], S[kb][vb][1]); sw.y = pk2(S[kb][vb][2], S[kb][vb][3]);
                        o[vb] = __builtin_amdgcn_mfma_f32_16x16x16bf16_1k(aq, __builtin_bit_cast(s16x4, sw), o[vb], 0, 0, 0);
                    }
                }
                {
                    LAS float* ob0 = obuf + (dir == 0 ? 16 * c + quad * 4 : 255 - 16 * c - quad * 4) * 64 + fr;
                    const int rs = dir == 0 ? 64 : -64;
#pragma unroll
                    for (int r = 0; r < 4; ++r)
#pragma unroll
                        for (int vb = 0; vb < 4; ++vb)
                            __hip_atomic_fetch_add(ob0 + r * rs + vb * 16, o[vb][r], __ATOMIC_RELAXED, __HIP_MEMORY_SCOPE_WORKGROUP);
                }
            }
#pragma unroll
            for (int kb = 0; kb < 4; ++kb) {
                const f32x4 ev = *(const LAS f32x4*)(eg + kb * 16 + quad * 4);
                const s16x4 akg = *(const LAS s16x4*)(kgT + (kb * 16 + fr) * 48 + quad * 8);
#pragma unroll
                for (int vb = 0; vb < 4; ++vb) S[kb][vb] = __builtin_amdgcn_mfma_f32_16x16x16bf16_1k(akg, bv[vb], S[kb][vb] * ev, 0, 0, 0);
            }
            HG_BAR();
        }
    }
#undef HG_BAR
    __syncthreads();
}

__device__ __forceinline__ void hgrn_pass1(const Args& a, LAS unsigned char* lds, int bi) {
    const int tid = threadIdx.x, lane = tid & 63, wave = tid >> 6, fr = lane & 15, quad = lane >> 4;
    unsigned char* ws = a.ws;
    const int dir = wave & 1, seg = bi & 7, h = (bi >> 3) & 7, b = bi >> 6;
    const int row0 = NCTX + b * 2048 + seg * 256;
    f32x4 S[4][4]; float dtot = 1.f;
#pragma unroll
    for (int kb = 0; kb < 4; ++kb)
#pragma unroll
        for (int vb = 0; vb < 4; ++vb) S[kb][vb] = (f32x4){0.f, 0.f, 0.f, 0.f};
    hgrn_block_scan<false>(S, dtot, lds, (const bf16_t*)(ws + WS_HQ), (const bf16_t*)(ws + WS_HV), (const float*)(ws + WS_FF), (const float*)(ws + WS_FB), row0, h);
    if (wave < 2) {
        const int item = bi * 2 + dir;
        float* sl = (float*)(ws + WS_SLOC) + (size_t)item * 4096 + quad * 256 + fr;
#pragma unroll
        for (int kb = 0; kb < 4; ++kb) {
            float* pk = sl + kb * 1024; asm volatile("" : "+v"(pk));
#pragma unroll
            for (int vb = 0; vb < 4; ++vb)
#pragma unroll
                for (int r = 0; r < 4; ++r) pk[r * 64 + vb * 16] = S[kb][vb][r];
        }
        ((float*)(ws + WS_GDEC))[(size_t)item * 64 + lane] = dtot;
    }
}

__device__ __forceinline__ void hgrn_pass2(const Args& a, LAS unsigned char* lds, int item) {
    const int tid = threadIdx.x, lane = tid & 63, wave = tid >> 6, fr = lane & 15, quad = lane >> 4;
    unsigned char* ws = a.ws;
    const bool ctx = item < 128;
    int b, h, seg = 0, row0;
    if (ctx) { b = item >> 3; h = item & 7; row0 = b * 256; }
    else { const int it = item - 128; seg = it & 7; h = (it >> 3) & 7; b = it >> 6; row0 = NCTX + b * 2048 + seg * 256; }
    LAS float* ob = (LAS float*)(lds + HG_OB);
    for (int i = tid; i < 256 * 64 / 4; i += NTHR) ((LAS f32x4*)ob)[i] = (f32x4){0.f, 0.f, 0.f, 0.f};
    const int dir = wave & 1;
    f32x4 S[4][4]; float dtot = 1.f;
#pragma unroll
    for (int kb = 0; kb < 4; ++kb)
#pragma unroll
        for (int vb = 0; vb < 4; ++vb) S[kb][vb] = (f32x4){0.f, 0.f, 0.f, 0.f};
    if (wave < 2 && !ctx) {
        const int it2 = ((b * 8 + h) * 8 + seg) * 2 + dir;
        const float* s0 = (const float*)(ws + WS_SENT) + (size_t)it2 * 4096 + quad * 256 + fr;
#pragma unroll
        for (int kb = 0; kb < 4; ++kb) {
            const float* pk = s0 + kb * 1024; asm volatile("" : "+v"(pk));
#pragma unroll
            for (int vb = 0; vb < 4; ++vb)
#pragma unroll
                for (int r = 0; r < 4; ++r) S[kb][vb][r] = pk[r * 64 + vb * 16];
        }
    }
    hgrn_block_scan<true>(S, dtot, lds, (const bf16_t*)(ws + WS_HQ), (const bf16_t*)(ws + WS_HV), (const float*)(ws + WS_FF), (const float*)(ws + WS_FB), row0, h);
    if (wave < 2 && ctx) {
        float* so = a.out + OST + (size_t)((b * 2 + dir) * 8 + h) * 4096 + quad * 256 + fr;
#pragma unroll
        for (int kb = 0; kb < 4; ++kb) {
            float* pk = so + kb * 1024; asm volatile("" : "+v"(pk));
#pragma unroll
            for (int vb = 0; vb < 4; ++vb)
#pragma unroll
                for (int r = 0; r < 4; ++r) pk[r * 64 + vb * 16] = S[kb][vb][r];
        }
    }
    const float gn = a.in[I_HGNG][lane];
    const bf16_t* HG = (const bf16_t*)(ws + WS_HG);
    bf16_t* OR = (bf16_t*)(ws + WS_O) + (size_t)NTOK * 512;
    {
        const size_t off0 = (size_t)(row0 + wave * 32) * 512 + h * 64 + lane;
        bf16_t gt[32];
#pragma unroll
        for (int i = 0; i < 32; ++i) gt[i] = HG[off0 + (size_t)i * 512];
#pragma unroll
        for (int i = 0; i < 32; ++i) {
            const float v = ob[(wave * 32 + i) * 64 + lane];
            const float rinv = rsqrtf(wave_sum(v * v) * (1.f / 64.f) + EPS);
            const float gate = __uint_as_float((unsigned)gt[i] << 16);
            OR[off0 + (size_t)i * 512] = f2bf(v * rinv * gn * gate);
        }
    }
    __syncthreads();
}


template <int NST>
__device__ __forceinline__ void attn_group_item(const Args& a, LAS unsigned char* lds, unsigned ring_off, int wa, int ab, int h, int qt) {
    const int tid = threadIdx.x, lane = tid & 63, fr = lane & 15, fq = lane >> 4;
    unsigned char* ws = a.ws;
    const bf16_t* Q = (const bf16_t*)(ws + WS_Q); const bf16_t* KN = (const bf16_t*)(ws + WS_KN); const bf16_t* KRP = (const bf16_t*)(ws + WS_KRP); const bf16_t* VT = (const bf16_t*)(ws + WS_VT);
    bf16_t* O = (bf16_t*)(ws + WS_O);
    const float cs = 0.10206207261596577f * 1.4426950408889634f;
    const int sw7 = fr & 7, sw3 = (fr >> 2) & 3;
        const int Tk = ab < 16 ? 256 : 2304;
        const int kbase = ab < 16 ? ab * 256 : NCTX + (ab - 16) * 2304;
        const size_t vbase = ab < 16 ? (size_t)(ab * 8 + h) * 64 * 256 : (size_t)16 * 8 * 64 * 256 + (size_t)((ab - 16) * 8 + h) * 64 * 2304;
        const int qrow = (ab < 16 ? ab * 256 : NCTX + (ab - 16) * 2048) + qt * 128 + wa * 32 + fr;
        bf16x8 qf[2][3];
#pragma unroll
        for (int sb = 0; sb < 2; ++sb)
#pragma unroll
            for (int ks = 0; ks < 3; ++ks) qf[sb][ks] = *(const bf16x8*)(Q + (size_t)(qrow + 16 * sb) * 768 + h * 96 + ks * 32 + fq * 8);
        if (ab >= 16) {
#pragma unroll
            for (int sb = 0; sb < 2; ++sb) {
                const int t = qt * 128 + wa * 32 + 16 * sb + fr;
                const float pos = fq < 2 ? (float)(t >> 6) : (float)(t & 63);
                const u32x4 w = __builtin_bit_cast(u32x4, qf[sb][2]);
                u32x4 pw; pw.x = __shfl_xor(w.x, 16); pw.y = __shfl_xor(w.y, 16); pw.z = __shfl_xor(w.z, 16); pw.w = __shfl_xor(w.w, 16);
                const float x[8] = {bflo(w.x), bfhi(w.x), bflo(w.y), bfhi(w.y), bflo(w.z), bfhi(w.z), bflo(w.w), bfhi(w.w)};
                const float pp[8] = {bflo(pw.x), bfhi(pw.x), bflo(pw.y), bfhi(pw.y), bflo(pw.z), bfhi(pw.z), bflo(pw.w), bfhi(pw.w)};
                const float iv[8] = {1.0f, 0.31622776601683794f, 0.1f, 0.031622776601683794f, 0.01f, 0.0031622776601683794f, 0.001f, 0.00031622776601683794f};
                float o[8];
#pragma unroll
                for (int i = 0; i < 8; ++i) {
                    float rev = pos * iv[i] * 0.15915494309189535f; rev -= rintf(rev);
                    const float s = __builtin_amdgcn_sinf(rev), c = __builtin_amdgcn_cosf(rev);
                    o[i] = (fq & 1) ? (x[i] * c + pp[i] * s) : (x[i] * c - pp[i] * s);
                }
                u32x4 ow; ow.x = pk2(o[0], o[1]); ow.y = pk2(o[2], o[3]); ow.z = pk2(o[4], o[5]); ow.w = pk2(o[6], o[7]);
                qf[sb][2] = __builtin_bit_cast(bf16x8, ow);
            }
        }
        const int nt = Tk / 64;
        const char* gk[2]; const char* gv[2];
#pragma unroll
        for (int j = 0; j < 2; ++j) {
            const int kk = (2 * wa + j) * 8 + (lane >> 3), kc = (lane & 7) ^ (kk & 7);
            gk[j] = (const char*)(KN + (size_t)(kbase + kk) * 512 + h * 64 + kc * 8);
            const int vd = (2 * wa + j) * 8 + (lane >> 3), vc = (lane & 7) ^ (vd & 7);
            gv[j] = (const char*)(VT + vbase + (size_t)vd * Tk + vc * 8);
        }
        const int rk = wa * 16 + (lane >> 2), rc = (lane & 3) ^ ((rk >> 2) & 3);
        const char* gr = (const char*)(KRP + (size_t)(kbase + rk) * 32 + rc * 8);
#define F_ISSUE(tile, stg) do { const int _t = (tile) < nt ? (tile) : nt - 1; const unsigned _s = ring_off + (unsigned)(stg) * AT_STAGE; \
        __builtin_amdgcn_global_load_lds((const unsigned*)(gk[0] + (size_t)_t * 65536), (LAS unsigned*)(lds + _s + AT_KN + (2 * wa) * 1024), 16, 0, 0); \
        __builtin_amdgcn_global_load_lds((const unsigned*)(gk[1] + (size_t)_t * 65536), (LAS unsigned*)(lds + _s + AT_KN + (2 * wa + 1) * 1024), 16, 0, 0); \
        __builtin_amdgcn_global_load_lds((const unsigned*)(gr + (size_t)_t * 4096), (LAS unsigned*)(lds + _s + AT_KR + wa * 1024), 16, 0, 0); \
        __builtin_amdgcn_global_load_lds((const unsigned*)(gv[0] + (size_t)_t * 128), (LAS unsigned*)(lds + _s + AT_VT + (2 * wa) * 1024), 16, 0, 0); \
        __builtin_amdgcn_global_load_lds((const unsigned*)(gv[1] + (size_t)_t * 128), (LAS unsigned*)(lds + _s + AT_VT + (2 * wa + 1) * 1024), 16, 0, 0); } while (0)
        asm volatile("s_waitcnt vmcnt(0) lgkmcnt(0)" ::: "memory");
        __builtin_amdgcn_s_barrier();
        asm volatile("" ::: "memory");
        F_ISSUE(0, 0); if (NST == 3) F_ISSUE(1, 1);
        f32x4 oacc[2][4];
#pragma unroll
        for (int sb = 0; sb < 2; ++sb)
#pragma unroll
            for (int i = 0; i < 4; ++i) oacc[sb][i] = (f32x4){0.f, 0.f, 0.f, 0.f};
        float mrun[2] = {-INFINITY, -INFINITY}, lrun[2] = {0.f, 0.f};
        int stg = 0;
        for (int t = 0; t < nt; ++t) {
            if (NST == 3) asm volatile("s_waitcnt vmcnt(5)" ::: "memory"); else asm volatile("s_waitcnt vmcnt(0)" ::: "memory");
            __builtin_amdgcn_s_barrier();
            asm volatile("" ::: "memory");
            if (NST == 3) { const int s2 = stg >= 1 ? stg - 1 : 2; F_ISSUE(t + 2, s2); } else { F_ISSUE(t + 1, stg ^ 1); }
            const LAS unsigned char* sbp = lds + ring_off + stg * AT_STAGE;
            f32x4 s[2][4];
#pragma unroll
            for (int kb = 0; kb < 4; ++kb) {
                s[0][kb] = (f32x4){0.f, 0.f, 0.f, 0.f}; s[1][kb] = (f32x4){0.f, 0.f, 0.f, 0.f};
                const int key = kb * 16 + fr;
#pragma unroll
                for (int ks = 0; ks < 2; ++ks) {
                    const bf16x8 kf = *(const LAS bf16x8*)(sbp + AT_KN + key * 128 + (((ks * 4 + fq) ^ sw7) * 16));
                    s[0][kb] = __builtin_amdgcn_mfma_f32_16x16x32_bf16(kf, qf[0][ks], s[0][kb], 0, 0, 0);
                    s[1][kb] = __builtin_amdgcn_mfma_f32_16x16x32_bf16(kf, qf[1][ks], s[1][kb], 0, 0, 0);
                }
                const bf16x8 kr = *(const LAS bf16x8*)(sbp + AT_KR + key * 64 + ((fq ^ sw3) * 16));
                s[0][kb] = __builtin_amdgcn_mfma_f32_16x16x32_bf16(kr, qf[0][2], s[0][kb], 0, 0, 0);
                s[1][kb] = __builtin_amdgcn_mfma_f32_16x16x32_bf16(kr, qf[1][2], s[1][kb], 0, 0, 0);
            }
            bf16x8 pf[2][2];
#pragma unroll
            for (int sb = 0; sb < 2; ++sb) {
                float mx = fmaxf(fmaxf(s[sb][0][0], s[sb][0][1]), fmaxf(s[sb][0][2], s[sb][0][3]));
#pragma unroll
                for (int kb = 1; kb < 4; ++kb) mx = fmaxf(mx, fmaxf(fmaxf(s[sb][kb][0], s[sb][kb][1]), fmaxf(s[sb][kb][2], s[sb][kb][3])));
                const bool upd = __builtin_amdgcn_ballot_w64((mx - mrun[sb]) * cs > 8.f) != 0ull;
                if (upd) {
                    mx = fmaxf(mx, __shfl_xor(mx, 16)); mx = fmaxf(mx, __shfl_xor(mx, 32));
                    const float mn = fmaxf(mrun[sb], mx);
                    const float alpha = __builtin_amdgcn_exp2f((mrun[sb] - mn) * cs);
                    mrun[sb] = mn;
                    lrun[sb] *= alpha;
#pragma unroll
                    for (int i = 0; i < 4; ++i) oacc[sb][i] = oacc[sb][i] * alpha;
                }
                const float mc = mrun[sb] * cs;
                float ps = 0.f;
#pragma unroll
                for (int kb = 0; kb < 4; ++kb)
#pragma unroll
                    for (int j = 0; j < 4; ++j) { const float p = __builtin_amdgcn_exp2f(s[sb][kb][j] * cs - mc); s[sb][kb][j] = p; ps += p; }
                lrun[sb] += ps;
#pragma unroll
                for (int kp2 = 0; kp2 < 2; ++kp2) {
                    u32x4 w; w.x = pk2(s[sb][2 * kp2][0], s[sb][2 * kp2][1]); w.y = pk2(s[sb][2 * kp2][2], s[sb][2 * kp2][3]);
                    w.z = pk2(s[sb][2 * kp2 + 1][0], s[sb][2 * kp2 + 1][1]); w.w = pk2(s[sb][2 * kp2 + 1][2], s[sb][2 * kp2 + 1][3]);
                    pf[sb][kp2] = __builtin_bit_cast(bf16x8, w);
                }
            }
#pragma unroll
            for (int db = 0; db < 4; ++db)
#pragma unroll
                for (int kp2 = 0; kp2 < 2; ++kp2) {
                    const int d = db * 16 + fr, c0 = kp2 * 4 + (fq >> 1);
                    const LAS unsigned char* vb = sbp + AT_VT + d * 128 + (fq & 1) * 8;
                    const u32x2 lo = *(const LAS u32x2*)(vb + ((c0 ^ sw7) * 16)), hi = *(const LAS u32x2*)(vb + (((c0 + 2) ^ sw7) * 16));
                    u32x4 w; w.x = lo.x; w.y = lo.y; w.z = hi.x; w.w = hi.y;
                    const bf16x8 vf = __builtin_bit_cast(bf16x8, w);
                    oacc[0][db] = __builtin_amdgcn_mfma_f32_16x16x32_bf16(vf, pf[0][kp2], oacc[0][db], 0, 0, 0);
                    oacc[1][db] = __builtin_amdgcn_mfma_f32_16x16x32_bf16(vf, pf[1][kp2], oacc[1][db], 0, 0, 0);
                }
            stg = (stg == NST - 1) ? 0 : stg + 1;
        }
        asm volatile("s_waitcnt vmcnt(0)" ::: "memory");
#pragma unroll
        for (int sb = 0; sb < 2; ++sb) {
            float l = lrun[sb]; l += __shfl_xor(l, 16); l += __shfl_xor(l, 32);
            const float il = 1.f / l;
#pragma unroll
            for (int db = 0; db < 4; ++db) {
                u32x2 w; w.x = pk2(oacc[sb][db][0] * il, oacc[sb][db][1] * il); w.y = pk2(oacc[sb][db][2] * il, oacc[sb][db][3] * il);
                *(u32x2*)(O + (size_t)(qrow + 16 * sb) * 512 + h * 64 + db * 16 + fq * 4) = w;
            }
        }
#undef F_ISSUE
}

constexpr int F_RING = 0, F_WL = 61440, F_RAW = 83456, F_NB = 32;
__device__ __forceinline__ void p7_fused(const Args& a, LAS unsigned char* lds, int blk) {
    const int tid = threadIdx.x, lane = tid & 63, wave = __builtin_amdgcn_readfirstlane(tid >> 6), fr = lane & 15, fq = lane >> 4;
    unsigned char* ws = a.ws;
#define F_BAR() do { asm volatile("s_waitcnt lgkmcnt(0)" ::: "memory"); __builtin_amdgcn_s_barrier(); asm volatile("" ::: "memory"); } while (0)
    const bool ctx = blk < 128;
    int hb, hh, hseg = 0, hrow0;
    if (ctx) { hb = blk >> 3; hh = blk & 7; hrow0 = hb * 256; }
    else { const int it = blk - 128; hseg = it & 7; hh = (it >> 3) & 7; hb = it >> 6; hrow0 = NCTX + hb * 2048 + hseg * 256; }
    if (wave < 4) {
        attn_group_item<3>(a, lds, F_RING, wave, 16 + (blk >> 7), (blk >> 4) & 7, blk & 15);
    } else if (wave >= 6) {
        const int lt = tid - 384;
        const bf16_t* HQ = (const bf16_t*)(ws + WS_HQ); const bf16_t* HV = (const bf16_t*)(ws + WS_HV);
        const char* lsrc[8]; int ldst[8];
#pragma unroll
        for (int j = 0; j < 8; ++j) {
            const int d = j >> 2, ty = j & 3;
            int row, dst, rowbytes, tokbytes; const char* s;
            if (ty < 2) { const int r = ty * 128 + lt; row = r >> 4; const int ch = r & 15; s = (const char*)((const float*)(ws + (d ? WS_FB : WS_FF)) + (size_t)hrow0 * 512 + hh * 64 + ch * 4); dst = ch * 16; rowbytes = 256; tokbytes = 2048; }
            else { row = lt >> 3; const int ch = lt & 7; s = (const char*)((ty == 2 ? HQ : HV) + (size_t)hrow0 * 512 + hh * 64 + ch * 8); dst = (ty == 2 ? 4096 : 6144) + ch * 16; rowbytes = 128; tokbytes = 1024; }
            lsrc[j] = s + (size_t)((d ? 240 : 0) + row) * tokbytes;
            ldst[j] = F_RAW + d * 8192 + dst + (d ? 15 - row : row) * rowbytes;
        }
        u32x4 lnxt[8];
#pragma unroll
        for (int j = 0; j < 8; ++j) lnxt[j] = *(const u32x4*)lsrc[j];
#pragma unroll
        for (int j = 0; j < 8; ++j) *(LAS u32x4*)(lds + ldst[j]) = lnxt[j];
#pragma unroll
        for (int j = 0; j < 8; ++j) { const int d = j >> 2, tokbytes = (j & 3) < 2 ? 2048 : 1024; lnxt[j] = *(const u32x4*)(lsrc[j] + (ptrdiff_t)((d ? -16 : 16) * tokbytes)); }
        for (int n = 0; n < F_NB; ++n) {
            F_BAR();
            const int c = n >> 1;
            if ((n & 1) == 0 && c + 1 < 16) {
                asm volatile("s_waitcnt vmcnt(0)" ::: "memory");
#pragma unroll
                for (int j = 0; j < 8; ++j) *(LAS u32x4*)(lds + ((c + 1) & 1) * 16384 + ldst[j]) = lnxt[j];
                if (c + 2 < 16) {
#pragma unroll
                    for (int j = 0; j < 8; ++j) { const int d = j >> 2, tokbytes = (j & 3) < 2 ? 2048 : 1024; lnxt[j] = *(const u32x4*)(lsrc[j] + (ptrdiff_t)(c + 2) * ((d ? -16 : 16) * tokbytes)); }
                }
            }
        }
        attn_group_item<2>(a, lds, F_WL, wave - 4, blk >> 4, (blk >> 1) & 7, blk & 1);
    } else {
        const int dir = wave & 1, quad = fq;
        f32x4 S[4][4];
#pragma unroll
        for (int kb = 0; kb < 4; ++kb)
#pragma unroll
            for (int vb = 0; vb < 4; ++vb) S[kb][vb] = (f32x4){0.f, 0.f, 0.f, 0.f};
        if (!ctx) {
            const int it2 = ((hb * 8 + hh) * 8 + hseg) * 2 + dir;
            const float* s0 = (const float*)(ws + WS_SENT) + (size_t)it2 * 4096 + quad * 256 + fr;
#pragma unroll
            for (int kb = 0; kb < 4; ++kb) {
                const float* pk = s0 + kb * 1024; asm volatile("" : "+v"(pk));
#pragma unroll
                for (int vb = 0; vb < 4; ++vb)
#pragma unroll
                    for (int r = 0; r < 4; ++r) S[kb][vb][r] = pk[r * 64 + vb * 16];
            }
        }
        LAS unsigned char* wl = lds + F_WL + dir * HW_BYTES;
        LAS unsigned char* qe = wl + HW_QE; LAS unsigned char* ke = wl + HW_KE; LAS unsigned char* kgT = wl + HW_KGT; LAS unsigned char* vT = wl + HW_VT;
        LAS float* eg = (LAS float*)(wl + HW_EG);
        bf16_t* OX = (bf16_t*)(ws + (dir ? WS_OBW : WS_OFW));
        for (int n = 0; n < F_NB; ++n) {
            F_BAR();
            const int c = n >> 1;
            if (n < 32 && (n & 1) == 0) {
                const LAS unsigned char* rb = lds + F_RAW + (c & 1) * 16384 + dir * 8192;
                float b2 = 0.f; float kreg[16];
                float fin[16]; unsigned qin[16];
#pragma unroll
                for (int s = 0; s < 16; ++s) { fin[s] = *(const LAS float*)(rb + s * 256 + lane * 4); qin[s] = *(const LAS bf16_t*)(rb + 4096 + s * 128 + lane * 2); }
#pragma unroll
                for (int s = 0; s < 16; ++s) {
                    const float fv = fin[s];
                    b2 += __log2f(fv);
                    const float kin = (1.f - fv) * __builtin_amdgcn_exp2f(-b2);
                    kreg[s] = kin;
                    *(LAS bf16_t*)(ke + s * 144 + lane * 2) = f2bf(kin);
                    const float qv = __uint_as_float(qin[s] << 16) * __builtin_amdgcn_exp2f(b2);
                    *(LAS bf16_t*)(qe + s * 144 + lane * 2) = f2bf(qv);
                }
                const float egv = __builtin_amdgcn_exp2f(b2);
                eg[lane] = egv;
                {
                    u32x4 w0, w1;
                    w0.x = pk2(kreg[0] * egv, kreg[1] * egv); w0.y = pk2(kreg[2] * egv, kreg[3] * egv); w0.z = pk2(kreg[4] * egv, kreg[5] * egv); w0.w = pk2(kreg[6] * egv, kreg[7] * egv);
                    w1.x = pk2(kreg[8] * egv, kreg[9] * egv); w1.y = pk2(kreg[10] * egv, kreg[11] * egv); w1.z = pk2(kreg[12] * egv, kreg[13] * egv); w1.w = pk2(kreg[14] * egv, kreg[15] * egv);
                    *(LAS u32x4*)(kgT + lane * 48) = w0; *(LAS u32x4*)(kgT + lane * 48 + 16) = w1;
                    unsigned vv[16];
#pragma unroll
                    for (int s = 0; s < 16; ++s) vv[s] = *(const LAS bf16_t*)(rb + 6144 + s * 128 + lane * 2);
                    u32x4 x0, x1;
                    x0.x = vv[0] | (vv[1] << 16); x0.y = vv[2] | (vv[3] << 16); x0.z = vv[4] | (vv[5] << 16); x0.w = vv[6] | (vv[7] << 16);
                    x1.x = vv[8] | (vv[9] << 16); x1.y = vv[10] | (vv[11] << 16); x1.z = vv[12] | (vv[13] << 16); x1.w = vv[14] | (vv[15] << 16);
                    *(LAS u32x4*)(vT + lane * 48) = x0; *(LAS u32x4*)(vT + lane * 48 + 16) = x1;
                }
            }
            if (n < 32 && (n & 1) == 1) {
                s16x4 bv[4];
#pragma unroll
                for (int vb = 0; vb < 4; ++vb) bv[vb] = *(const LAS s16x4*)(vT + (vb * 16 + fr) * 48 + quad * 8);
                f32x4 at = (f32x4){0.f, 0.f, 0.f, 0.f};
#pragma unroll
                for (int kp = 0; kp < 2; ++kp) {
                    const bf16x8 ak = *(const LAS bf16x8*)(ke + fr * 144 + kp * 64 + quad * 16);
                    const bf16x8 bq = *(const LAS bf16x8*)(qe + fr * 144 + kp * 64 + quad * 16);
                    at = __builtin_amdgcn_mfma_f32_16x16x32_bf16(ak, bq, at, 0, 0, 0);
                }
#pragma unroll
                for (int r = 0; r < 4; ++r) at[r] = (quad * 4 + r <= fr) ? at[r] : 0.f;
                u32x2 pw; pw.x = pk2(at[0], at[1]); pw.y = pk2(at[2], at[3]);
                const s16x4 pa = __builtin_bit_cast(s16x4, pw);
                f32x4 o[4];
#pragma unroll
                for (int vb = 0; vb < 4; ++vb) o[vb] = __builtin_amdgcn_mfma_f32_16x16x16bf16_1k(pa, bv[vb], (f32x4){0.f, 0.f, 0.f, 0.f}, 0, 0, 0);
#pragma unroll
                for (int kb = 0; kb < 4; ++kb) {
                    const s16x4 aq = *(const LAS s16x4*)(qe + fr * 144 + kb * 32 + quad * 8);
#pragma unroll
                    for (int vb = 0; vb < 4; ++vb) {
                        u32x2 sw; sw.x = pk2(S[kb][vb][0], S[kb][vb][1]); sw.y = pk2(S[kb][vb][2], S[kb][vb][3]);
                        o[vb] = __builtin_amdgcn_mfma_f32_16x16x16bf16_1k(aq, __builtin_bit_cast(s16x4, sw), o[vb], 0, 0, 0);
                    }
                }
                {
                    const int tl0 = dir == 0 ? 16 * c + quad * 4 : 255 - 16 * c - quad * 4;
                    bf16_t* op = OX + (size_t)(hrow0 + tl0) * 512 + hh * 64 + fr;
                    const ptrdiff_t rs = dir == 0 ? 512 : -512;
#pragma unroll
                    for (int r = 0; r < 4; ++r)
#pragma unroll
                        for (int vb = 0; vb < 4; ++vb) op[r * rs + vb * 16] = f2bf(o[vb][r]);
                }
#pragma unroll
                for (int kb = 0; kb < 4; ++kb) {
                    const f32x4 ev = *(const LAS f32x4*)(eg + kb * 16 + quad * 4);
                    const s16x4 akg = *(const LAS s16x4*)(kgT + (kb * 16 + fr) * 48 + quad * 8);
#pragma unroll
                    for (int vb = 0; vb < 4; ++vb) S[kb][vb] = __builtin_amdgcn_mfma_f32_16x16x16bf16_1k(akg, bv[vb], S[kb][vb] * ev, 0, 0, 0);
                }
                if (n == 31 && ctx) {
                    float* so = a.out + OST + (size_t)((hb * 2 + dir) * 8 + hh) * 4096 + quad * 256 + fr;
#pragma unroll
                    for (int kb = 0; kb < 4; ++kb) {
                        float* pk = so + kb * 1024; asm volatile("" : "+v"(pk));
#pragma unroll
                        for (int vb = 0; vb < 4; ++vb)
#pragma unroll
                            for (int r = 0; r < 4; ++r) pk[r * 64 + vb * 16] = S[kb][vb][r];
                    }
                }
            }
        }
        attn_group_item<2>(a, lds, F_WL, wave - 4, blk >> 4, (blk >> 1) & 7, blk & 1);
    }
#undef F_BAR
    __syncthreads();
}

__device__ __forceinline__ void phase_hgfin(const Args& a, int G) {
    const int tid = threadIdx.x, lane = tid & 63, wave = tid >> 6;
    unsigned char* ws = a.ws;
    const bf16_t* OF = (const bf16_t*)(ws + WS_OFW); const bf16_t* OB = (const bf16_t*)(ws + WS_OBW); const bf16_t* HG = (const bf16_t*)(ws + WS_HG);
    bf16_t* OR = (bf16_t*)(ws + WS_O) + (size_t)NTOK * 512;
    const f32x4 g0 = *(const f32x4*)(a.in[I_HGNG] + (lane & 7) * 8), g1 = *(const f32x4*)(a.in[I_HGNG] + (lane & 7) * 8 + 4);
#pragma unroll 4
    for (int row = blockIdx.x * 8 + wave; row < NTOK; row += G * 8) {
        const size_t off = (size_t)row * 512 + lane * 8;
        const u32x4 wf = *(const u32x4*)(OF + off), wb = *(const u32x4*)(OB + off), wg = *(const u32x4*)(HG + off);
        float v[8] = {bflo(wf.x) + bflo(wb.x), bfhi(wf.x) + bfhi(wb.x), bflo(wf.y) + bflo(wb.y), bfhi(wf.y) + bfhi(wb.y),
                      bflo(wf.z) + bflo(wb.z), bfhi(wf.z) + bfhi(wb.z), bflo(wf.w) + bflo(wb.w), bfhi(wf.w) + bfhi(wb.w)};
        float ss = 0.f;
#pragma unroll
        for (int i = 0; i < 8; ++i) ss += v[i] * v[i];
        ss += __shfl_xor(ss, 1); ss += __shfl_xor(ss, 2); ss += __shfl_xor(ss, 4);
        const float ri = rsqrtf(ss * (1.f / 64.f) + EPS);
        u32x4 o;
        o.x = pk2(v[0] * ri * g0.x * bflo(wg.x), v[1] * ri * g0.y * bfhi(wg.x)); o.y = pk2(v[2] * ri * g0.z * bflo(wg.y), v[3] * ri * g0.w * bfhi(wg.y));
        o.z = pk2(v[4] * ri * g1.x * bflo(wg.z), v[5] * ri * g1.y * bfhi(wg.z)); o.w = pk2(v[6] * ri * g1.z * bflo(wg.w), v[7] * ri * g1.w * bfhi(wg.w));
        *(u32x4*)(OR + off) = o;
    }
}


#define XB_TMO      128
#define XB_XCNT(j)  (256  + 64 * (j))
#define XB_XSUB(j)  (1280 + 64 * (j))
#define XB_XGEN(j)  (2304 + 64 * (j))
#define XB_TOP      3328
#define XB_TOPGEN   3392
#define XCD_BAR_WORDS 3456
#define XB_SPIN_CAP (1u << 18)
__device__ __forceinline__ unsigned xb_ld(unsigned* p)              { return __hip_atomic_load(p, __ATOMIC_RELAXED, __HIP_MEMORY_SCOPE_AGENT); }
__device__ __forceinline__ unsigned xb_add(unsigned* p, unsigned v) { return __hip_atomic_fetch_add(p, v, __ATOMIC_RELAXED, __HIP_MEMORY_SCOPE_AGENT); }
__device__ __forceinline__ unsigned xb_xcc_id() { return (unsigned)__builtin_amdgcn_s_getreg((3 << 11) | 20) & 0xFu; }
#define XB_SPIN(cond, bar) do { unsigned _sp = 0; while (cond) { __builtin_amdgcn_s_sleep(1); \
    if ((++_sp & 255u) == 0u) { if (xb_ld(&(bar)[XB_TMO])) break; if (_sp > XB_SPIN_CAP) { atomicAdd(&(bar)[XB_TMO], 1u); break; } } } } while (0)
struct XcdBarrier { unsigned* bar; unsigned x; volatile LAS unsigned* st; };
__device__ __forceinline__ XcdBarrier xcd_barrier_post(unsigned* bar, volatile LAS unsigned* st) {
    XcdBarrier b; b.bar = bar; b.x = xb_xcc_id(); b.st = st;
    if (threadIdx.x == 0) (void)xb_add(&bar[XB_XCNT(b.x)], 1u);
    return b;
}
__device__ __forceinline__ void xcd_barrier_complete(unsigned* bar, unsigned x, unsigned& nloc, unsigned& nx) {
    const unsigned G = gridDim.x * gridDim.y * gridDim.z;
    unsigned sum, cnt, mine, sp = 0u;
    for (;;) {
        sum = 0u; cnt = 0u; mine = 0u;
#pragma unroll
        for (unsigned j = 0; j < 16; ++j) { const unsigned c = xb_ld(&bar[XB_XCNT(j)]); sum += c; cnt += (c > 0u) ? 1u : 0u; mine = (j == x) ? c : mine; }
        if (sum == G) break;
        __builtin_amdgcn_s_sleep(1);
        if ((++sp & 255u) == 0u) { if (xb_ld(&bar[XB_TMO])) break; if (sp > XB_SPIN_CAP) { atomicAdd(&bar[XB_TMO], 1u); break; } }
    }
    nloc = mine > 0u ? mine : 1u; nx = cnt > 0u ? cnt : 1u;
}
__device__ __forceinline__ void xcd_barrier(const XcdBarrier& b) {
    asm volatile("s_waitcnt vmcnt(0)" ::: "memory");
    __syncthreads();
    if (threadIdx.x == 0) {
        unsigned* bar = b.bar;
        __builtin_amdgcn_s_waitcnt(0);
        unsigned nloc = b.st[0], nx = b.st[1];
        if (nloc == 0u) { xcd_barrier_complete(bar, b.x, nloc, nx); b.st[0] = nloc; b.st[1] = nx; }
        const unsigned old = xb_add(&bar[XB_XSUB(b.x)], 1u);
        const unsigned gen = old / nloc;
        if (old + 1u == (gen + 1u) * nloc) {
            __builtin_amdgcn_fence(__ATOMIC_RELEASE, "agent");
            asm volatile("s_waitcnt vmcnt(0)" ::: "memory");
            const unsigned og = xb_add(&bar[XB_TOP], 1u);
            const unsigned tg = og / nx;
            if (og + 1u == (tg + 1u) * nx) xb_add(&bar[XB_TOPGEN], 1u);
            else XB_SPIN(xb_ld(&bar[XB_TOPGEN]) == tg, bar);
            __builtin_amdgcn_fence(__ATOMIC_ACQUIRE, "agent");
            xb_add(&bar[XB_XGEN(b.x)], 1u);
            asm volatile("s_waitcnt vmcnt(0)" ::: "memory");
        } else {
            XB_SPIN(xb_ld(&bar[XB_XGEN(b.x)]) == gen, bar);
            __builtin_amdgcn_fence(__ATOMIC_ACQUIRE, "agent");
            asm volatile("s_waitcnt vmcnt(0)" ::: "memory");
        }
    }
    __syncthreads();
}

#ifndef PHMASK
#define PHMASK 0xFFFFF
#endif
#define PH(n) ((PHMASK >> (n)) & 1)
__global__ void __launch_bounds__(NTHR, 2) fwd_megakernel(Args a) {
    extern __shared__ __attribute__((aligned(16))) unsigned char lds_raw[];
    LAS unsigned char* lds = (LAS unsigned char*)lds_raw;
    volatile LAS unsigned* bar_st = (volatile LAS unsigned*)(lds + LDS_BYTES - 16);
    if (threadIdx.x < 4) bar_st[threadIdx.x] = 0u;
    __syncthreads();
    XcdBarrier gbar = xcd_barrier_post((unsigned*)(a.ws + WS_BAR), bar_st);
    const int G = gridDim.x, tid = threadIdx.x;
    unsigned char* ws = a.ws;
    using namespace pg8;

    if (PH(0)) {
    phase_prep(a, lds, G);
    }
    xcd_barrier(gbar);
    if (PH(1)) {
    phase_norm<1>(a, G);
    }
    xcd_barrier(gbar);
    if (PH(2)) {
    { Gemm g{(const bf16_t*)(ws + WS_XN), (const bf16_t*)(ws + WS_W1A), D, D, D, 0, 0}; GridOrder S{32, 22, 1, G, (int)blockIdx.x, 0}; EpiSwiGLU E{(bf16_t*)(ws + WS_HFF)};
      gemm_phase(lds, g, S, E); }
    tr_in_tail(a, lds, 32 * 22, TR_B0, TR_B1, G);
    }
    xcd_barrier(gbar);
    if (PH(3)) {
    { Gemm g{(const bf16_t*)(ws + WS_HFF), (const bf16_t*)(ws + WS_W1B), DFF, DFF, DFF / 2, (size_t)DFF, (size_t)DFF}; GridOrder S{32, 4, 2, G, (int)blockIdx.x, 0}; EpiPart E{(bf16_t*)(ws + WS_PART)};
      gemm_phase(lds, g, S, E); }
    }
    xcd_barrier(gbar);
    if (PH(4)) {
    phase_norm<2>(a, G);
    }
    xcd_barrier(gbar);
    if (PH(5)) {
    { Gemm g{(const bf16_t*)(ws + WS_XN), (const bf16_t*)(ws + WS_WIN), D, D, D, 0, 0}; GridOrder S{32, 21, 1, G, (int)blockIdx.x, 0};
      EpiIn E{(bf16_t*)(ws + WS_QC), (bf16_t*)(ws + WS_KVC), (bf16_t*)(ws + WS_HQ), (bf16_t*)(ws + WS_HV), (bf16_t*)(ws + WS_HG), (bf16_t*)(ws + WS_GATE), (bf16_t*)(ws + WS_KRP),
              (float*)(ws + WS_FF), (float*)(ws + WS_FB), a.out + OKR, (const float*)(ws + WS_LB)};
      gemm_phase(lds, g, S, E); }
    tr_in_tail(a, lds, 32 * 21, TR_C0, TR_C1, G);
    }
    xcd_barrier(gbar);
    if (PH(6)) {
        const int lane = tid & 63, wave = tid >> 6;
        float* RQ = (float*)(ws + WS_RQ); float* RKV = (float*)(ws + WS_RKV);
        const int nsk = G >= 192 ? 128 : 0;
        for (int rb = ((int)blockIdx.x - nsk) * 8 + wave; rb >= 0 && rb < NTOK / 4; rb += (G - nsk) * 8) {
            const int row0 = rb * 4;
            u32x4 wq[4], wk[4];
#pragma unroll
            for (int i = 0; i < 4; ++i) {
                wq[i] = (u32x4){0u, 0u, 0u, 0u}; wk[i] = (u32x4){0u, 0u, 0u, 0u};
                if (lane < 48) wq[i] = *(const u32x4*)((const bf16_t*)(ws + WS_QC) + (size_t)(row0 + i) * 384 + lane * 8);
                if (lane < 32) wk[i] = *(const u32x4*)((const bf16_t*)(ws + WS_KVC) + (size_t)(row0 + i) * 256 + lane * 8);
            }
            float sq[4], sk[4];
#pragma unroll
            for (int i = 0; i < 4; ++i) {
                { const u32x4 w = wq[i]; const float e0 = bflo(w.x), e1 = bfhi(w.x), e2 = bflo(w.y), e3 = bfhi(w.y), e4 = bflo(w.z), e5 = bfhi(w.z), e6 = bflo(w.w), e7 = bfhi(w.w);
                  sq[i] = (e0 * e0 + e1 * e1) + (e2 * e2 + e3 * e3) + (e4 * e4 + e5 * e5) + (e6 * e6 + e7 * e7); }
                { const u32x4 w = wk[i]; const float e0 = bflo(w.x), e1 = bfhi(w.x), e2 = bflo(w.y), e3 = bfhi(w.y), e4 = bflo(w.z), e5 = bfhi(w.z), e6 = bflo(w.w), e7 = bfhi(w.w);
                  sk[i] = (e0 * e0 + e1 * e1) + (e2 * e2 + e3 * e3) + (e4 * e4 + e5 * e5) + (e6 * e6 + e7 * e7); }
            }
#pragma unroll
            for (int o = 1; o < 64; o <<= 1) {
#pragma unroll
                for (int i = 0; i < 4; ++i) { sq[i] += __shfl_xor(sq[i], o); sk[i] += __shfl_xor(sk[i], o); }
            }
#pragma unroll
            for (int i = 0; i < 4; ++i) {
                const int row = row0 + i;
                const float ri = rsqrtf(sk[i] * (1.f / 256.f) + EPS);
                if (lane == 0) { RQ[row] = rsqrtf(sq[i] * (1.f / 384.f) + EPS); RKV[row] = ri; }
                if (row < NCTX && lane < 32) {
                    const u32x4 w = wk[i];
                    const f32x4 g0 = *(const f32x4*)(a.in[I_KVNG] + lane * 8), g1 = *(const f32x4*)(a.in[I_KVNG] + lane * 8 + 4);
                    f32x4 o0, o1; o0.x = bflo(w.x) * ri * g0.x; o0.y = bfhi(w.x) * ri * g0.y; o0.z = bflo(w.y) * ri * g0.z; o0.w = bfhi(w.y) * ri * g0.w;
                    o1.x = bflo(w.z) * ri * g1.x; o1.y = bfhi(w.z) * ri * g1.y; o1.z = bflo(w.w) * ri * g1.z; o1.w = bfhi(w.w) * ri * g1.w;
                    float* op = a.out + OCKV + (size_t)row * 256 + lane * 8;
                    *(f32x4*)op = o0; *(f32x4*)(op + 4) = o1;
                }
            }
        }
        for (int i = blockIdx.x * NTHR + tid; i < 512; i += G * NTHR) RKV[NTOK + i] = 1.f;
        for (int i = blockIdx.x * NTHR + tid; i < 512 * 256 / 2; i += G * NTHR) { const f32x2 v = *(const f32x2*)(a.in[I_CCKV] + 2 * (size_t)i); ((unsigned*)(ws + WS_KVC) + (size_t)NTOK * 256 / 2)[i] = pk2(v.x, v.y); }
        __syncthreads();
        for (int it = blockIdx.x; it < 128; it += G) hgrn_pass1(a, lds, it);
    }
    xcd_barrier(gbar);
    if (PH(6)) {
        { Gemm g{(const bf16_t*)(ws + WS_QC), (const bf16_t*)(ws + WS_WQB), 384, 384, 384, 0, 0}; GridOrder S{32, 3, 1, G, (int)blockIdx.x, 0}; EpiQ E{(bf16_t*)(ws + WS_Q), (const float*)(ws + WS_RQ)};
          gemm_phase(lds, g, S, E); }
        { Gemm g{(const bf16_t*)(ws + WS_KVC), (const bf16_t*)(ws + WS_WKVB), 256, 256, 256, 0, (size_t)1024 * 256 * 2}; GridOrder S{34, 4, 1, G, (int)((blockIdx.x + G - 96 % G) % G), 32}; EpiKV E{(bf16_t*)(ws + WS_KN), (bf16_t*)(ws + WS_VT), (const float*)(ws + WS_RKV)};
          gemm_phase(lds, g, S, E); }
        __syncthreads();
        for (int it = blockIdx.x; it < 256; it += G) {
            const int dir = it & 1, seg = (it >> 1) & 7, bh = it >> 4;
            const float* s0 = a.in[I_ST] + (size_t)(((bh >> 3) * 2 + dir) * 8 + (bh & 7)) * 4096;
            f32x4 e0 = *(const f32x4*)(s0 + tid * 4), e1 = *(const f32x4*)(s0 + 2048 + tid * 4);
            const int k0 = tid >> 4, k1 = 32 + (tid >> 4);
            const int nsteps = dir == 0 ? seg : 7 - seg;
            for (int st = 0; st < nsteps; ++st) {
                const int sj = dir == 0 ? st : 7 - st;
                const int pit = (bh * 8 + sj) * 2 + dir;
                const float* sl = (const float*)(ws + WS_SLOC) + (size_t)pit * 4096;
                const float* gd = (const float*)(ws + WS_GDEC) + (size_t)pit * 64;
                const f32x4 l0 = *(const f32x4*)(sl + tid * 4), l1 = *(const f32x4*)(sl + 2048 + tid * 4);
                const float g0 = gd[k0], g1 = gd[k1];
                e0 = g0 * e0 + l0; e1 = g1 * e1 + l1;
            }
            float* se = (float*)(ws + WS_SENT) + (size_t)it * 4096;
            *(f32x4*)(se + tid * 4) = e0; *(f32x4*)(se + 2048 + tid * 4) = e1;
        }
    }
    xcd_barrier(gbar);
    if (PH(7)) {
        p7_fused(a, lds, (int)blockIdx.x);
    }
    xcd_barrier(gbar);
    if (PH(7)) {
        phase_hgfin(a, G);
    }
    xcd_barrier(gbar);
    if (PH(8)) {
    { Gemm g{(const bf16_t*)(ws + WS_O), (const bf16_t*)(ws + WS_WUP), 512, 512, 512, (size_t)NTOK * 512 * 2, (size_t)1024 * 512 * 2}; GridOrder S{32, 4, 2, G, (int)blockIdx.x, 0};
      EpiUp E{(bf16_t*)(ws + WS_T), (const bf16_t*)(ws + WS_GATE)};
      gemm_phase(lds, g, S, E); }
    }
    xcd_barrier(gbar);
    if (PH(9)) {
    { Gemm g{(const bf16_t*)(ws + WS_T), (const bf16_t*)(ws + WS_WOUT), D, D, D, (size_t)NTOK * D * 2, 0}; GridOrder S{32, 4, 2, G, (int)blockIdx.x, 0}; EpiPart E{(bf16_t*)(ws + WS_PART)};
      gemm_phase(lds, g, S, E); }
    }
    xcd_barrier(gbar);
    if (PH(10)) {
    phase_norm<3>(a, G);
    }
    xcd_barrier(gbar);
    if (PH(11)) {
    { Gemm g{(const bf16_t*)(ws + WS_XN), (const bf16_t*)(ws + WS_W2A), D, D, D, 0, 0}; GridOrder S{32, 22, 1, G, (int)blockIdx.x, 0}; EpiSwiGLU E{(bf16_t*)(ws + WS_HFF)};
      gemm_phase(lds, g, S, E); }
    }
    xcd_barrier(gbar);
    if (PH(12)) {
    { Gemm g{(const bf16_t*)(ws + WS_HFF), (const bf16_t*)(ws + WS_W2B), DFF, DFF, DFF / 2, (size_t)DFF, (size_t)DFF}; GridOrder S{32, 4, 2, G, (int)blockIdx.x, 0}; EpiPart E{(bf16_t*)(ws + WS_PART)};
      gemm_phase(lds, g, S, E); }
    }
    xcd_barrier(gbar);
    if (PH(13)) {
    phase_norm<4>(a, G);
    }
}

extern "C" void kernel_launch(void* const* d_in, const int* in_sizes, int n_in, void* d_out, int out_size, void* d_ws, size_t ws_size, hipStream_t stream) {
    static int grid = 0;
    if (grid == 0) {
        int dev = 0, cus = 0, per_cu = 0;
        if (n_in != 27 || ws_size < WS_END) { fprintf(stderr, "kernel_launch: unexpected n_in %d / ws_size %zu\n", n_in, ws_size); grid = -1; return; }
        hipGetDevice(&dev);
        hipDeviceGetAttribute(&cus, hipDeviceAttributeMultiprocessorCount, dev);
        if (hipFuncSetAttribute((const void*)fwd_megakernel, hipFuncAttributeMaxDynamicSharedMemorySize, LDS_BYTES) != hipSuccess) { fprintf(stderr, "kernel_launch: hipFuncSetAttribute failed\n"); grid = -1; return; }
        if (hipOccupancyMaxActiveBlocksPerMultiprocessor(&per_cu, (const void*)fwd_megakernel, NTHR, LDS_BYTES) != hipSuccess || per_cu < 1) { fprintf(stderr, "kernel_launch: occupancy query says %d blocks/CU\n", per_cu); grid = -1; return; }
        grid = cus;
    }
    if (grid < 0) return;
    if (hipMemsetAsync((char*)d_ws + WS_BAR, 0, 16384, stream) != hipSuccess) { fprintf(stderr, "kernel_launch: memset of barrier words failed\n"); return; }
    Args a{};
    for (int i = 0; i < 27; ++i) a.in[i] = (const float*)d_in[i];
    a.out = (float*)d_out; a.ws = (unsigned char*)d_ws;
    void* args[] = {&a};
    hipError_t e = hipLaunchCooperativeKernel((const void*)fwd_megakernel, dim3(grid), dim3(NTHR), args, LDS_BYTES, stream);
    if (e != hipSuccess) fprintf(stderr, "cooperative launch failed: %s (grid %d)\n", hipGetErrorString(e), grid);
}
```

```cpp
#include <hip/hip_runtime.h>
#include <hip/hip_cooperative_groups.h>
#include <cstdio>
#include <cstdint>
namespace cg = cooperative_groups;

#define LAS __attribute__((address_space(3)))
typedef unsigned short bf16_t;
typedef short bf16x8 __attribute__((ext_vector_type(8)));
typedef float f32x4 __attribute__((ext_vector_type(4)));
typedef float f32x2 __attribute__((ext_vector_type(2)));
typedef unsigned u32x4 __attribute__((ext_vector_type(4)));
typedef unsigned u32x2 __attribute__((ext_vector_type(2)));

constexpr int D = 1024, NTOK = 8192, NCTX = 4096, DFF = 2816;
constexpr int DIN = 5280, DIN_P = 5376;
constexpr float EPS = 1e-6f;
constexpr int NTHR = 512;
constexpr int LDS_BYTES = 147456;
constexpr int LDS_X = 131072;

constexpr size_t OY = 0, OCKV = 8388608, OKR = 9437184, OST = 9568256;

constexpr size_t MiB = 1u << 20;
constexpr size_t WS_MOD = 0;
constexpr size_t WS_LB = 512 * 1024;
constexpr size_t WS_RQ = 640 * 1024;
constexpr size_t WS_RKV = 704 * 1024;
constexpr size_t WS_BAR = 768 * 1024;
constexpr size_t WS_SLOC = 1 * MiB;
constexpr size_t WS_GDEC = 5 * MiB;
constexpr size_t WS_W1A = 6 * MiB;
constexpr size_t WS_W1B = 17 * MiB;
constexpr size_t WS_W2A = 23 * MiB;
constexpr size_t WS_W2B = 34 * MiB;
constexpr size_t WS_WIN = 40 * MiB;
constexpr size_t WS_WQB = 51 * MiB;
constexpr size_t WS_WKVB = 52 * MiB;
constexpr size_t WS_WUP = 53 * MiB;
constexpr size_t WS_WOUT = 55 * MiB;
constexpr size_t WS_XN = 57 * MiB;
constexpr size_t WS_OFW = 61 * MiB;
constexpr size_t WS_OBW = 153 * MiB;
constexpr size_t WS_SENT = 57 * MiB;
constexpr size_t WS_X = 73 * MiB;
constexpr size_t WS_PART = 105 * MiB;
constexpr size_t WS_HFF = 169 * MiB;
constexpr size_t WS_GATE = 105 * MiB;
constexpr size_t WS_O = 137 * MiB;
constexpr size_t WS_T = 169 * MiB;
constexpr size_t WS_QC = 153 * MiB;
constexpr size_t WS_KVC = 159 * MiB;
constexpr size_t WS_FF = 165 * MiB;
constexpr size_t WS_FB = 181 * MiB;
constexpr size_t WS_HQ = 197 * MiB;
constexpr size_t WS_HV = 205 * MiB;
constexpr size_t WS_HG = 213 * MiB;
constexpr size_t WS_Q = 221 * MiB;
constexpr size_t WS_KN = 233 * MiB;
constexpr size_t WS_VT = 242 * MiB;
constexpr size_t WS_KRP = 251 * MiB;
constexpr size_t WS_END = 252 * MiB;

typedef __bf16 nbf16x2 __attribute__((ext_vector_type(2)));
__device__ __forceinline__ unsigned pk2(float lo, float hi) { f32x2 v = {lo, hi}; return __builtin_bit_cast(unsigned, __builtin_convertvector(v, nbf16x2)); }
__device__ __forceinline__ float bflo(unsigned w) { return __uint_as_float(w << 16); }
__device__ __forceinline__ float bfhi(unsigned w) { return __uint_as_float(w & 0xffff0000u); }
__device__ __forceinline__ float sigmf(float x) { return __builtin_amdgcn_rcpf(1.f + __builtin_amdgcn_exp2f(-1.4426950408889634f * x)); }
__device__ __forceinline__ float siluf(float x) { return x * sigmf(x); }
__device__ __forceinline__ float wave_sum(float v) {
#pragma unroll
    for (int o = 1; o < 64; o <<= 1) v += __shfl_xor(v, o);
    return v;
}
__device__ __forceinline__ f32x4 rope4(f32x4 x, float pos, int fq) {
    f32x4 p, o;
#pragma unroll
    for (int j = 0; j < 4; ++j) p[j] = __shfl_xor(x[j], 32);
    const bool lo = fq < 2;
    const bool hi4 = (fq & 1) != 0;
    const float inv0 = hi4 ? 0.01f : 1.0f, inv1 = hi4 ? 0.0031622776601683794f : 0.31622776601683794f,
                inv2 = hi4 ? 0.001f : 0.1f, inv3 = hi4 ? 0.00031622776601683794f : 0.031622776601683794f;
    const float iv[4] = {inv0, inv1, inv2, inv3};
#pragma unroll
    for (int j = 0; j < 4; ++j) {
        float rev = pos * iv[j] * 0.15915494309189535f;
        rev -= rintf(rev);
        const float s = __builtin_amdgcn_sinf(rev), c = __builtin_amdgcn_cosf(rev);
        o[j] = lo ? (x[j] * c - p[j] * s) : (x[j] * c + p[j] * s);
    }
    return o;
}

namespace pg8 {
constexpr int BM = 256, BK = 64, HALF = 128, HTB = HALF * BK * 2, STAGE_BYTES = 8 * HTB, NXCD = 8, WGM = 8;
__device__ __forceinline__ int lds_byte(int r, int c) { const int st = (r >> 4) * 2 + (c >> 5), rr = r & 15, cc = c & 31, ob = rr * 64 + cc * 2; return st * 1024 + (ob ^ (((ob >> 9) & 1) << 5)); }
__device__ __forceinline__ void stage_rc(int b, int& R, int& C) { const int st = b / 1024, sb = b % 1024, swz = sb ^ (((sb >> 9) & 1) << 5); R = (st >> 1) * 16 + swz / 64; C = (st & 1) * 32 + (swz % 64) / 2; }

struct Unit { int pm, pn, z; };
struct Gemm { const bf16_t* A; const bf16_t* Bt; int lda, ldb, K; size_t zA, zB; };

__device__ __forceinline__ void order_unit(int L, int nM, int nN, Unit& u) {
    const int nwg = nM * nN;
    u.z = L / nwg; int wgid = L - u.z * nwg;
    { const int q = nwg / NXCD, r = nwg % NXCD, xcd = wgid % NXCD, off = wgid / NXCD; wgid = (xcd < r ? xcd * (q + 1) : r * (q + 1) + (xcd - r) * q) + off; }
    const int nig = WGM * nN, gid = wgid / nig, fm = gid * WGM, gsz = (nM - fm) < WGM ? (nM - fm) : WGM;
    u.pm = fm + ((wgid % nig) % gsz); u.pn = (wgid % nig) / gsz;
}
struct GridOrder {
    int nM, nN, nZ, G, c, zpm;
    __device__ __forceinline__ bool next(int i, Unit& u) const {
        const int L = i * G + c; if (L >= nM * nN * nZ) return false;
        order_unit(L, nM, nN, u); if (zpm > 0) u.z = u.pm >= zpm ? 1 : 0; return true;
    }
};
struct SingleOrder {
    Unit u0;
    __device__ __forceinline__ bool next(int i, Unit& u) const { if (i != 0) return false; u = u0; return true; }
};

template <class Epi, class Sched>
__device__ __forceinline__ void gemm_phase(LAS unsigned char* lds, const Gemm g, const Sched& S, const Epi& E) {
    const int tid = threadIdx.x, wid = __builtin_amdgcn_readfirstlane(tid >> 6), lane = tid & 63, wr = wid >> 2, wc = wid & 3, fr = lane & 15, fq = lane >> 4;
    int K_ = g.K; asm volatile("" : "+s"(K_));
    const int nt = K_ / BK;
    unsigned voffA[2], voffB[2];
#pragma unroll
    for (int i = 0; i < 2; ++i) { int R, C; stage_rc(tid * 16 + i * 8192, R, C);
        voffA[i] = (unsigned)(R * g.lda + C) * 2u; voffB[i] = (unsigned)(R * g.ldb + C) * 2u; }
    const size_t kstep = (size_t)(BK * 2);
    const size_t hstepA = (size_t)HALF * g.lda * 2, hstepB = (size_t)HALF * g.ldb * 2;
    const size_t tstepA = 2 * hstepA, tstepB = 2 * hstepB;
    const unsigned ldsw = (unsigned)wid * 1024u;
    const int aoff = lds_byte(wr * 64 + fr, fq * 8), boff = lds_byte(wc * 32 + fr, fq * 8);
#define PG8_SA(b, h) (((b) * 2 + (h)) * HTB)
#define PG8_SB(b, h) ((4 + (b) * 2 + (h)) * HTB)
#define PG8_STAGE(bufoff, gbase, voff) do { _Pragma("unroll") for (int _i = 0; _i < 2; ++_i) \
        __builtin_amdgcn_global_load_lds((const unsigned*)((const char*)(gbase) + (voff)[_i]), (LAS unsigned*)(lds + (bufoff) + ldsw + _i * 8192), 16, 0, 0); } while (0)
#define PG8_LDA(dst, b, h) do { _Pragma("unroll") for (int m = 0; m < 4; ++m) _Pragma("unroll") for (int k = 0; k < 2; ++k) dst[m][k] = *(const LAS bf16x8*)(lds + PG8_SA(b, h) + aoff + m * 2048 + k * 1024); } while (0)
#define PG8_LDB(dst, b, h) do { _Pragma("unroll") for (int n = 0; n < 2; ++n) _Pragma("unroll") for (int k = 0; k < 2; ++k) dst[n][k] = *(const LAS bf16x8*)(lds + PG8_SB(b, h) + boff + n * 2048 + k * 1024); } while (0)
#define PG8_MMA(ai, bj, At, Bt) do { __builtin_amdgcn_s_setprio(1); _Pragma("unroll") for (int m = 0; m < 4; ++m) _Pragma("unroll") for (int n = 0; n < 2; ++n) _Pragma("unroll") for (int k = 0; k < 2; ++k) \
        acc[ai][bj][m][n] = __builtin_amdgcn_mfma_f32_16x16x32_bf16(Bt[n][k], At[m][k], acc[ai][bj][m][n], 0, 0, 0); __builtin_amdgcn_s_setprio(0); } while (0)
#define PG8_WAIT_V(n) asm volatile("s_waitcnt vmcnt(" #n ")" ::: "memory")
#define PG8_WAIT_L(n) asm volatile("s_waitcnt lgkmcnt(" #n ")" ::: "memory")
#define PG8_BAR __builtin_amdgcn_s_barrier()
#define PG8_SCHED __builtin_amdgcn_sched_barrier(0)
    Unit cur, nxt; int ui = 0;
    if (!S.next(0, cur)) return;
    f32x4 acc[2][2][4][2];
#pragma unroll
    for (int a = 0; a < 2; ++a)
#pragma unroll
        for (int b = 0; b < 2; ++b)
#pragma unroll
            for (int m = 0; m < 4; ++m)
#pragma unroll
                for (int n = 0; n < 2; ++n) acc[a][b][m][n] = (f32x4){0.f, 0.f, 0.f, 0.f};
    bf16x8 At[4][2], B0[2][2], B1[2][2];
    const char* cA = (const char*)g.A + (size_t)cur.z * g.zA + (size_t)cur.pm * tstepA;
    const char* cB = (const char*)g.Bt + (size_t)cur.z * g.zB + (size_t)cur.pn * tstepB;
    PG8_STAGE(PG8_SB(0, 0), cB, voffB); PG8_STAGE(PG8_SA(0, 0), cA, voffA); PG8_STAGE(PG8_SB(0, 1), cB + hstepB, voffB); PG8_STAGE(PG8_SA(0, 1), cA + hstepA, voffA);
    if (wr == 1) PG8_BAR;
    PG8_WAIT_V(4); PG8_BAR;
    PG8_STAGE(PG8_SB(1, 0), cB + kstep, voffB); PG8_STAGE(PG8_SA(1, 0), cA + kstep, voffA); PG8_STAGE(PG8_SB(1, 1), cB + hstepB + kstep, voffB);
    PG8_WAIT_V(6); PG8_BAR;
    for (;;) {
        const bool has_next = S.next(ui + 1, nxt);
        const char* nA = has_next ? (const char*)g.A + (size_t)nxt.z * g.zA + (size_t)nxt.pm * tstepA : cA;
        const char* nB = has_next ? (const char*)g.Bt + (size_t)nxt.z * g.zB + (size_t)nxt.pn * tstepB : cB;
        for (int t = 0; t < nt; t += 2) {
            const bool last = (t == nt - 2);
            const char* a1 = cA + (size_t)(t + 1) * kstep;
            const char* a2 = last ? nA : cA + (size_t)(t + 2) * kstep; const char* b2 = last ? nB : cB + (size_t)(t + 2) * kstep;
            const char* a3 = a2 + kstep; const char* b3 = b2 + kstep;
            PG8_LDB(B0, 0, 0); PG8_SCHED; PG8_LDA(At, 0, 0); PG8_STAGE(PG8_SA(1, 1), a1 + hstepA, voffA);
            PG8_WAIT_L(8); PG8_BAR; PG8_WAIT_L(0); PG8_MMA(0, 0, At, B0); PG8_BAR; PG8_SCHED;
            PG8_LDB(B1, 0, 1); PG8_STAGE(PG8_SB(0, 0), b2, voffB);
            PG8_BAR; PG8_WAIT_L(0); PG8_MMA(0, 1, At, B1); PG8_BAR;
            PG8_LDA(At, 0, 1); PG8_STAGE(PG8_SA(0, 0), a2, voffA);
            PG8_BAR; PG8_WAIT_L(0); PG8_MMA(1, 0, At, B0); PG8_BAR; PG8_SCHED;
            PG8_STAGE(PG8_SB(0, 1), b2 + hstepB, voffB);
            PG8_WAIT_V(6); PG8_BAR; PG8_MMA(1, 1, At, B1); PG8_BAR;
            PG8_LDB(B0, 1, 0); PG8_SCHED; PG8_LDA(At, 1, 0); PG8_STAGE(PG8_SA(0, 1), a2 + hstepA, voffA);
            PG8_WAIT_L(8); PG8_BAR; PG8_WAIT_L(0); PG8_MMA(0, 0, At, B0); PG8_BAR; PG8_SCHED;
            PG8_LDB(B1, 1, 1); PG8_STAGE(PG8_SB(1, 0), b3, voffB);
            PG8_BAR; PG8_WAIT_L(0); PG8_MMA(0, 1, At, B1); PG8_BAR;
            PG8_LDA(At, 1, 1); PG8_STAGE(PG8_SA(1, 0), a3, voffA);
            PG8_BAR; PG8_WAIT_L(0); PG8_MMA(1, 0, At, B0); PG8_BAR; PG8_SCHED;
            PG8_STAGE(PG8_SB(1, 1), b3 + hstepB, voffB);
            PG8_WAIT_V(6); PG8_BAR; PG8_MMA(1, 1, At, B1); PG8_BAR;
        }
        if (wr == 0) PG8_BAR;
        E(acc, cur, wr, wc, fr, fq);
        if (!has_next) break;
#pragma unroll
        for (int a = 0; a < 2; ++a)
#pragma unroll
            for (int b = 0; b < 2; ++b)
#pragma unroll
                for (int m = 0; m < 4; ++m)
#pragma unroll
                    for (int n = 0; n < 2; ++n) acc[a][b][m][n] = (f32x4){0.f, 0.f, 0.f, 0.f};
        cur = nxt; cA = nA; cB = nB; ++ui;
        if (wr == 1) PG8_BAR;
    }
    PG8_WAIT_V(0);
    PG8_BAR;
#undef PG8_SA
#undef PG8_SB
#undef PG8_STAGE
#undef PG8_LDA
#undef PG8_LDB
#undef PG8_MMA
#undef PG8_WAIT_V
#undef PG8_WAIT_L
#undef PG8_BAR
#undef PG8_SCHED
}

template <int ACT, bool F32>
__device__ __forceinline__ void tile_store(const f32x4 (&acc)[2][2][4][2], void* dst, int ld, int row0, int col0, const float* lbp) {
    f32x4 lb[2][2];
    if (ACT == 3) {
#pragma unroll
        for (int bj = 0; bj < 2; ++bj)
#pragma unroll
            for (int n = 0; n < 2; ++n) lb[bj][n] = *(const f32x4*)(lbp + bj * HALF + n * 16);
    }
#pragma unroll
    for (int ai = 0; ai < 2; ++ai)
#pragma unroll
        for (int m = 0; m < 4; ++m) {
            const size_t ro = (size_t)(row0 + ai * HALF + m * 16) * ld + col0;
#pragma unroll
            for (int bj = 0; bj < 2; ++bj)
#pragma unroll
                for (int n = 0; n < 2; ++n) {
                    f32x4 v = acc[ai][bj][m][n];
#pragma unroll
                    for (int j = 0; j < 4; ++j) {
                        if (ACT == 1) v[j] = siluf(v[j]);
                        if (ACT == 2) v[j] = sigmf(v[j]);
                        if (ACT == 3) v[j] = lb[bj][n][j] + (1.f - lb[bj][n][j]) * sigmf(v[j]);
                    }
                    if (F32) *(f32x4*)((float*)dst + ro + bj * HALF + n * 16) = v;
                    else { u32x2 w; w.x = pk2(v[0], v[1]); w.y = pk2(v[2], v[3]); *(u32x2*)((bf16_t*)dst + ro + bj * HALF + n * 16) = w; }
                }
            asm volatile("" ::: "memory");
        }
}

struct EpiSwiGLU {
    bf16_t* H;
    __device__ __forceinline__ void operator()(const f32x4 (&acc)[2][2][4][2], const Unit& u_, int wr, int wc, int fr, int fq) const {
        Unit u; u.pm = __builtin_amdgcn_readfirstlane(u_.pm); u.pn = __builtin_amdgcn_readfirstlane(u_.pn); u.z = __builtin_amdgcn_readfirstlane(u_.z); asm volatile("" : "+v"(fr), "+v"(fq), "+s"(u.pm), "+s"(u.pn), "+s"(u.z));
        const int row0 = u.pm * BM + wr * 64 + fr;
#pragma unroll
        for (int ai = 0; ai < 2; ++ai)
#pragma unroll
            for (int m = 0; m < 4; ++m) {
                bf16_t* rp = H + (size_t)(row0 + ai * HALF + m * 16) * DFF + 4 * fq;
#pragma unroll
                for (int bj = 0; bj < 2; ++bj) {
                    const int g = 8 * u.pn + 4 * bj + wc;
                    const f32x4 a = acc[ai][bj][m][0], b = acc[ai][bj][m][1];
                    u32x2 w; w.x = pk2(siluf(a[0]) * b[0], siluf(a[1]) * b[1]); w.y = pk2(siluf(a[2]) * b[2], siluf(a[3]) * b[3]);
                    *(u32x2*)(rp + 16 * g) = w;
                }
                asm volatile("" ::: "memory");
            }
    }
};
struct EpiPart {
    bf16_t* P;
    __device__ __forceinline__ void operator()(const f32x4 (&acc)[2][2][4][2], const Unit& u_, int wr, int wc, int fr, int fq) const {
        Unit u; u.pm = __builtin_amdgcn_readfirstlane(u_.pm); u.pn = __builtin_amdgcn_readfirstlane(u_.pn); u.z = __builtin_amdgcn_readfirstlane(u_.z); asm volatile("" : "+v"(fr), "+v"(fq), "+s"(u.pm), "+s"(u.pn), "+s"(u.z));
        tile_store<0, false>(acc, P + (size_t)u.z * NTOK * D, D, u.pm * BM + wr * 64 + fr, u.pn * BM + wc * 32 + 4 * fq, nullptr);
    }
};
struct EpiUp {
    bf16_t* T; const bf16_t* GATE;
    __device__ __forceinline__ void operator()(const f32x4 (&acc)[2][2][4][2], const Unit& u_, int wr, int wc, int fr, int fq) const {
        Unit u; u.pm = __builtin_amdgcn_readfirstlane(u_.pm); u.pn = __builtin_amdgcn_readfirstlane(u_.pn); u.z = __builtin_amdgcn_readfirstlane(u_.z); asm volatile("" : "+v"(fr), "+v"(fq), "+s"(u.pm), "+s"(u.pn), "+s"(u.z));
        const int row0 = u.pm * BM + wr * 64 + fr, col0 = u.pn * BM + wc * 32 + 4 * fq;
        const size_t zo = (size_t)u.z * NTOK * D;
#pragma unroll
        for (int ai = 0; ai < 2; ++ai)
#pragma unroll
            for (int m = 0; m < 4; ++m) {
                const size_t ro = zo + (size_t)(row0 + ai * HALF + m * 16) * D + col0;
#pragma unroll
                for (int bj = 0; bj < 2; ++bj)
#pragma unroll
                    for (int n = 0; n < 2; ++n) {
                        const u32x2 gw = *(const u32x2*)(GATE + ro + bj * HALF + n * 16);
                        const f32x4 v = acc[ai][bj][m][n];
                        u32x2 w; w.x = pk2(v[0] * bflo(gw.x), v[1] * bfhi(gw.x)); w.y = pk2(v[2] * bflo(gw.y), v[3] * bfhi(gw.y));
                        *(u32x2*)(T + ro + bj * HALF + n * 16) = w;
                    }
                asm volatile("" ::: "memory");
            }
    }
};
struct EpiIn {
    bf16_t *QC, *KVC, *HQ, *HV, *HG, *GATE, *KRP; float *FF, *FB, *KRO; const float* LB;
    __device__ __forceinline__ void operator()(const f32x4 (&acc)[2][2][4][2], const Unit& u_, int wr, int wc, int fr, int fq) const {
        Unit u; u.pm = __builtin_amdgcn_readfirstlane(u_.pm); u.pn = __builtin_amdgcn_readfirstlane(u_.pn); u.z = __builtin_amdgcn_readfirstlane(u_.z); asm volatile("" : "+v"(fr), "+v"(fq), "+s"(u.pm), "+s"(u.pn), "+s"(u.z));
        const int pn = u.pn, row0 = u.pm * BM + wr * 64 + fr, cw = wc * 32 + 4 * fq;
        if (pn == 0) { tile_store<0, false>(acc, QC, 384, row0, cw, nullptr); }
        else if (pn == 2) { tile_store<0, false>(acc, KVC, 256, row0, cw, nullptr); }
        else if (pn == 1) {
#pragma unroll
            for (int ai = 0; ai < 2; ++ai)
#pragma unroll
                for (int m = 0; m < 4; ++m) {
                    const int row = row0 + ai * HALF + m * 16;
#pragma unroll
                    for (int n = 0; n < 2; ++n) { const f32x4 v = acc[ai][0][m][n]; u32x2 w; w.x = pk2(v[0], v[1]); w.y = pk2(v[2], v[3]);
                        *(u32x2*)(QC + (size_t)row * 384 + 256 + cw + n * 16) = w; }
                    if (wc == 0) {
                        f32x4 v0 = acc[ai][1][m][0], v1 = acc[ai][1][m][1];
                        int kidx;
                        if (u.pm >= 16) { const int t = (row - NCTX) & 2047; v0 = rope4(v0, (float)(t >> 6), fq); v1 = rope4(v1, (float)(t & 63), fq);
                            kidx = NCTX + ((row - NCTX) >> 11) * 2304 + 256 + t; }
                        else { kidx = row; *(f32x4*)(KRO + (size_t)row * 32 + 4 * fq) = v0; *(f32x4*)(KRO + (size_t)row * 32 + 16 + 4 * fq) = v1; }
                        u32x2 w; w.x = pk2(v0[0], v0[1]); w.y = pk2(v0[2], v0[3]); *(u32x2*)(KRP + (size_t)kidx * 32 + 4 * fq) = w;
                        w.x = pk2(v1[0], v1[1]); w.y = pk2(v1[2], v1[3]); *(u32x2*)(KRP + (size_t)kidx * 32 + 16 + 4 * fq) = w;
                    }
                    asm volatile("" ::: "memory");
                }
        }
        else if (pn <= 12) {
            const int seg = (pn - 3) >> 1, c0 = ((pn - 3) & 1) * 256 + cw;
            if (seg == 0) tile_store<1, false>(acc, HQ, 512, row0, c0, nullptr);
            else if (seg == 1) tile_store<3, true>(acc, FF, 512, row0, c0, LB + c0);
            else if (seg == 2) tile_store<3, true>(acc, FB, 512, row0, c0, LB + 512 + c0);
            else if (seg == 3) tile_store<0, false>(acc, HV, 512, row0, c0, nullptr);
            else tile_store<1, false>(acc, HG, 512, row0, c0, nullptr);
        }
        else { const int z = (pn - 13) >> 2, c0 = ((pn - 13) & 3) * 256 + cw;
            tile_store<2, false>(acc, GATE + (size_t)z * NTOK * D, D, row0, c0, nullptr); }
    }
};
struct EpiQ {
    bf16_t* Q; const float* rinv;
    __device__ __forceinline__ void operator()(const f32x4 (&acc)[2][2][4][2], const Unit& u_, int wr, int wc, int fr, int fq) const {
        Unit u; u.pm = __builtin_amdgcn_readfirstlane(u_.pm); u.pn = __builtin_amdgcn_readfirstlane(u_.pn); u.z = __builtin_amdgcn_readfirstlane(u_.z); asm volatile("" : "+v"(fr), "+v"(fq), "+s"(u.pm), "+s"(u.pn), "+s"(u.z));
#pragma unroll
        for (int ai = 0; ai < 2; ++ai)
#pragma unroll
            for (int m = 0; m < 4; ++m) {
                const int rl = ai * HALF + wr * 64 + m * 16 + fr, row = u.pm * BM + rl;
                const float ri = rinv[row];
#pragma unroll
                for (int bj = 0; bj < 2; ++bj) {
                    const int g32 = 8 * u.pn + 4 * bj + wc;
                    const f32x4 v0 = acc[ai][bj][m][0] * ri, v1 = acc[ai][bj][m][1] * ri;
                    bf16_t* p = Q + (size_t)row * 768 + g32 * 32 + 4 * fq;
                    u32x2 w; w.x = pk2(v0[0], v0[1]); w.y = pk2(v0[2], v0[3]); *(u32x2*)p = w;
                    w.x = pk2(v1[0], v1[1]); w.y = pk2(v1[2], v1[3]); *(u32x2*)(p + 16) = w;
                }
                asm volatile("" ::: "memory");
            }
    }
};
struct EpiKV {
    bf16_t *KN, *VT; const float* rinv;
    __device__ __forceinline__ void operator()(const f32x4 (&acc)[2][2][4][2], const Unit& u_, int wr, int wc, int fr, int fq) const {
        Unit u; u.pm = __builtin_amdgcn_readfirstlane(u_.pm); u.pn = __builtin_amdgcn_readfirstlane(u_.pn); u.z = 0; asm volatile("" : "+v"(fr), "+v"(fq), "+s"(u.pm), "+s"(u.pn));
        const int pm = u.pm;
        int ab, kidx0;
        if (pm < 16) { ab = pm; kidx0 = pm * 256; }
        else if (pm < 32) { ab = 16 + ((pm - 16) >> 3); kidx0 = NCTX + (ab - 16) * 2304 + 256 + ((pm - 16) & 7) * 256; }
        else { ab = 16 + (pm - 32); kidx0 = NCTX + (ab - 16) * 2304; }
        const int Tk = ab < 16 ? 256 : 2304;
        const int j0 = kidx0 - (ab < 16 ? ab * 256 : NCTX + (ab - 16) * 2304);
#pragma unroll
        for (int bj = 0; bj < 2; ++bj) {
            const int h = 2 * u.pn + bj;
            if (wc < 2) {
                bf16_t* base = KN + (size_t)kidx0 * 512 + h * 64 + wc * 32 + 4 * fq;
#pragma unroll
                for (int ai = 0; ai < 2; ++ai)
#pragma unroll
                    for (int m = 0; m < 4; ++m) {
                        const int rl = ai * HALF + wr * 64 + m * 16 + fr;
                        const float ri = rinv[pm * BM + rl];
#pragma unroll
                        for (int n = 0; n < 2; ++n) {
                            const f32x4 v = acc[ai][bj][m][n] * ri;
                            u32x2 w; w.x = pk2(v[0], v[1]); w.y = pk2(v[2], v[3]);
                            *(u32x2*)(base + (size_t)rl * 512 + n * 16) = w;
                        }
                        asm volatile("" ::: "memory");
                    }
            } else {
                const size_t vb = ab < 16 ? (size_t)(ab * 8 + h) * 64 * 256 : (size_t)16 * 8 * 64 * 256 + (size_t)((ab - 16) * 8 + h) * 64 * 2304;
                bf16_t* base = VT + vb + (size_t)((wc - 2) * 32 + 4 * fq) * Tk + j0;
#pragma unroll
                for (int ai = 0; ai < 2; ++ai)
#pragma unroll
                    for (int m = 0; m < 4; ++m) {
                        const int rl = ai * HALF + wr * 64 + m * 16 + fr;
                        const float ri = rinv[pm * BM + rl];
#pragma unroll
                        for (int n = 0; n < 2; ++n) {
                            const f32x4 v = acc[ai][bj][m][n] * ri;
                            const unsigned w0 = pk2(v[0], v[1]), w1 = pk2(v[2], v[3]);
                            bf16_t* vp = base + (size_t)(n * 16) * Tk + rl;
                            vp[0] = (bf16_t)(w0 & 0xffffu); vp[Tk] = (bf16_t)(w0 >> 16); vp[2 * Tk] = (bf16_t)(w1 & 0xffffu); vp[3 * Tk] = (bf16_t)(w1 >> 16);
                        }
                        asm volatile("" ::: "memory");
                    }
            }
        }
    }
};
}

struct Args { const float* in[27]; float* out; unsigned char* ws; };
enum { I_XP = 0, I_XS, I_CCKV, I_CKR, I_ST, I_C, I_CCTX, I_WADA, I_BADA, I_NORMG, I_F1W1, I_F1W3, I_F1W2, I_F2W1, I_F2W3, I_F2W2, I_WIN, I_QNG, I_WQB, I_KVNG, I_WKVB,
       I_WUPA, I_HGGAMMA, I_HGNG, I_WUPR, I_WOUT, I_FING };

__device__ __forceinline__ int map_row(int mode, int n) {
    if (mode == 1) return 32 * (n >> 4) + (n & 15);
    if (mode == 2) return 32 * (n >> 4) + 16 + (n & 15);
    if (mode == 3) return n < 384 ? n : (n < 640 ? n + 128 : (n < 672 ? n - 256 : n + 96));
    return n;
}
__device__ __forceinline__ void tr_item(const float* W, int K, int N, bf16_t* WT, int mode, const float* ksc, LAS float* scr, int item, int lane) {
    const int nblk = N / 32, kb = item / nblk, nb = item % nblk, k0 = 64 * kb, n0 = 32 * nb;
    float tv[32];
#pragma unroll
    for (int i = 0; i < 32; ++i) { const int kk = 2 * i + (lane >> 5); tv[i] = W[(size_t)(k0 + kk) * N + n0 + (lane & 31)]; }
#pragma unroll
    for (int i = 0; i < 32; ++i) { const int kk = 2 * i + (lane >> 5); float v = tv[i]; if (ksc) v *= ksc[k0 + kk]; scr[kk * 33 + (lane & 31)] = v; }
    asm volatile("s_waitcnt lgkmcnt(0)" ::: "memory");
    const int c = lane & 7;
#pragma unroll
    for (int j = 0; j < 4; ++j) { const int n = (lane >> 3) + 8 * j; const LAS float* s = scr + (8 * c) * 33 + n;
        u32x4 o; o.x = pk2(s[0 * 33], s[1 * 33]); o.y = pk2(s[2 * 33], s[3 * 33]); o.z = pk2(s[4 * 33], s[5 * 33]); o.w = pk2(s[6 * 33], s[7 * 33]);
        *(u32x4*)(WT + (size_t)map_row(mode, n0 + n) * K + k0 + 8 * c) = o; }
    asm volatile("s_waitcnt lgkmcnt(0)" ::: "memory");
}

constexpr int TRI_F = 1408, TRI_IN = 2640, TRI_QB = 144, TRI_KVB = 128, TRI_UP = 256, TRI_OUT = 512;
constexpr int TR_A0 = 0, TR_A1 = 2 * TRI_F;
constexpr int TR_B0 = TR_A1, TR_B1 = TR_B0 + TRI_F + TRI_IN;
constexpr int TR_C0 = TR_B1, TR_C1 = TR_C0 + 3 * TRI_F + TRI_QB + 2 * TRI_KVB + 2 * TRI_UP + TRI_OUT;
__device__ __forceinline__ void tr_range(const Args& a, LAS unsigned char* lds, int lo, int hi, int gw, int nw) {
    const int lane = threadIdx.x & 63, wave = threadIdx.x >> 6;
    unsigned char* ws = a.ws;
    LAS float* scr = (LAS float*)(lds + wave * 8448);
    for (int it = lo + gw; it < hi; it += nw) {
        int r = it;
        if (r < TRI_F) { tr_item(a.in[I_F1W1], 1024, DFF, (bf16_t*)(ws + WS_W1A), 1, nullptr, scr, r, lane); continue; } r -= TRI_F;
        if (r < TRI_F) { tr_item(a.in[I_F1W3], 1024, DFF, (bf16_t*)(ws + WS_W1A), 2, nullptr, scr, r, lane); continue; } r -= TRI_F;
        if (r < TRI_F) { tr_item(a.in[I_F1W2], DFF, 1024, (bf16_t*)(ws + WS_W1B), 0, nullptr, scr, r, lane); continue; } r -= TRI_F;
        if (r < TRI_IN) { tr_item(a.in[I_WIN], 1024, DIN, (bf16_t*)(ws + WS_WIN), 3, nullptr, scr, r, lane); continue; } r -= TRI_IN;
        if (r < TRI_F) { tr_item(a.in[I_F2W1], 1024, DFF, (bf16_t*)(ws + WS_W2A), 1, nullptr, scr, r, lane); continue; } r -= TRI_F;
        if (r < TRI_F) { tr_item(a.in[I_F2W3], 1024, DFF, (bf16_t*)(ws + WS_W2A), 2, nullptr, scr, r, lane); continue; } r -= TRI_F;
        if (r < TRI_F) { tr_item(a.in[I_F2W2], DFF, 1024, (bf16_t*)(ws + WS_W2B), 0, nullptr, scr, r, lane); continue; } r -= TRI_F;
        if (r < TRI_QB) { tr_item(a.in[I_WQB], 384, 768, (bf16_t*)(ws + WS_WQB), 0, a.in[I_QNG], scr, r, lane); continue; } r -= TRI_QB;
        if (r < TRI_KVB) { tr_item(a.in[I_WKVB], 256, 1024, (bf16_t*)(ws + WS_WKVB), 0, a.in[I_KVNG], scr, r, lane); continue; } r -= TRI_KVB;
        if (r < TRI_KVB) { tr_item(a.in[I_WKVB], 256, 1024, (bf16_t*)(ws + WS_WKVB) + 1024 * 256, 0, nullptr, scr, r, lane); continue; } r -= TRI_KVB;
        if (r < TRI_UP) { tr_item(a.in[I_WUPA], 512, 1024, (bf16_t*)(ws + WS_WUP), 0, nullptr, scr, r, lane); continue; } r -= TRI_UP;
        if (r < TRI_UP) { tr_item(a.in[I_WUPR], 512, 1024, (bf16_t*)(ws + WS_WUP) + 1024 * 512, 0, nullptr, scr, r, lane); continue; } r -= TRI_UP;
        tr_item(a.in[I_WOUT], 1024, 1024, (bf16_t*)(ws + WS_WOUT), 0, nullptr, scr, r, lane);
    }
}
__device__ __forceinline__ void tr_in_tail(const Args& a, LAS unsigned char* lds, int nunits, int lo, int hi, int G) {
    const int r = nunits % G, wave = threadIdx.x >> 6;
    if (r == 0) tr_range(a, lds, lo, hi, (int)blockIdx.x * 8 + wave, G * 8);
    else if ((int)blockIdx.x >= r) tr_range(a, lds, lo, hi, ((int)blockIdx.x - r) * 8 + wave, (G - r) * 8);
}

__device__ __forceinline__ void phase_prep(const Args& a, LAS unsigned char* lds, int G) {
    const int tid = threadIdx.x, lane = tid & 63, wave = tid >> 6;
    unsigned char* ws = a.ws;
    for (int nb = blockIdx.x; nb < 72; nb += G) {
        LAS float* sc = (LAS float*)lds;
        for (int i = tid; i < 3072; i += NTHR) { const int s = i >> 10, k = i & 1023; const float v = (s == 0) ? a.in[I_CCTX][k] : a.in[I_C][(s - 1) * 1024 + k]; sc[i] = siluf(v); }
        __syncthreads();
        const float* wp = a.in[I_WADA] + (size_t)(wave * 128) * 9216 + nb * 128 + 2 * lane;
        float a00 = 0.f, a01 = 0.f, a10 = 0.f, a11 = 0.f, a20 = 0.f, a21 = 0.f;
#pragma unroll 32
        for (int kk = 0; kk < 128; ++kk) {
            const f32x2 w = *(const f32x2*)(wp + (size_t)kk * 9216);
            const float s0 = sc[wave * 128 + kk], s1 = sc[1024 + wave * 128 + kk], s2 = sc[2048 + wave * 128 + kk];
            a00 += s0 * w.x; a01 += s0 * w.y; a10 += s1 * w.x; a11 += s1 * w.y; a20 += s2 * w.x; a21 += s2 * w.y;
        }
        LAS float* red = sc + 3072;
        red[(wave * 3 + 0) * 128 + 2 * lane] = a00; red[(wave * 3 + 0) * 128 + 2 * lane + 1] = a01;
        red[(wave * 3 + 1) * 128 + 2 * lane] = a10; red[(wave * 3 + 1) * 128 + 2 * lane + 1] = a11;
        red[(wave * 3 + 2) * 128 + 2 * lane] = a20; red[(wave * 3 + 2) * 128 + 2 * lane + 1] = a21;
        __syncthreads();
        for (int i = tid; i < 384; i += NTHR) { const int s = i >> 7, col = i & 127; float v = a.in[I_BADA][nb * 128 + col];
#pragma unroll
            for (int w = 0; w < 8; ++w) v += red[(w * 3 + s) * 128 + col];
            ((float*)(ws + WS_MOD))[s * 9216 + nb * 128 + col] = v; }
        __syncthreads();
    }
    {
        const int nskip = G >= 144 ? 72 : 0;
        const int gw = ((int)blockIdx.x - nskip) * 8 + wave;
        if (gw >= 0) tr_range(a, lds, TR_A0, TR_A1, gw, (G - nskip) * 8);
    }
    {
        const int gt = blockIdx.x * NTHR + tid, NT = G * NTHR;
        for (int i = gt; i < 1024; i += NT) { const int dir = i >> 9, n = i & 511; const float g0 = a.in[I_HGGAMMA][dir * 1024 + n], g1 = a.in[I_HGGAMMA][dir * 1024 + 512 + n];
            ((float*)(ws + WS_LB))[i] = 1.f / (1.f + __expf(g1 - g0)); }
        for (int i = gt; i < 96 * 1024 / 2; i += NT) ((unsigned*)(ws + WS_WIN) + (size_t)416 * 1024 / 2)[i] = 0u;
        for (int i = gt; i < 512 * 32 / 2; i += NT) { const int e = 2 * i, r = e >> 5, cc = e & 31, b = r >> 8, j = r & 255; const f32x2 v = *(const f32x2*)(a.in[I_CKR] + e);
            *(unsigned*)((bf16_t*)(ws + WS_KRP) + (size_t)(NCTX + b * 2304 + j) * 32 + cc) = pk2(v.x, v.y); }
    }
}

template <int MODE>
__device__ __forceinline__ void phase_norm(const Args& a, int G) {
    const int tid = threadIdx.x, lane = tid & 63, wave = tid >> 6;
    unsigned char* ws = a.ws;
    const float* MOD = (const float*)(ws + WS_MOD);
    bf16_t* X = (bf16_t*)(ws + WS_X);
    const bf16_t* P0 = (const bf16_t*)(ws + WS_PART); const bf16_t* P1 = P0 + (size_t)NTOK * D;
    bf16_t* XN = (bf16_t*)(ws + WS_XN);
    constexpr int GI = MODE == 2 ? 2 : (MODE == 3 ? 5 : 8);
    constexpr float GS = MODE == 3 ? 1.0f : 0.5f;
    constexpr int SH = MODE == 1 ? 0 : (MODE == 2 ? 3 : 6), SC = SH + 1;
    for (int rb = blockIdx.x * 8 + wave; rb < NTOK / 4; rb += G * 8) {
        const int row0 = rb * 4;
        const int s = row0 < NCTX ? 0 : 1 + ((row0 - NCTX) >> 11);
        const float* md = MOD + (size_t)s * 9216;
        f32x4 v[4][4]; float ss[4] = {0.f, 0.f, 0.f, 0.f};
        f32x4 gt[4];
        if (MODE != 1) {
#pragma unroll
            for (int j = 0; j < 4; ++j) gt[j] = *(const f32x4*)(md + GI * 1024 + 4 * lane + 256 * j) * GS;
        }
#pragma unroll
        for (int i = 0; i < 4; ++i) {
            const int row = row0 + i;
            const float* xsrc = row < NCTX ? a.in[I_XP] + (size_t)row * D : a.in[I_XS] + (size_t)(row - NCTX) * D;
#pragma unroll
            for (int j = 0; j < 4; ++j) {
                const int c = 4 * lane + 256 * j;
                if (MODE == 1 || MODE == 2) v[i][j] = *(const f32x4*)(xsrc + c);
                else { const u32x2 xw = *(const u32x2*)(X + (size_t)row * D + c); v[i][j].x = bflo(xw.x); v[i][j].y = bfhi(xw.x); v[i][j].z = bflo(xw.y); v[i][j].w = bfhi(xw.y); }
                if (MODE != 1) {
                    const u32x2 q0 = *(const u32x2*)(P0 + (size_t)row * D + c), q1 = *(const u32x2*)(P1 + (size_t)row * D + c);
                    f32x4 ps; ps.x = bflo(q0.x) + bflo(q1.x); ps.y = bfhi(q0.x) + bfhi(q1.x); ps.z = bflo(q0.y) + bflo(q1.y); ps.w = bfhi(q0.y) + bfhi(q1.y);
                    v[i][j] = v[i][j] + gt[j] * ps;
                }
            }
        }
#pragma unroll
        for (int i = 0; i < 4; ++i) {
#pragma unroll
            for (int j = 0; j < 4; ++j) ss[i] += (v[i][j].x * v[i][j].x + v[i][j].y * v[i][j].y) + (v[i][j].z * v[i][j].z + v[i][j].w * v[i][j].w);
        }
#pragma unroll
        for (int o = 1; o < 64; o <<= 1) {
#pragma unroll
            for (int i = 0; i < 4; ++i) ss[i] += __shfl_xor(ss[i], o);
        }
        float rinv[4];
#pragma unroll
        for (int i = 0; i < 4; ++i) rinv[i] = rsqrtf(ss[i] * (1.f / D) + EPS);
#pragma unroll
        for (int j = 0; j < 4; ++j) {
            const int c = 4 * lane + 256 * j;
            if (MODE == 4) {
                const f32x4 g = *(const f32x4*)(a.in[I_FING] + c);
#pragma unroll
                for (int i = 0; i < 4; ++i) *(f32x4*)(a.out + OY + (size_t)(row0 + i) * D + c) = v[i][j] * rinv[i] * g;
            } else {
                const f32x4 g = *(const f32x4*)(a.in[I_NORMG] + (MODE - 1) * 1024 + c), sh = *(const f32x4*)(md + SH * 1024 + c), sc = *(const f32x4*)(md + SC * 1024 + c);
                const f32x4 gs = g * (1.f + sc);
#pragma unroll
                for (int i = 0; i < 4; ++i) {
                    const f32x4 o = v[i][j] * rinv[i] * gs + sh;
                    u32x2 w; w.x = pk2(o.x, o.y); w.y = pk2(o.z, o.w);
                    *(u32x2*)(XN + (size_t)(row0 + i) * D + c) = w;
                    if (MODE == 2 || MODE == 3) { u32x2 xw; xw.x = pk2(v[i][j].x, v[i][j].y); xw.y = pk2(v[i][j].z, v[i][j].w); *(u32x2*)(X + (size_t)(row0 + i) * D + c) = xw; }
                }
            }
        }
    }
}

constexpr int AT_KN = 0, AT_KR = 8192, AT_VT = 12288, AT_STAGE = 20480;
__device__ __forceinline__ void attn_item(LAS unsigned char* lds, const bf16_t* Q, const bf16_t* KN, const bf16_t* KRP, const bf16_t* VT, bf16_t* O, int ab, int h, int qt) {
    const int tid = threadIdx.x, lane = tid & 63, wave = __builtin_amdgcn_readfirstlane(tid >> 6), fr = lane & 15, fq = lane >> 4;
    const int Tk = ab < 16 ? 256 : 2304;
    const int kbase = ab < 16 ? ab * 256 : NCTX + (ab - 16) * 2304;
    const size_t vbase = ab < 16 ? (size_t)(ab * 8 + h) * 64 * 256 : (size_t)16 * 8 * 64 * 256 + (size_t)((ab - 16) * 8 + h) * 64 * 2304;
    const int qrow = (ab < 16 ? ab * 256 : NCTX + (ab - 16) * 2048) + qt * 128 + wave * 16 + fr;
    bf16x8 qf[3];
#pragma unroll
    for (int ks = 0; ks < 3; ++ks) qf[ks] = *(const bf16x8*)(Q + (size_t)qrow * 768 + h * 96 + ks * 32 + fq * 8);
    if (ab >= 16) {
        const int t = qt * 128 + wave * 16 + fr;
        const float pos = fq < 2 ? (float)(t >> 6) : (float)(t & 63);
        const u32x4 w = __builtin_bit_cast(u32x4, qf[2]);
        u32x4 pw; pw.x = __shfl_xor(w.x, 16); pw.y = __shfl_xor(w.y, 16); pw.z = __shfl_xor(w.z, 16); pw.w = __shfl_xor(w.w, 16);
        const float x[8] = {bflo(w.x), bfhi(w.x), bflo(w.y), bfhi(w.y), bflo(w.z), bfhi(w.z), bflo(w.w), bfhi(w.w)};
        const float pp[8] = {bflo(pw.x), bfhi(pw.x), bflo(pw.y), bfhi(pw.y), bflo(pw.z), bfhi(pw.z), bflo(pw.w), bfhi(pw.w)};
        const float iv[8] = {1.0f, 0.31622776601683794f, 0.1f, 0.031622776601683794f, 0.01f, 0.0031622776601683794f, 0.001f, 0.00031622776601683794f};
        float o[8];
#pragma unroll
        for (int i = 0; i < 8; ++i) {
            float rev = pos * iv[i] * 0.15915494309189535f; rev -= rintf(rev);
            const float s = __builtin_amdgcn_sinf(rev), c = __builtin_amdgcn_cosf(rev);
            o[i] = (fq & 1) ? (x[i] * c + pp[i] * s) : (x[i] * c - pp[i] * s);
        }
        u32x4 ow; ow.x = pk2(o[0], o[1]); ow.y = pk2(o[2], o[3]); ow.z = pk2(o[4], o[5]); ow.w = pk2(o[6], o[7]);
        qf[2] = __builtin_bit_cast(bf16x8, ow);
    }
    const int nt = Tk / 64;
    const int kk = wave * 8 + (lane >> 3), kc = (lane & 7) ^ (kk & 7);
    const char* gk = (const char*)(KN + (size_t)(kbase + kk) * 512 + h * 64 + kc * 8);
    const int rk = (wave & 3) * 16 + (lane >> 2), rc = (lane & 3) ^ ((rk >> 2) & 3);
    const char* gr = (const char*)(KRP + (size_t)(kbase + rk) * 32 + rc * 8);
    const int vd = wave * 8 + (lane >> 3), vc = (lane & 7) ^ (vd & 7);
    const char* gv = (const char*)(VT + vbase + (size_t)vd * Tk + vc * 8);
    const unsigned ldk = AT_KN + wave * 1024, ldr = AT_KR + (wave & 3) * 1024, ldv = AT_VT + wave * 1024;
#define AT_ISSUE(tile, stg) do { const int _t = (tile) < nt ? (tile) : nt - 1; const unsigned _s = (unsigned)(stg) * AT_STAGE; \
        __builtin_amdgcn_global_load_lds((const unsigned*)(gk + (size_t)_t * 65536), (LAS unsigned*)(lds + _s + ldk), 16, 0, 0); \
        __builtin_amdgcn_global_load_lds((const unsigned*)(gr + (size_t)_t * 4096), (LAS unsigned*)(lds + _s + ldr), 16, 0, 0); \
        __builtin_amdgcn_global_load_lds((const unsigned*)(gv + (size_t)_t * 128), (LAS unsigned*)(lds + _s + ldv), 16, 0, 0); } while (0)
    asm volatile("s_waitcnt vmcnt(0) lgkmcnt(0)" ::: "memory");
    __builtin_amdgcn_s_barrier();
    AT_ISSUE(0, 0); AT_ISSUE(1, 1);
    f32x4 oacc[4];
#pragma unroll
    for (int i = 0; i < 4; ++i) oacc[i] = (f32x4){0.f, 0.f, 0.f, 0.f};
    float mrun = -INFINITY, lrun = 0.f;
    const float cs = 0.10206207261596577f * 1.4426950408889634f;
    const int sw7 = fr & 7, sw3 = (fr >> 2) & 3;
    int stg = 0;
    for (int t = 0; t < nt; ++t) {
        asm volatile("s_waitcnt vmcnt(3)" ::: "memory");
        __builtin_amdgcn_s_barrier();
        asm volatile("" ::: "memory");
        { const int s2 = stg >= 1 ? stg - 1 : 2; AT_ISSUE(t + 2, s2); }
        const LAS unsigned char* sb = lds + stg * AT_STAGE;
        f32x4 s[4];
#pragma unroll
        for (int kb = 0; kb < 4; ++kb) {
            s[kb] = (f32x4){0.f, 0.f, 0.f, 0.f};
            const int key = kb * 16 + fr;
#pragma unroll
            for (int ks = 0; ks < 2; ++ks) {
                const bf16x8 kf = *(const LAS bf16x8*)(sb + AT_KN + key * 128 + (((ks * 4 + fq) ^ sw7) * 16));
                s[kb] = __builtin_amdgcn_mfma_f32_16x16x32_bf16(kf, qf[ks], s[kb], 0, 0, 0);
            }
            const bf16x8 kr = *(const LAS bf16x8*)(sb + AT_KR + key * 64 + ((fq ^ sw3) * 16));
            s[kb] = __builtin_amdgcn_mfma_f32_16x16x32_bf16(kr, qf[2], s[kb], 0, 0, 0);
        }
        float mx = fmaxf(fmaxf(s[0][0], s[0][1]), fmaxf(s[0][2], s[0][3]));
#pragma unroll
        for (int kb = 1; kb < 4; ++kb) mx = fmaxf(mx, fmaxf(fmaxf(s[kb][0], s[kb][1]), fmaxf(s[kb][2], s[kb][3])));
        mx = fmaxf(mx, __shfl_xor(mx, 16)); mx = fmaxf(mx, __shfl_xor(mx, 32));
        const float mn = fmaxf(mrun, mx);
        const float alpha = __builtin_amdgcn_exp2f((mrun - mn) * cs);
        mrun = mn;
        const float mc = mn * cs;
        float ps = 0.f;
#pragma unroll
        for (int kb = 0; kb < 4; ++kb)
#pragma unroll
            for (int j = 0; j < 4; ++j) { const float p = __builtin_amdgcn_exp2f(s[kb][j] * cs - mc); s[kb][j] = p; ps += p; }
        lrun = lrun * alpha + ps;
#pragma unroll
        for (int i = 0; i < 4; ++i) oacc[i] = oacc[i] * alpha;
        bf16x8 pf[2];
#pragma unroll
        for (int kp2 = 0; kp2 < 2; ++kp2) {
            u32x4 w; w.x = pk2(s[2 * kp2][0], s[2 * kp2][1]); w.y = pk2(s[2 * kp2][2], s[2 * kp2][3]);
            w.z = pk2(s[2 * kp2 + 1][0], s[2 * kp2 + 1][1]); w.w = pk2(s[2 * kp2 + 1][2], s[2 * kp2 + 1][3]);
            pf[kp2] = __builtin_bit_cast(bf16x8, w);
        }
#pragma unroll
        for (int db = 0; db < 4; ++db)
#pragma unroll
            for (int kp2 = 0; kp2 < 2; ++kp2) {
                const int d = db * 16 + fr, c0 = kp2 * 4 + (fq >> 1);
                const LAS unsigned char* vb = sb + AT_VT + d * 128 + (fq & 1) * 8;
                const u32x2 lo = *(const LAS u32x2*)(vb + ((c0 ^ sw7) * 16)), hi = *(const LAS u32x2*)(vb + (((c0 + 2) ^ sw7) * 16));
                u32x4 w; w.x = lo.x; w.y = lo.y; w.z = hi.x; w.w = hi.y;
                oacc[db] = __builtin_amdgcn_mfma_f32_16x16x32_bf16(__builtin_bit_cast(bf16x8, w), pf[kp2], oacc[db], 0, 0, 0);
            }
        stg = stg == 2 ? 0 : stg + 1;
    }
    asm volatile("s_waitcnt vmcnt(0)" ::: "memory");
    lrun += __shfl_xor(lrun, 16); lrun += __shfl_xor(lrun, 32);
    const float il = 1.f / lrun;
#pragma unroll
    for (int db = 0; db < 4; ++db) {
        u32x2 w; w.x = pk2(oacc[db][0] * il, oacc[db][1] * il); w.y = pk2(oacc[db][2] * il, oacc[db][3] * il);
        *(u32x2*)(O + (size_t)qrow * 512 + h * 64 + db * 16 + fq * 4) = w;
    }
#undef AT_ISSUE
}

typedef short s16x4 __attribute__((ext_vector_type(4)));
constexpr int HW_QE = 0, HW_KE = 2304, HW_KGT = 4608, HW_VT = 7680, HW_EG = 10752, HW_BYTES = 11008;
constexpr int HG_OB = 0, HG_WL = 65536;
__device__ __forceinline__ bf16_t f2bf(float x) { return (bf16_t)(pk2(x, 0.f) & 0xffffu); }
constexpr int HG_RAW = 88064;
template <bool WITH_O>
__device__ __forceinline__ void hgrn_block_scan(f32x4 (&S)[4][4], float& dtot, LAS unsigned char* lds, const bf16_t* HQ, const bf16_t* HV, const float* FF, const float* FB, int row0, int h) {
    const int tid = threadIdx.x, lane = tid & 63, wave = __builtin_amdgcn_readfirstlane(tid >> 6), fr = lane & 15, quad = lane >> 4;
    const bool scanner = wave < 2;
    const int dir = wave & 1;
#define HG_BAR() do { asm volatile("s_waitcnt lgkmcnt(0)" ::: "memory"); __builtin_amdgcn_s_barrier(); asm volatile("" ::: "memory"); } while (0)
    if (!scanner) {
        const int lt = tid - 128;
        const char* lsrc[3]; int ldst[3]; int lstep[3]; bool lval[3];
#pragma unroll
        for (int j = 0; j < 3; ++j) {
            const int i = lt + 384 * j; const int d = (i >> 9) & 1, r = i & 511;
            lval[j] = i < 1024 && (WITH_O || r < 256 || r >= 384);
            int row, dst; const char* s;
            if (r < 256) { row = r >> 4; const int ch = r & 15; s = (const char*)((d ? FB : FF) + (size_t)row0 * 512 + h * 64 + ch * 4); dst = ch * 16; lstep[j] = 2048; }
            else if (r < 384) { const int r2 = r - 256; row = r2 >> 3; const int ch = r2 & 7; s = (const char*)(HQ + (size_t)row0 * 512 + h * 64 + ch * 8); dst = 4096 + ch * 16; lstep[j] = 1024; }
            else { const int r2 = r - 384; row = r2 >> 3; const int ch = r2 & 7; s = (const char*)(HV + (size_t)row0 * 512 + h * 64 + ch * 8); dst = 6144 + ch * 16; lstep[j] = 1024; }
            const int rowbytes = r < 256 ? 256 : 128;
            lsrc[j] = s + (size_t)((d ? 240 : 0) + row) * lstep[j];
            lstep[j] = (d ? -16 : 16) * lstep[j];
            ldst[j] = d * 8192 + dst + (d ? 15 - row : row) * rowbytes;
        }
        u32x4 lnxt[3];
#pragma unroll
        for (int j = 0; j < 3; ++j) if (lval[j]) lnxt[j] = *(const u32x4*)lsrc[j];
#pragma unroll
        for (int j = 0; j < 3; ++j) if (lval[j]) *(LAS u32x4*)(lds + HG_RAW + ldst[j]) = lnxt[j];
#pragma unroll
        for (int j = 0; j < 3; ++j) if (lval[j]) lnxt[j] = *(const u32x4*)(lsrc[j] + (ptrdiff_t)lstep[j]);
        HG_BAR();
        for (int c = 0; c < 16; ++c) {
            if (c + 1 < 16) {
                asm volatile("s_waitcnt vmcnt(0)" ::: "memory");
#pragma unroll
                for (int j = 0; j < 3; ++j) if (lval[j]) *(LAS u32x4*)(lds + HG_RAW + ((c + 1) & 1) * 16384 + ldst[j]) = lnxt[j];
                if (c + 2 < 16) {
#pragma unroll
                    for (int j = 0; j < 3; ++j) if (lval[j]) lnxt[j] = *(const u32x4*)(lsrc[j] + (ptrdiff_t)(c + 2) * lstep[j]);
                }
            }
            HG_BAR();
        }
    } else {
        LAS unsigned char* wl = lds + HG_WL + dir * HW_BYTES;
        LAS unsigned char* qe = wl + HW_QE; LAS unsigned char* ke = wl + HW_KE; LAS unsigned char* kgT = wl + HW_KGT; LAS unsigned char* vT = wl + HW_VT;
        LAS float* eg = (LAS float*)(wl + HW_EG);
        LAS float* obuf = (LAS float*)(lds + HG_OB);
        HG_BAR();
        for (int c = 0; c < 16; ++c) {
            const LAS unsigned char* rb = lds + HG_RAW + (c & 1) * 16384 + dir * 8192;
            float b2 = 0.f; float kreg[16];
            float fin[16]; unsigned qin[16];
#pragma unroll
            for (int s = 0; s < 16; ++s) { fin[s] = *(const LAS float*)(rb + s * 256 + lane * 4);
                if (WITH_O) qin[s] = *(const LAS bf16_t*)(rb + 4096 + s * 128 + lane * 2); }
#pragma unroll
            for (int s = 0; s < 16; ++s) {
                const float fv = fin[s];
                b2 += __log2f(fv);
                const float kin = (1.f - fv) * __builtin_amdgcn_exp2f(-b2);
                kreg[s] = kin;
                if (WITH_O) {
                    *(LAS bf16_t*)(ke + s * 144 + lane * 2) = f2bf(kin);
                    const float qv = __uint_as_float(qin[s] << 16) * __builtin_amdgcn_exp2f(b2);
                    *(LAS bf16_t*)(qe + s * 144 + lane * 2) = f2bf(qv);
                }
            }
            const float egv = __builtin_amdgcn_exp2f(b2);
            eg[lane] = egv; dtot *= egv;
            {
                u32x4 w0, w1;
                w0.x = pk2(kreg[0] * egv, kreg[1] * egv); w0.y = pk2(kreg[2] * egv, kreg[3] * egv); w0.z = pk2(kreg[4] * egv, kreg[5] * egv); w0.w = pk2(kreg[6] * egv, kreg[7] * egv);
                w1.x = pk2(kreg[8] * egv, kreg[9] * egv); w1.y = pk2(kreg[10] * egv, kreg[11] * egv); w1.z = pk2(kreg[12] * egv, kreg[13] * egv); w1.w = pk2(kreg[14] * egv, kreg[15] * egv);
                *(LAS u32x4*)(kgT + lane * 48) = w0; *(LAS u32x4*)(kgT + lane * 48 + 16) = w1;
                unsigned vv[16];
#pragma unroll
                for (int s = 0; s < 16; ++s) vv[s] = *(const LAS bf16_t*)(rb + 6144 + s * 128 + lane * 2);
                u32x4 x0, x1;
                x0.x = vv[0] | (vv[1] << 16); x0.y = vv[2] | (vv[3] << 16); x0.z = vv[4] | (vv[5] << 16); x0.w = vv[6] | (vv[7] << 16);
                x1.x = vv[8] | (vv[9] << 16); x1.y = vv[10] | (vv[11] << 16); x1.z = vv[12] | (vv[13] << 16); x1.w = vv[14] | (vv[15] << 16);
                *(LAS u32x4*)(vT + lane * 48) = x0; *(LAS u32x4*)(vT + lane * 48 + 16) = x1;
            }
            asm volatile("s_waitcnt lgkmcnt(0)" ::: "memory");
            s16x4 bv[4];
#pragma unroll
            for (int vb = 0; vb < 4; ++vb) bv[vb] = *(const LAS s16x4*)(vT + (vb * 16 + fr) * 48 + quad * 8);
            if (WITH_O) {
                f32x4 at = (f32x4){0.f, 0.f, 0.f, 0.f};
#pragma unroll
                for (int kp = 0; kp < 2; ++kp) {
                    const bf16x8 ak = *(const LAS bf16x8*)(ke + fr * 144 + kp * 64 + quad * 16);
                    const bf16x8 bq = *(const LAS bf16x8*)(qe + fr * 144 + kp * 64 + quad * 16);
                    at = __builtin_amdgcn_mfma_f32_16x16x32_bf16(ak, bq, at, 0, 0, 0);
                }
#pragma unroll
                for (int r = 0; r < 4; ++r) at[r] = (quad * 4 + r <= fr) ? at[r] : 0.f;
                u32x2 pw; pw.x = pk2(at[0], at[1]); pw.y = pk2(at[2], at[3]);
                const s16x4 pa = __builtin_bit_cast(s16x4, pw);
                f32x4 o[4];
#pragma unroll
                for (int vb = 0; vb < 4; ++vb) o[vb] = __builtin_amdgcn_mfma_f32_16x16x16bf16_1k(pa, bv[vb], (f32x4){0.f, 0.f, 0.f, 0.f}, 0, 0, 0);
#pragma unroll
                for (int kb = 0; kb < 4; ++kb) {
                    const s16x4 aq = *(const LAS s16x4*)(qe + fr * 144 + kb * 32 + quad * 8);
#pragma unroll
                    for (int vb = 0; vb < 4; ++vb) {
                        u32x2 sw; sw.x = pk2(S[kb][vb][0], S[kb][vb][1]); sw.y = pk2(S[kb][vb][2], S[kb][vb][3]);
                        o[vb] = __builtin_amdgcn_mfma_f32_16x16x16bf16_1k(aq, __builtin_bit_cast(s16x4, sw), o[vb], 0, 0, 0);
                    }
                }
                {
                    LAS float* ob0 = obuf + (dir == 0 ? 16 * c + quad * 4 : 255 - 16 * c - quad * 4) * 64 + fr;
                    const int rs = dir == 0 ? 64 : -64;
#pragma unroll
                    for (int r = 0; r < 4; ++r)
#pragma unroll
                        for (int vb = 0; vb < 4; ++vb)
                            __hip_atomic_fetch_add(ob0 + r * rs + vb * 16, o[vb][r], __ATOMIC_RELAXED, __HIP_MEMORY_SCOPE_WORKGROUP);
                }
            }
#pragma unroll
            for (int kb = 0; kb < 4; ++kb) {
                const f32x4 ev = *(const LAS f32x4*)(eg + kb * 16 + quad * 4);
                const s16x4 akg = *(const LAS s16x4*)(kgT + (kb * 16 + fr) * 48 + quad * 8);
#pragma unroll
                for (int vb = 0; vb < 4; ++vb) S[kb][vb] = __builtin_amdgcn_mfma_f32_16x16x16bf16_1k(akg, bv[vb], S[kb][vb] * ev, 0, 0, 0);
            }
            HG_BAR();
        }
    }
#undef HG_BAR
    __syncthreads();
}

__device__ __forceinline__ void hgrn_pass1(const Args& a, LAS unsigned char* lds, int bi) {
    const int tid = threadIdx.x, lane = tid & 63, wave = tid >> 6, fr = lane & 15, quad = lane >> 4;
    unsigned char* ws = a.ws;
    const int dir = wave & 1, seg = bi & 7, h = (bi >> 3) & 7, b = bi >> 6;
    const int row0 = NCTX + b * 2048 + seg * 256;
    f32x4 S[4][4]; float dtot = 1.f;
#pragma unroll
    for (int kb = 0; kb < 4; ++kb)
#pragma unroll
        for (int vb = 0; vb < 4; ++vb) S[kb][vb] = (f32x4){0.f, 0.f, 0.f, 0.f};
    hgrn_block_scan<false>(S, dtot, lds, (const bf16_t*)(ws + WS_HQ), (const bf16_t*)(ws + WS_HV), (const float*)(ws + WS_FF), (const float*)(ws + WS_FB), row0, h);
    if (wave < 2) {
        const int item = bi * 2 + dir;
        float* sl = (float*)(ws + WS_SLOC) + (size_t)item * 4096 + quad * 256 + fr;
#pragma unroll
        for (int kb = 0; kb < 4; ++kb) {
            float* pk = sl + kb * 1024; asm volatile("" : "+v"(pk));
#pragma unroll
            for (int vb = 0; vb < 4; ++vb)
#pragma unroll
                for (int r = 0; r < 4; ++r) pk[r * 64 + vb * 16] = S[kb][vb][r];
        }
        ((float*)(ws + WS_GDEC))[(size_t)item * 64 + lane] = dtot;
    }
}

__device__ __forceinline__ void hgrn_pass2(const Args& a, LAS unsigned char* lds, int item) {
    const int tid = threadIdx.x, lane = tid & 63, wave = tid >> 6, fr = lane & 15, quad = lane >> 4;
    unsigned char* ws = a.ws;
    const bool ctx = item < 128;
    int b, h, seg = 0, row0;
    if (ctx) { b = item >> 3; h = item & 7; row0 = b * 256; }
    else { const int it = item - 128; seg = it & 7; h = (it >> 3) & 7; b = it >> 6; row0 = NCTX + b * 2048 + seg * 256; }
    LAS float* ob = (LAS float*)(lds + HG_OB);
    for (int i = tid; i < 256 * 64 / 4; i += NTHR) ((LAS f32x4*)ob)[i] = (f32x4){0.f, 0.f, 0.f, 0.f};
    const int dir = wave & 1;
    f32x4 S[4][4]; float dtot = 1.f;
#pragma unroll
    for (int kb = 0; kb < 4; ++kb)
#pragma unroll
        for (int vb = 0; vb < 4; ++vb) S[kb][vb] = (f32x4){0.f, 0.f, 0.f, 0.f};
    if (wave < 2 && !ctx) {
        const int it2 = ((b * 8 + h) * 8 + seg) * 2 + dir;
        const float* s0 = (const float*)(ws + WS_SENT) + (size_t)it2 * 4096 + quad * 256 + fr;
#pragma unroll
        for (int kb = 0; kb < 4; ++kb) {
            const float* pk = s0 + kb * 1024; asm volatile("" : "+v"(pk));
#pragma unroll
            for (int vb = 0; vb < 4; ++vb)
#pragma unroll
                for (int r = 0; r < 4; ++r) S[kb][vb][r] = pk[r * 64 + vb * 16];
        }
    }
    hgrn_block_scan<true>(S, dtot, lds, (const bf16_t*)(ws + WS_HQ), (const bf16_t*)(ws + WS_HV), (const float*)(ws + WS_FF), (const float*)(ws + WS_FB), row0, h);
    if (wave < 2 && ctx) {
        float* so = a.out + OST + (size_t)((b * 2 + dir) * 8 + h) * 4096 + quad * 256 + fr;
#pragma unroll
        for (int kb = 0; kb < 4; ++kb) {
            float* pk = so + kb * 1024; asm volatile("" : "+v"(pk));
#pragma unroll
            for (int vb = 0; vb < 4; ++vb)
#pragma unroll
                for (int r = 0; r < 4; ++r) pk[r * 64 + vb * 16] = S[kb][vb][r];
        }
    }
    const float gn = a.in[I_HGNG][lane];
    const bf16_t* HG = (const bf16_t*)(ws + WS_HG);
    bf16_t* OR = (bf16_t*)(ws + WS_O) + (size_t)NTOK * 512;
    {
        const size_t off0 = (size_t)(row0 + wave * 32) * 512 + h * 64 + lane;
        bf16_t gt[32];
#pragma unroll
        for (int i = 0; i < 32; ++i) gt[i] = HG[off0 + (size_t)i * 512];
#pragma unroll
        for (int i = 0; i < 32; ++i) {
            const float v = ob[(wave * 32 + i) * 64 + lane];
            const float rinv = rsqrtf(wave_sum(v * v) * (1.f / 64.f) + EPS);
            const float gate = __uint_as_float((unsigned)gt[i] << 16);
            OR[off0 + (size_t)i * 512] = f2bf(v * rinv * gn * gate);
        }
    }
    __syncthreads();
}


template <int NST>
__device__ __forceinline__ void attn_group_item(const Args& a, LAS unsigned char* lds, unsigned ring_off, int wa, int ab, int h, int qt) {
    const int tid = threadIdx.x, lane = tid & 63, fr = lane & 15, fq = lane >> 4;
    unsigned char* ws = a.ws;
    const bf16_t* Q = (const bf16_t*)(ws + WS_Q); const bf16_t* KN = (const bf16_t*)(ws + WS_KN); const bf16_t* KRP = (const bf16_t*)(ws + WS_KRP); const bf16_t* VT = (const bf16_t*)(ws + WS_VT);
    bf16_t* O = (bf16_t*)(ws + WS_O);
    const float cs = 0.10206207261596577f * 1.4426950408889634f;
    const int sw7 = fr & 7, sw3 = (fr >> 2) & 3;
        const int Tk = ab < 16 ? 256 : 2304;
        const int kbase = ab < 16 ? ab * 256 : NCTX + (ab - 16) * 2304;
        const size_t vbase = ab < 16 ? (size_t)(ab * 8 + h) * 64 * 256 : (size_t)16 * 8 * 64 * 256 + (size_t)((ab - 16) * 8 + h) * 64 * 2304;
        const int qrow = (ab < 16 ? ab * 256 : NCTX + (ab - 16) * 2048) + qt * 128 + wa * 32 + fr;
        bf16x8 qf[2][3];
#pragma unroll
        for (int sb = 0; sb < 2; ++sb)
#pragma unroll
            for (int ks = 0; ks < 3; ++ks) qf[sb][ks] = *(const bf16x8*)(Q + (size_t)(qrow + 16 * sb) * 768 + h * 96 + ks * 32 + fq * 8);
        if (ab >= 16) {
#pragma unroll
            for (int sb = 0; sb < 2; ++sb) {
                const int t = qt * 128 + wa * 32 + 16 * sb + fr;
                const float pos = fq < 2 ? (float)(t >> 6) : (float)(t & 63);
                const u32x4 w = __builtin_bit_cast(u32x4, qf[sb][2]);
                u32x4 pw; pw.x = __shfl_xor(w.x, 16); pw.y = __shfl_xor(w.y, 16); pw.z = __shfl_xor(w.z, 16); pw.w = __shfl_xor(w.w, 16);
                const float x[8] = {bflo(w.x), bfhi(w.x), bflo(w.y), bfhi(w.y), bflo(w.z), bfhi(w.z), bflo(w.w), bfhi(w.w)};
                const float pp[8] = {bflo(pw.x), bfhi(pw.x), bflo(pw.y), bfhi(pw.y), bflo(pw.z), bfhi(pw.z), bflo(pw.w), bfhi(pw.w)};
                const float iv[8] = {1.0f, 0.31622776601683794f, 0.1f, 0.031622776601683794f, 0.01f, 0.0031622776601683794f, 0.001f, 0.00031622776601683794f};
                float o[8];
#pragma unroll
                for (int i = 0; i < 8; ++i) {
                    float rev = pos * iv[i] * 0.15915494309189535f; rev -= rintf(rev);
                    const float s = __builtin_amdgcn_sinf(rev), c = __builtin_amdgcn_cosf(rev);
                    o[i] = (fq & 1) ? (x[i] * c + pp[i] * s) : (x[i] * c - pp[i] * s);
                }
                u32x4 ow; ow.x = pk2(o[0], o[1]); ow.y = pk2(o[2], o[3]); ow.z = pk2(o[4], o[5]); ow.w = pk2(o[6], o[7]);
                qf[sb][2] = __builtin_bit_cast(bf16x8, ow);
            }
        }
        const int nt = Tk / 64;
        const char* gk[2]; const char* gv[2];
#pragma unroll
        for (int j = 0; j < 2; ++j) {
            const int kk = (2 * wa + j) * 8 + (lane >> 3), kc = (lane & 7) ^ (kk & 7);
            gk[j] = (const char*)(KN + (size_t)(kbase + kk) * 512 + h * 64 + kc * 8);
            const int vd = (2 * wa + j) * 8 + (lane >> 3), vc = (lane & 7) ^ (vd & 7);
            gv[j] = (const char*)(VT + vbase + (size_t)vd * Tk + vc * 8);
        }
        const int rk = wa * 16 + (lane >> 2), rc = (lane & 3) ^ ((rk >> 2) & 3);
        const char* gr = (const char*)(KRP + (size_t)(kbase + rk) * 32 + rc * 8);
#define F_ISSUE(tile, stg) do { const int _t = (tile) < nt ? (tile) : nt - 1; const unsigned _s = ring_off + (unsigned)(stg) * AT_STAGE; \
        __builtin_amdgcn_global_load_lds((const unsigned*)(gk[0] + (size_t)_t * 65536), (LAS unsigned*)(lds + _s + AT_KN + (2 * wa) * 1024), 16, 0, 0); \
        __builtin_amdgcn_global_load_lds((const unsigned*)(gk[1] + (size_t)_t * 65536), (LAS unsigned*)(lds + _s + AT_KN + (2 * wa + 1) * 1024), 16, 0, 0); \
        __builtin_amdgcn_global_load_lds((const unsigned*)(gr + (size_t)_t * 4096), (LAS unsigned*)(lds + _s + AT_KR + wa * 1024), 16, 0, 0); \
        __builtin_amdgcn_global_load_lds((const unsigned*)(gv[0] + (size_t)_t * 128), (LAS unsigned*)(lds + _s + AT_VT + (2 * wa) * 1024), 16, 0, 0); \
        __builtin_amdgcn_global_load_lds((const unsigned*)(gv[1] + (size_t)_t * 128), (LAS unsigned*)(lds + _s + AT_VT + (2 * wa + 1) * 1024), 16, 0, 0); } while (0)
        asm volatile("s_waitcnt vmcnt(0) lgkmcnt(0)" ::: "memory");
        __builtin_amdgcn_s_barrier();
        asm volatile("" ::: "memory");
        F_ISSUE(0, 0); if (NST == 3) F_ISSUE(1, 1);
        f32x4 oacc[2][4];
#pragma unroll
        for (int sb = 0; sb < 2; ++sb)
#pragma unroll
            for (int i = 0; i < 4; ++i) oacc[sb][i] = (f32x4){0.f, 0.f, 0.f, 0.f};
        float mrun[2] = {-INFINITY, -INFINITY}, lrun[2] = {0.f, 0.f};
        int stg = 0;
        for (int t = 0; t < nt; ++t) {
            if (NST == 3) asm volatile("s_waitcnt vmcnt(5)" ::: "memory"); else asm volatile("s_waitcnt vmcnt(0)" ::: "memory");
            __builtin_amdgcn_s_barrier();
            asm volatile("" ::: "memory");
            if (NST == 3) { const int s2 = stg >= 1 ? stg - 1 : 2; F_ISSUE(t + 2, s2); } else { F_ISSUE(t + 1, stg ^ 1); }
            const LAS unsigned char* sbp = lds + ring_off + stg * AT_STAGE;
            f32x4 s[2][4];
#pragma unroll
            for (int kb = 0; kb < 4; ++kb) {
                s[0][kb] = (f32x4){0.f, 0.f, 0.f, 0.f}; s[1][kb] = (f32x4){0.f, 0.f, 0.f, 0.f};
                const int key = kb * 16 + fr;
#pragma unroll
                for (int ks = 0; ks < 2; ++ks) {
                    const bf16x8 kf = *(const LAS bf16x8*)(sbp + AT_KN + key * 128 + (((ks * 4 + fq) ^ sw7) * 16));
                    s[0][kb] = __builtin_amdgcn_mfma_f32_16x16x32_bf16(kf, qf[0][ks], s[0][kb], 0, 0, 0);
                    s[1][kb] = __builtin_amdgcn_mfma_f32_16x16x32_bf16(kf, qf[1][ks], s[1][kb], 0, 0, 0);
                }
                const bf16x8 kr = *(const LAS bf16x8*)(sbp + AT_KR + key * 64 + ((fq ^ sw3) * 16));
                s[0][kb] = __builtin_amdgcn_mfma_f32_16x16x32_bf16(kr, qf[0][2], s[0][kb], 0, 0, 0);
                s[1][kb] = __builtin_amdgcn_mfma_f32_16x16x32_bf16(kr, qf[1][2], s[1][kb], 0, 0, 0);
            }
            bf16x8 pf[2][2];
#pragma unroll
            for (int sb = 0; sb < 2; ++sb) {
                float mx = fmaxf(fmaxf(s[sb][0][0], s[sb][0][1]), fmaxf(s[sb][0][2], s[sb][0][3]));
#pragma unroll
                for (int kb = 1; kb < 4; ++kb) mx = fmaxf(mx, fmaxf(fmaxf(s[sb][kb][0], s[sb][kb][1]), fmaxf(s[sb][kb][2], s[sb][kb][3])));
                const bool upd = __builtin_amdgcn_ballot_w64((mx - mrun[sb]) * cs > 8.f) != 0ull;
                if (upd) {
                    mx = fmaxf(mx, __shfl_xor(mx, 16)); mx = fmaxf(mx, __shfl_xor(mx, 32));
                    const float mn = fmaxf(mrun[sb], mx);
                    const float alpha = __builtin_amdgcn_exp2f((mrun[sb] - mn) * cs);
                    mrun[sb] = mn;
                    lrun[sb] *= alpha;
#pragma unroll
                    for (int i = 0; i < 4; ++i) oacc[sb][i] = oacc[sb][i] * alpha;
                }
                const float mc = mrun[sb] * cs;
                float ps = 0.f;
#pragma unroll
                for (int kb = 0; kb < 4; ++kb)
#pragma unroll
                    for (int j = 0; j < 4; ++j) { const float p = __builtin_amdgcn_exp2f(s[sb][kb][j] * cs - mc); s[sb][kb][j] = p; ps += p; }
                lrun[sb] += ps;
#pragma unroll
                for (int kp2 = 0; kp2 < 2; ++kp2) {
                    u32x4 w; w.x = pk2(s[sb][2 * kp2][0], s[sb][2 * kp2][1]); w.y = pk2(s[sb][2 * kp2][2], s[sb][2 * kp2][3]);
                    w.z = pk2(s[sb][2 * kp2 + 1][0], s[sb][2 * kp2 + 1][1]); w.w = pk2(s[sb][2 * kp2 + 1][2], s[sb][2 * kp2 + 1][3]);
                    pf[sb][kp2] = __builtin_bit_cast(bf16x8, w);
                }
            }
#pragma unroll
            for (int db = 0; db < 4; ++db)
#pragma unroll
                for (int kp2 = 0; kp2 < 2; ++kp2) {
                    const int d = db * 16 + fr, c0 = kp2 * 4 + (fq >> 1);
                    const LAS unsigned char* vb = sbp + AT_VT + d * 128 + (fq & 1) * 8;
                    const u32x2 lo = *(const LAS u32x2*)(vb + ((c0 ^ sw7) * 16)), hi = *(const LAS u32x2*)(vb + (((c0 + 2) ^ sw7) * 16));
                    u32x4 w; w.x = lo.x; w.y = lo.y; w.z = hi.x; w.w = hi.y;
                    const bf16x8 vf = __builtin_bit_cast(bf16x8, w);
                    oacc[0][db] = __builtin_amdgcn_mfma_f32_16x16x32_bf16(vf, pf[0][kp2], oacc[0][db], 0, 0, 0);
                    oacc[1][db] = __builtin_amdgcn_mfma_f32_16x16x32_bf16(vf, pf[1][kp2], oacc[1][db], 0, 0, 0);
                }
            stg = (stg == NST - 1) ? 0 : stg + 1;
        }
        asm volatile("s_waitcnt vmcnt(0)" ::: "memory");
#pragma unroll
        for (int sb = 0; sb < 2; ++sb) {
            float l = lrun[sb]; l += __shfl_xor(l, 16); l += __shfl_xor(l, 32);
            const float il = 1.f / l;
#pragma unroll
            for (int db = 0; db < 4; ++db) {
                u32x2 w; w.x = pk2(oacc[sb][db][0] * il, oacc[sb][db][1] * il); w.y = pk2(oacc[sb][db][2] * il, oacc[sb][db][3] * il);
                *(u32x2*)(O + (size_t)(qrow + 16 * sb) * 512 + h * 64 + db * 16 + fq * 4) = w;
            }
        }
#undef F_ISSUE
}

constexpr int F_RING = 0, F_WL = 61440, F_RAW = 83456, F_NB = 32;
__device__ __forceinline__ void p7_fused(const Args& a, LAS unsigned char* lds, int blk) {
    const int tid = threadIdx.x, lane = tid & 63, wave = __builtin_amdgcn_readfirstlane(tid >> 6), fr = lane & 15, fq = lane >> 4;
    unsigned char* ws = a.ws;
#define F_BAR() do { asm volatile("s_waitcnt lgkmcnt(0)" ::: "memory"); __builtin_amdgcn_s_barrier(); asm volatile("" ::: "memory"); } while (0)
    const bool ctx = blk < 128;
    int hb, hh, hseg = 0, hrow0;
    if (ctx) { hb = blk >> 3; hh = blk & 7; hrow0 = hb * 256; }
    else { const int it = blk - 128; hseg = it & 7; hh = (it >> 3) & 7; hb = it >> 6; hrow0 = NCTX + hb * 2048 + hseg * 256; }
    if (wave < 4) {
        attn_group_item<3>(a, lds, F_RING, wave, 16 + (blk >> 7), (blk >> 4) & 7, blk & 15);
    } else if (wave >= 6) {
        const int lt = tid - 384;
        const bf16_t* HQ = (const bf16_t*)(ws + WS_HQ); const bf16_t* HV = (const bf16_t*)(ws + WS_HV);
        const char* lsrc[8]; int ldst[8];
#pragma unroll
        for (int j = 0; j < 8; ++j) {
            const int d = j >> 2, ty = j & 3;
            int row, dst, rowbytes, tokbytes; const char* s;
            if (ty < 2) { const int r = ty * 128 + lt; row = r >> 4; const int ch = r & 15; s = (const char*)((const float*)(ws + (d ? WS_FB : WS_FF)) + (size_t)hrow0 * 512 + hh * 64 + ch * 4); dst = ch * 16; rowbytes = 256; tokbytes = 2048; }
            else { row = lt >> 3; const int ch = lt & 7; s = (const char*)((ty == 2 ? HQ : HV) + (size_t)hrow0 * 512 + hh * 64 + ch * 8); dst = (ty == 2 ? 4096 : 6144) + ch * 16; rowbytes = 128; tokbytes = 1024; }
            lsrc[j] = s + (size_t)((d ? 240 : 0) + row) * tokbytes;
            ldst[j] = F_RAW + d * 8192 + dst + (d ? 15 - row : row) * rowbytes;
        }
        u32x4 lnxt[8];
#pragma unroll
        for (int j = 0; j < 8; ++j) lnxt[j] = *(const u32x4*)lsrc[j];
#pragma unroll
        for (int j = 0; j < 8; ++j) *(LAS u32x4*)(lds + ldst[j]) = lnxt[j];
#pragma unroll
        for (int j = 0; j < 8; ++j) { const int d = j >> 2, tokbytes = (j & 3) < 2 ? 2048 : 1024; lnxt[j] = *(const u32x4*)(lsrc[j] + (ptrdiff_t)((d ? -16 : 16) * tokbytes)); }
        for (int n = 0; n < F_NB; ++n) {
            F_BAR();
            const int c = n >> 1;
            if ((n & 1) == 0 && c + 1 < 16) {
                asm volatile("s_waitcnt vmcnt(0)" ::: "memory");
#pragma unroll
                for (int j = 0; j < 8; ++j) *(LAS u32x4*)(lds + ((c + 1) & 1) * 16384 + ldst[j]) = lnxt[j];
                if (c + 2 < 16) {
#pragma unroll
                    for (int j = 0; j < 8; ++j) { const int d = j >> 2, tokbytes = (j & 3) < 2 ? 2048 : 1024; lnxt[j] = *(const u32x4*)(lsrc[j] + (ptrdiff_t)(c + 2) * ((d ? -16 : 16) * tokbytes)); }
                }
            }
        }
        attn_group_item<2>(a, lds, F_WL, wave - 4, blk >> 4, (blk >> 1) & 7, blk & 1);
    } else {
        const int dir = wave & 1, quad = fq;
        f32x4 S[4][4];
#pragma unroll
        for (int kb = 0; kb < 4; ++kb)
#pragma unroll
            for (int vb = 0; vb < 4; ++vb) S[kb][vb] = (f32x4){0.f, 0.f, 0.f, 0.f};
        if (!ctx) {
            const int it2 = ((hb * 8 + hh) * 8 + hseg) * 2 + dir;
            const float* s0 = (const float*)(ws + WS_SENT) + (size_t)it2 * 4096 + quad * 256 + fr;
#pragma unroll
            for (int kb = 0; kb < 4; ++kb) {
                const float* pk = s0 + kb * 1024; asm volatile("" : "+v"(pk));
#pragma unroll
                for (int vb = 0; vb < 4; ++vb)
#pragma unroll
                    for (int r = 0; r < 4; ++r) S[kb][vb][r] = pk[r * 64 + vb * 16];
            }
        }
        LAS unsigned char* wl = lds + F_WL + dir * HW_BYTES;
        LAS unsigned char* qe = wl + HW_QE; LAS unsigned char* ke = wl + HW_KE; LAS unsigned char* kgT = wl + HW_KGT; LAS unsigned char* vT = wl + HW_VT;
        LAS float* eg = (LAS float*)(wl + HW_EG);
        bf16_t* OX = (bf16_t*)(ws + (dir ? WS_OBW : WS_OFW));
        for (int n = 0; n < F_NB; ++n) {
            F_BAR();
            const int c = n >> 1;
            if (n < 32 && (n & 1) == 0) {
                const LAS unsigned char* rb = lds + F_RAW + (c & 1) * 16384 + dir * 8192;
                float b2 = 0.f; float kreg[16];
                float fin[16]; unsigned qin[16];
#pragma unroll
                for (int s = 0; s < 16; ++s) { fin[s] = *(const LAS float*)(rb + s * 256 + lane * 4); qin[s] = *(const LAS bf16_t*)(rb + 4096 + s * 128 + lane * 2); }
#pragma unroll
                for (int s = 0; s < 16; ++s) {
                    const float fv = fin[s];
                    b2 += __log2f(fv);
                    const float kin = (1.f - fv) * __builtin_amdgcn_exp2f(-b2);
                    kreg[s] = kin;
                    *(LAS bf16_t*)(ke + s * 144 + lane * 2) = f2bf(kin);
                    const float qv = __uint_as_float(qin[s] << 16) * __builtin_amdgcn_exp2f(b2);
                    *(LAS bf16_t*)(qe + s * 144 + lane * 2) = f2bf(qv);
                }
                const float egv = __builtin_amdgcn_exp2f(b2);
                eg[lane] = egv;
                {
                    u32x4 w0, w1;
                    w0.x = pk2(kreg[0] * egv, kreg[1] * egv); w0.y = pk2(kreg[2] * egv, kreg[3] * egv); w0.z = pk2(kreg[4] * egv, kreg[5] * egv); w0.w = pk2(kreg[6] * egv, kreg[7] * egv);
                    w1.x = pk2(kreg[8] * egv, kreg[9] * egv); w1.y = pk2(kreg[10] * egv, kreg[11] * egv); w1.z = pk2(kreg[12] * egv, kreg[13] * egv); w1.w = pk2(kreg[14] * egv, kreg[15] * egv);
                    *(LAS u32x4*)(kgT + lane * 48) = w0; *(LAS u32x4*)(kgT + lane * 48 + 16) = w1;
                    unsigned vv[16];
#pragma unroll
                    for (int s = 0; s < 16; ++s) vv[s] = *(const LAS bf16_t*)(rb + 6144 + s * 128 + lane * 2);
                    u32x4 x0, x1;
                    x0.x = vv[0] | (vv[1] << 16); x0.y = vv[2] | (vv[3] << 16); x0.z = vv[4] | (vv[5] << 16); x0.w = vv[6] | (vv[7] << 16);
                    x1.x = vv[8] | (vv[9] << 16); x1.y = vv[10] | (vv[11] << 16); x1.z = vv[12] | (vv[13] << 16); x1.w = vv[14] | (vv[15] << 16);
                    *(LAS u32x4*)(vT + lane * 48) = x0; *(LAS u32x4*)(vT + lane * 48 + 16) = x1;
                }
            }
            if (n < 32 && (n & 1) == 1) {
                s16x4 bv[4];
#pragma unroll
                for (int vb = 0; vb < 4; ++vb) bv[vb] = *(const LAS s16x4*)(vT + (vb * 16 + fr) * 48 + quad * 8);
                f32x4 at = (f32x4){0.f, 0.f, 0.f, 0.f};
#pragma unroll
                for (int kp = 0; kp < 2; ++kp) {
                    const bf16x8 ak = *(const LAS bf16x8*)(ke + fr * 144 + kp * 64 + quad * 16);
                    const bf16x8 bq = *(const LAS bf16x8*)(qe + fr * 144 + kp * 64 + quad * 16);
                    at = __builtin_amdgcn_mfma_f32_16x16x32_bf16(ak, bq, at, 0, 0, 0);
                }
#pragma unroll
                for (int r = 0; r < 4; ++r) at[r] = (quad * 4 + r <= fr) ? at[r] : 0.f;
                u32x2 pw; pw.x = pk2(at[0], at[1]); pw.y = pk2(at[2], at[3]);
                const s16x4 pa = __builtin_bit_cast(s16x4, pw);
                f32x4 o[4];
#pragma unroll
                for (int vb = 0; vb < 4; ++vb) o[vb] = __builtin_amdgcn_mfma_f32_16x16x16bf16_1k(pa, bv[vb], (f32x4){0.f, 0.f, 0.f, 0.f}, 0, 0, 0);
#pragma unroll
                for (int kb = 0; kb < 4; ++kb) {
                    const s16x4 aq = *(const LAS s16x4*)(qe + fr * 144 + kb * 32 + quad * 8);
#pragma unroll
                    for (int vb = 0; vb < 4; ++vb) {
                        u32x2 sw; sw.x = pk2(S[kb][vb][0], S[kb][vb][1]); sw.y = pk2(S[kb][vb][2], S[kb][vb][3]);
                        o[vb] = __builtin_amdgcn_mfma_f32_16x16x16bf16_1k(aq, __builtin_bit_cast(s16x4, sw), o[vb], 0, 0, 0);
                    }
                }
                {
                    const int tl0 = dir == 0 ? 16 * c + quad * 4 : 255 - 16 * c - quad * 4;
                    bf16_t* op = OX + (size_t)(hrow0 + tl0) * 512 + hh * 64 + fr;
                    const ptrdiff_t rs = dir == 0 ? 512 : -512;
#pragma unroll
                    for (int r = 0; r < 4; ++r)
#pragma unroll
                        for (int vb = 0; vb < 4; ++vb) op[r * rs + vb * 16] = f2bf(o[vb][r]);
                }
#pragma unroll
                for (int kb = 0; kb < 4; ++kb) {
                    const f32x4 ev = *(const LAS f32x4*)(eg + kb * 16 + quad * 4);
                    const s16x4 akg = *(const LAS s16x4*)(kgT + (kb * 16 + fr) * 48 + quad * 8);
#pragma unroll
                    for (int vb = 0; vb < 4; ++vb) S[kb][vb] = __builtin_amdgcn_mfma_f32_16x16x16bf16_1k(akg, bv[vb], S[kb][vb] * ev, 0, 0, 0);
                }
                if (n == 31 && ctx) {
                    float* so = a.out + OST + (size_t)((hb * 2 + dir) * 8 + hh) * 4096 + quad * 256 + fr;
#pragma unroll
                    for (int kb = 0; kb < 4; ++kb) {
                        float* pk = so + kb * 1024; asm volatile("" : "+v"(pk));
#pragma unroll
                        for (int vb = 0; vb < 4; ++vb)
#pragma unroll
                            for (int r = 0; r < 4; ++r) pk[r * 64 + vb * 16] = S[kb][vb][r];
                    }
                }
            }
        }
        attn_group_item<2>(a, lds, F_WL, wave - 4, blk >> 4, (blk >> 1) & 7, blk & 1);
    }
#undef F_BAR
    __syncthreads();
}

__device__ __forceinline__ void phase_hgfin(const Args& a, int G) {
    const int tid = threadIdx.x, lane = tid & 63, wave = tid >> 6;
    unsigned char* ws = a.ws;
    const bf16_t* OF = (const bf16_t*)(ws + WS_OFW); const bf16_t* OB = (const bf16_t*)(ws + WS_OBW); const bf16_t* HG = (const bf16_t*)(ws + WS_HG);
    bf16_t* OR = (bf16_t*)(ws + WS_O) + (size_t)NTOK * 512;
    const f32x4 g0 = *(const f32x4*)(a.in[I_HGNG] + (lane & 7) * 8), g1 = *(const f32x4*)(a.in[I_HGNG] + (lane & 7) * 8 + 4);
#pragma unroll 4
    for (int row = blockIdx.x * 8 + wave; row < NTOK; row += G * 8) {
        const size_t off = (size_t)row * 512 + lane * 8;
        const u32x4 wf = *(const u32x4*)(OF + off), wb = *(const u32x4*)(OB + off), wg = *(const u32x4*)(HG + off);
        float v[8] = {bflo(wf.x) + bflo(wb.x), bfhi(wf.x) + bfhi(wb.x), bflo(wf.y) + bflo(wb.y), bfhi(wf.y) + bfhi(wb.y),
                      bflo(wf.z) + bflo(wb.z), bfhi(wf.z) + bfhi(wb.z), bflo(wf.w) + bflo(wb.w), bfhi(wf.w) + bfhi(wb.w)};
        float ss = 0.f;
#pragma unroll
        for (int i = 0; i < 8; ++i) ss += v[i] * v[i];
        ss += __shfl_xor(ss, 1); ss += __shfl_xor(ss, 2); ss += __shfl_xor(ss, 4);
        const float ri = rsqrtf(ss * (1.f / 64.f) + EPS);
        u32x4 o;
        o.x = pk2(v[0] * ri * g0.x * bflo(wg.x), v[1] * ri * g0.y * bfhi(wg.x)); o.y = pk2(v[2] * ri * g0.z * bflo(wg.y), v[3] * ri * g0.w * bfhi(wg.y));
        o.z = pk2(v[4] * ri * g1.x * bflo(wg.z), v[5] * ri * g1.y * bfhi(wg.z)); o.w = pk2(v[6] * ri * g1.z * bflo(wg.w), v[7] * ri * g1.w * bfhi(wg.w));
        *(u32x4*)(OR + off) = o;
    }
}


#define XB_TMO      128
#define XB_XCNT(j)  (256  + 64 * (j))
#define XB_XSUB(j)  (1280 + 64 * (j))
#define XB_XGEN(j)  (2304 + 64 * (j))
#define XB_TOP      3328
#define XB_TOPGEN   3392
#define XCD_BAR_WORDS 3456
#define XB_SPIN_CAP (1u << 18)
__device__ __forceinline__ unsigned xb_ld(unsigned* p)              { return __hip_atomic_load(p, __ATOMIC_RELAXED, __HIP_MEMORY_SCOPE_AGENT); }
__device__ __forceinline__ unsigned xb_add(unsigned* p, unsigned v) { return __hip_atomic_fetch_add(p, v, __ATOMIC_RELAXED, __HIP_MEMORY_SCOPE_AGENT); }
__device__ __forceinline__ unsigned xb_xcc_id() { return (unsigned)__builtin_amdgcn_s_getreg((3 << 11) | 20) & 0xFu; }
#define XB_SPIN(cond, bar) do { unsigned _sp = 0; while (cond) { __builtin_amdgcn_s_sleep(1); \
    if ((++_sp & 255u) == 0u) { if (xb_ld(&(bar)[XB_TMO])) break; if (_sp > XB_SPIN_CAP) { atomicAdd(&(bar)[XB_TMO], 1u); break; } } } } while (0)
struct XcdBarrier { unsigned* bar; unsigned x; volatile LAS unsigned* st; };
__device__ __forceinline__ XcdBarrier xcd_barrier_post(unsigned* bar, volatile LAS unsigned* st) {
    XcdBarrier b; b.bar = bar; b.x = xb_xcc_id(); b.st = st;
    if (threadIdx.x == 0) (void)xb_add(&bar[XB_XCNT(b.x)], 1u);
    return b;
}
__device__ __forceinline__ void xcd_barrier_complete(unsigned* bar, unsigned x, unsigned& nloc, unsigned& nx) {
    const unsigned G = gridDim.x * gridDim.y * gridDim.z;
    unsigned sum, cnt, mine, sp = 0u;
    for (;;) {
        sum = 0u; cnt = 0u; mine = 0u;
#pragma unroll
        for (unsigned j = 0; j < 16; ++j) { const unsigned c = xb_ld(&bar[XB_XCNT(j)]); sum += c; cnt += (c > 0u) ? 1u : 0u; mine = (j == x) ? c : mine; }
        if (sum == G) break;
        __builtin_amdgcn_s_sleep(1);
        if ((++sp & 255u) == 0u) { if (xb_ld(&bar[XB_TMO])) break; if (sp > XB_SPIN_CAP) { atomicAdd(&bar[XB_TMO], 1u); break; } }
    }
    nloc = mine > 0u ? mine : 1u; nx = cnt > 0u ? cnt : 1u;
}
__device__ __forceinline__ void xcd_barrier(const XcdBarrier& b) {
    asm volatile("s_waitcnt vmcnt(0)" ::: "memory");
    __syncthreads();
    if (threadIdx.x == 0) {
        unsigned* bar = b.bar;
        __builtin_amdgcn_s_waitcnt(0);
        unsigned nloc = b.st[0], nx = b.st[1];
        if (nloc == 0u) { xcd_barrier_complete(bar, b.x, nloc, nx); b.st[0] = nloc; b.st[1] = nx; }
        const unsigned old = xb_add(&bar[XB_XSUB(b.x)], 1u);
        const unsigned gen = old / nloc;
        if (old + 1u == (gen + 1u) * nloc) {
            __builtin_amdgcn_fence(__ATOMIC_RELEASE, "agent");
            asm volatile("s_waitcnt vmcnt(0)" ::: "memory");
            const unsigned og = xb_add(&bar[XB_TOP], 1u);
            const unsigned tg = og / nx;
            if (og + 1u == (tg + 1u) * nx) xb_add(&bar[XB_TOPGEN], 1u);
            else XB_SPIN(xb_ld(&bar[XB_TOPGEN]) == tg, bar);
            __builtin_amdgcn_fence(__ATOMIC_ACQUIRE, "agent");
            xb_add(&bar[XB_XGEN(b.x)], 1u);
            asm volatile("s_waitcnt vmcnt(0)" ::: "memory");
        } else {
            XB_SPIN(xb_ld(&bar[XB_XGEN(b.x)]) == gen, bar);
            __builtin_amdgcn_fence(__ATOMIC_ACQUIRE, "agent");
            asm volatile("s_waitcnt vmcnt(0)" ::: "memory");
        }
    }
    __syncthreads();
}

#ifndef PHMASK
#define PHMASK 0xFFFFF
#endif
#define PH(n) ((PHMASK >> (n)) & 1)
__global__ void __launch_bounds__(NTHR, 2) fwd_megakernel(Args a) {
    extern __shared__ __attribute__((aligned(16))) unsigned char lds_raw[];
    LAS unsigned char* lds = (LAS unsigned char*)lds_raw;
    volatile LAS unsigned* bar_st = (volatile LAS unsigned*)(lds + LDS_BYTES - 16);
    if (threadIdx.x < 4) bar_st[threadIdx.x] = 0u;
    __syncthreads();
    XcdBarrier gbar = xcd_barrier_post((unsigned*)(a.ws + WS_BAR), bar_st);
    const int G = gridDim.x, tid = threadIdx.x;
    unsigned char* ws = a.ws;
    using namespace pg8;

    if (PH(0)) {
    phase_prep(a, lds, G);
    }
    xcd_barrier(gbar);
    if (PH(1)) {
    phase_norm<1>(a, G);
    }
    xcd_barrier(gbar);
    if (PH(2)) {
    { Gemm g{(const bf16_t*)(ws + WS_XN), (const bf16_t*)(ws + WS_W1A), D, D, D, 0, 0}; GridOrder S{32, 22, 1, G, (int)blockIdx.x, 0}; EpiSwiGLU E{(bf16_t*)(ws + WS_HFF)};
      gemm_phase(lds, g, S, E); }
    tr_in_tail(a, lds, 32 * 22, TR_B0, TR_B1, G);
    }
    xcd_barrier(gbar);
    if (PH(3)) {
    { Gemm g{(const bf16_t*)(ws + WS_HFF), (const bf16_t*)(ws + WS_W1B), DFF, DFF, DFF / 2, (size_t)DFF, (size_t)DFF}; GridOrder S{32, 4, 2, G, (int)blockIdx.x, 0}; EpiPart E{(bf16_t*)(ws + WS_PART)};
      gemm_phase(lds, g, S, E); }
    }
    xcd_barrier(gbar);
    if (PH(4)) {
    phase_norm<2>(a, G);
    }
    xcd_barrier(gbar);
    if (PH(5)) {
    { Gemm g{(const bf16_t*)(ws + WS_XN), (const bf16_t*)(ws + WS_WIN), D, D, D, 0, 0}; GridOrder S{32, 21, 1, G, (int)blockIdx.x, 0};
      EpiIn E{(bf16_t*)(ws + WS_QC), (bf16_t*)(ws + WS_KVC), (bf16_t*)(ws + WS_HQ), (bf16_t*)(ws + WS_HV), (bf16_t*)(ws + WS_HG), (bf16_t*)(ws + WS_GATE), (bf16_t*)(ws + WS_KRP),
              (float*)(ws + WS_FF), (float*)(ws + WS_FB), a.out + OKR, (const float*)(ws + WS_LB)};
      gemm_phase(lds, g, S, E); }
    tr_in_tail(a, lds, 32 * 21, TR_C0, TR_C1, G);
    }
    xcd_barrier(gbar);
    if (PH(6)) {
        const int lane = tid & 63, wave = tid >> 6;
        float* RQ = (float*)(ws + WS_RQ); float* RKV = (float*)(ws + WS_RKV);
        const int nsk = G >= 192 ? 128 : 0;
        for (int rb = ((int)blockIdx.x - nsk) * 8 + wave; rb >= 0 && rb < NTOK / 4; rb += (G - nsk) * 8) {
            const int row0 = rb * 4;
            u32x4 wq[4], wk[4];
#pragma unroll
            for (int i = 0; i < 4; ++i) {
                wq[i] = (u32x4){0u, 0u, 0u, 0u}; wk[i] = (u32x4){0u, 0u, 0u, 0u};
                if (lane < 48) wq[i] = *(const u32x4*)((const bf16_t*)(ws + WS_QC) + (size_t)(row0 + i) * 384 + lane * 8);
                if (lane < 32) wk[i] = *(const u32x4*)((const bf16_t*)(ws + WS_KVC) + (size_t)(row0 + i) * 256 + lane * 8);
            }
            float sq[4], sk[4];
#pragma unroll
            for (int i = 0; i < 4; ++i) {
                { const u32x4 w = wq[i]; const float e0 = bflo(w.x), e1 = bfhi(w.x), e2 = bflo(w.y), e3 = bfhi(w.y), e4 = bflo(w.z), e5 = bfhi(w.z), e6 = bflo(w.w), e7 = bfhi(w.w);
                  sq[i] = (e0 * e0 + e1 * e1) + (e2 * e2 + e3 * e3) + (e4 * e4 + e5 * e5) + (e6 * e6 + e7 * e7); }
                { const u32x4 w = wk[i]; const float e0 = bflo(w.x), e1 = bfhi(w.x), e2 = bflo(w.y), e3 = bfhi(w.y), e4 = bflo(w.z), e5 = bfhi(w.z), e6 = bflo(w.w), e7 = bfhi(w.w);
                  sk[i] = (e0 * e0 + e1 * e1) + (e2 * e2 + e3 * e3) + (e4 * e4 + e5 * e5) + (e6 * e6 + e7 * e7); }
            }
#pragma unroll
            for (int o = 1; o < 64; o <<= 1) {
#pragma unroll
                for (int i = 0; i < 4; ++i) { sq[i] += __shfl_xor(sq[i], o); sk[i] += __shfl_xor(sk[i], o); }
            }
#pragma unroll
            for (int i = 0; i < 4; ++i) {
                const int row = row0 + i;
                const float ri = rsqrtf(sk[i] * (1.f / 256.f) + EPS);
                if (lane == 0) { RQ[row] = rsqrtf(sq[i] * (1.f / 384.f) + EPS); RKV[row] = ri; }
                if (row < NCTX && lane < 32) {
                    const u32x4 w = wk[i];
                    const f32x4 g0 = *(const f32x4*)(a.in[I_KVNG] + lane * 8), g1 = *(const f32x4*)(a.in[I_KVNG] + lane * 8 + 4);
                    f32x4 o0, o1; o0.x = bflo(w.x) * ri * g0.x; o0.y = bfhi(w.x) * ri * g0.y; o0.z = bflo(w.y) * ri * g0.z; o0.w = bfhi(w.y) * ri * g0.w;
                    o1.x = bflo(w.z) * ri * g1.x; o1.y = bfhi(w.z) * ri * g1.y; o1.z = bflo(w.w) * ri * g1.z; o1.w = bfhi(w.w) * ri * g1.w;
                    float* op = a.out + OCKV + (size_t)row * 256 + lane * 8;
                    *(f32x4*)op = o0; *(f32x4*)(op + 4) = o1;
                }
            }
        }
        for (int i = blockIdx.x * NTHR + tid; i < 512; i += G * NTHR) RKV[NTOK + i] = 1.f;
        for (int i = blockIdx.x * NTHR + tid; i < 512 * 256 / 2; i += G * NTHR) { const f32x2 v = *(const f32x2*)(a.in[I_CCKV] + 2 * (size_t)i); ((unsigned*)(ws + WS_KVC) + (size_t)NTOK * 256 / 2)[i] = pk2(v.x, v.y); }
        __syncthreads();
        for (int it = blockIdx.x; it < 128; it += G) hgrn_pass1(a, lds, it);
    }
    xcd_barrier(gbar);
    if (PH(6)) {
        { Gemm g{(const bf16_t*)(ws + WS_QC), (const bf16_t*)(ws + WS_WQB), 384, 384, 384, 0, 0}; GridOrder S{32, 3, 1, G, (int)blockIdx.x, 0}; EpiQ E{(bf16_t*)(ws + WS_Q), (const float*)(ws + WS_RQ)};
          gemm_phase(lds, g, S, E); }
        { Gemm g{(const bf16_t*)(ws + WS_KVC), (const bf16_t*)(ws + WS_WKVB), 256, 256, 256, 0, (size_t)1024 * 256 * 2}; GridOrder S{34, 4, 1, G, (int)((blockIdx.x + G - 96 % G) % G), 32}; EpiKV E{(bf16_t*)(ws + WS_KN), (bf16_t*)(ws + WS_VT), (const float*)(ws + WS_RKV)};
          gemm_phase(lds, g, S, E); }
        __syncthreads();
        for (int it = blockIdx.x; it < 256; it += G) {
            const int dir = it & 1, seg = (it >> 1) & 7, bh = it >> 4;
            const float* s0 = a.in[I_ST] + (size_t)(((bh >> 3) * 2 + dir) * 8 + (bh & 7)) * 4096;
            f32x4 e0 = *(const f32x4*)(s0 + tid * 4), e1 = *(const f32x4*)(s0 + 2048 + tid * 4);
            const int k0 = tid >> 4, k1 = 32 + (tid >> 4);
            const int nsteps = dir == 0 ? seg : 7 - seg;
            for (int st = 0; st < nsteps; ++st) {
                const int sj = dir == 0 ? st : 7 - st;
                const int pit = (bh * 8 + sj) * 2 + dir;
                const float* sl = (const float*)(ws + WS_SLOC) + (size_t)pit * 4096;
                const float* gd = (const float*)(ws + WS_GDEC) + (size_t)pit * 64;
                const f32x4 l0 = *(const f32x4*)(sl + tid * 4), l1 = *(const f32x4*)(sl + 2048 + tid * 4);
                const float g0 = gd[k0], g1 = gd[k1];
                e0 = g0 * e0 + l0; e1 = g1 * e1 + l1;
            }
            float* se = (float*)(ws + WS_SENT) + (size_t)it * 4096;
            *(f32x4*)(se + tid * 4) = e0; *(f32x4*)(se + 2048 + tid * 4) = e1;
        }
    }
    xcd_barrier(gbar);
    if (PH(7)) {
        p7_fused(a, lds, (int)blockIdx.x);
    }
    xcd_barrier(gbar);
    if (PH(7)) {
        phase_hgfin(a, G);
    }
    xcd_barrier(gbar);
    if (PH(8)) {
    { Gemm g{(const bf16_t*)(ws + WS_O), (const bf16_t*)(ws + WS_WUP), 512, 512, 512, (size_t)NTOK * 512 * 2, (size_t)1024 * 512 * 2}; GridOrder S{32, 4, 2, G, (int)blockIdx.x, 0};
      EpiUp E{(bf16_t*)(ws + WS_T), (const bf16_t*)(ws + WS_GATE)};
      gemm_phase(lds, g, S, E); }
    }
    xcd_barrier(gbar);
    if (PH(9)) {
    { Gemm g{(const bf16_t*)(ws + WS_T), (const bf16_t*)(ws + WS_WOUT), D, D, D, (size_t)NTOK * D * 2, 0}; GridOrder S{32, 4, 2, G, (int)blockIdx.x, 0}; EpiPart E{(bf16_t*)(ws + WS_PART)};
      gemm_phase(lds, g, S, E); }
    }
    xcd_barrier(gbar);
    if (PH(10)) {
    phase_norm<3>(a, G);
    }
    xcd_barrier(gbar);
    if (PH(11)) {
    { Gemm g{(const bf16_t*)(ws + WS_XN), (const bf16_t*)(ws + WS_W2A), D, D, D, 0, 0}; GridOrder S{32, 22, 1, G, (int)blockIdx.x, 0}; EpiSwiGLU E{(bf16_t*)(ws + WS_HFF)};
      gemm_phase(lds, g, S, E); }
    }
    xcd_barrier(gbar);
    if (PH(12)) {
    { Gemm g{(const bf16_t*)(ws + WS_HFF), (const bf16_t*)(ws + WS_W2B), DFF, DFF, DFF / 2, (size_t)DFF, (size_t)DFF}; GridOrder S{32, 4, 2, G, (int)blockIdx.x, 0}; EpiPart E{(bf16_t*)(ws + WS_PART)};
      gemm_phase(lds, g, S, E); }
    }
    xcd_barrier(gbar);
    if (PH(13)) {
    phase_norm<4>(a, G);
    }
}

extern "C" void kernel_launch(void* const* d_in, const int* in_sizes, int n_in, void* d_out, int out_size, void* d_ws, size_t ws_size, hipStream_t stream) {
    static int grid = 0;
    if (grid == 0) {
        int dev = 0, cus = 0, per_cu = 0;
        if (n_in != 27 || ws_size < WS_END) { fprintf(stderr, "kernel_launch: unexpected n_in %d / ws_size %zu\n", n_in, ws_size); grid = -1; return; }
        hipGetDevice(&dev);
        hipDeviceGetAttribute(&cus, hipDeviceAttributeMultiprocessorCount, dev);
        if (hipFuncSetAttribute((const void*)fwd_megakernel, hipFuncAttributeMaxDynamicSharedMemorySize, LDS_BYTES) != hipSuccess) { fprintf(stderr, "kernel_launch: hipFuncSetAttribute failed\n"); grid = -1; return; }
        if (hipOccupancyMaxActiveBlocksPerMultiprocessor(&per_cu, (const void*)fwd_megakernel, NTHR, LDS_BYTES) != hipSuccess || per_cu < 1) { fprintf(stderr, "kernel_launch: occupancy query says %d blocks/CU\n", per_cu); grid = -1; return; }
        grid = cus;
    }
    if (grid < 0) return;
    if (hipMemsetAsync((char*)d_ws + WS_BAR, 0, 16384, stream) != hipSuccess) { fprintf(stderr, "kernel_launch: memset of barrier words failed\n"); return; }
    Args a{};
    for (int i = 0; i < 27; ++i) a.in[i] = (const float*)d_in[i];
    a.out = (float*)d_out; a.ws = (unsigned char*)d_ws;
    void* args[] = {&a};
    hipError_t e = hipLaunchCooperativeKernel((const void*)fwd_megakernel, dim3(grid), dim3(NTHR), args, LDS_BYTES, stream);
    if (e != hipSuccess) fprintf(stderr, "cooperative launch failed: %s (grid %d)\n", hipGetErrorString(e), grid);
}
```

```cpp
#include <hip/hip_runtime.h>
#include <hip/hip_cooperative_groups.h>
#include <cstdio>
#include <cstdint>
namespace cg = cooperative_groups;

#define LAS __attribute__((address_space(3)))
typedef unsigned short bf16_t;
typedef short bf16x8 __attribute__((ext_vector_type(8)));
typedef float f32x4 __attribute__((ext_vector_type(4)));
typedef float f32x2 __attribute__((ext_vector_type(2)));
typedef unsigned u32x4 __attribute__((ext_vector_type(4)));
typedef unsigned u32x2 __attribute__((ext_vector_type(2)));

constexpr int D = 1024, NTOK = 8192, NCTX = 4096, DFF = 2816;
constexpr int DIN = 5280, DIN_P = 5376;
constexpr float EPS = 1e-6f;
constexpr int NTHR = 512;
constexpr int LDS_BYTES = 147456;
constexpr int LDS_X = 131072;

constexpr size_t OY = 0, OCKV = 8388608, OKR = 9437184, OST = 9568256;

constexpr size_t MiB = 1u << 20;
constexpr size_t WS_MOD = 0;
constexpr size_t WS_LB = 512 * 1024;
constexpr size_t WS_RQ = 640 * 1024;
constexpr size_t WS_RKV = 704 * 1024;
constexpr size_t WS_BAR = 768 * 1024;
constexpr size_t WS_SLOC = 1 * MiB;
constexpr size_t WS_GDEC = 5 * MiB;
constexpr size_t WS_W1A = 6 * MiB;
constexpr size_t WS_W1B = 17 * MiB;
constexpr size_t WS_W2A = 23 * MiB;
constexpr size_t WS_W2B = 34 * MiB;
constexpr size_t WS_WIN = 40 * MiB;
constexpr size_t WS_WQB = 51 * MiB;
constexpr size_t WS_WKVB = 52 * MiB;
constexpr size_t WS_WUP = 53 * MiB;
constexpr size_t WS_WOUT = 55 * MiB;
constexpr size_t WS_XN = 57 * MiB;
constexpr size_t WS_OFW = 61 * MiB;
constexpr size_t WS_OBW = 153 * MiB;
constexpr size_t WS_SENT = 57 * MiB;
constexpr size_t WS_X = 73 * MiB;
constexpr size_t WS_PART = 105 * MiB;
constexpr size_t WS_HFF = 169 * MiB;
constexpr size_t WS_GATE = 105 * MiB;
constexpr size_t WS_O = 137 * MiB;
constexpr size_t WS_T = 169 * MiB;
constexpr size_t WS_QC = 153 * MiB;
constexpr size_t WS_KVC = 159 * MiB;
constexpr size_t WS_FF = 165 * MiB;
constexpr size_t WS_FB = 181 * MiB;
constexpr size_t WS_HQ = 197 * MiB;
constexpr size_t WS_HV = 205 * MiB;
constexpr size_t WS_HG = 213 * MiB;
constexpr size_t WS_Q = 221 * MiB;
constexpr size_t WS_KN = 233 * MiB;
constexpr size_t WS_VT = 242 * MiB;
constexpr size_t WS_KRP = 251 * MiB;
constexpr size_t WS_END = 252 * MiB;

typedef __bf16 nbf16x2 __attribute__((ext_vector_type(2)));
__device__ __forceinline__ unsigned pk2(float lo, float hi) { f32x2 v = {lo, hi}; return __builtin_bit_cast(unsigned, __builtin_convertvector(v, nbf16x2)); }
__device__ __forceinline__ float bflo(unsigned w) { return __uint_as_float(w << 16); }
__device__ __forceinline__ float bfhi(unsigned w) { return __uint_as_float(w & 0xffff0000u); }
__device__ __forceinline__ float sigmf(float x) { return __builtin_amdgcn_rcpf(1.f + __builtin_amdgcn_exp2f(-1.4426950408889634f * x)); }
__device__ __forceinline__ float siluf(float x) { return x * sigmf(x); }
__device__ __forceinline__ float wave_sum(float v) {
#pragma unroll
    for (int o = 1; o < 64; o <<= 1) v += __shfl_xor(v, o);
    return v;
}
__device__ __forceinline__ f32x4 rope4(f32x4 x, float pos, int fq) {
    f32x4 p, o;
#pragma unroll
    for (int j = 0; j < 4; ++j) p[j] = __shfl_xor(x[j], 32);
    const bool lo = fq < 2;
    const bool hi4 = (fq & 1) != 0;
    const float inv0 = hi4 ? 0.01f : 1.0f, inv1 = hi4 ? 0.0031622776601683794f : 0.31622776601683794f,
                inv2 = hi4 ? 0.001f : 0.1f, inv3 = hi4 ? 0.00031622776601683794f : 0.031622776601683794f;
    const float iv[4] = {inv0, inv1, inv2, inv3};
#pragma unroll
    for (int j = 0; j < 4; ++j) {
        float rev = pos * iv[j] * 0.15915494309189535f;
        rev -= rintf(rev);
        const float s = __builtin_amdgcn_sinf(rev), c = __builtin_amdgcn_cosf(rev);
        o[j] = lo ? (x[j] * c - p[j] * s) : (x[j] * c + p[j] * s);
    }
    return o;
}

namespace pg8 {
constexpr int BM = 256, BK = 64, HALF = 128, HTB = HALF * BK * 2, STAGE_BYTES = 8 * HTB, NXCD = 8, WGM = 8;
__device__ __forceinline__ int lds_byte(int r, int c) { const int st = (r >> 4) * 2 + (c >> 5), rr = r & 15, cc = c & 31, ob = rr * 64 + cc * 2; return st * 1024 + (ob ^ (((ob >> 9) & 1) << 5)); }
__device__ __forceinline__ void stage_rc(int b, int& R, int& C) { const int st = b / 1024, sb = b % 1024, swz = sb ^ (((sb >> 9) & 1) << 5); R = (st >> 1) * 16 + swz / 64; C = (st & 1) * 32 + (swz % 64) / 2; }

struct Unit { int pm, pn, z; };
struct Gemm { const bf16_t* A; const bf16_t* Bt; int lda, ldb, K; size_t zA, zB; };

__device__ __forceinline__ void order_unit(int L, int nM, int nN, Unit& u) {
    const int nwg = nM * nN;
    u.z = L / nwg; int wgid = L - u.z * nwg;
    { const int q = nwg / NXCD, r = nwg % NXCD, xcd = wgid % NXCD, off = wgid / NXCD; wgid = (xcd < r ? xcd * (q + 1) : r * (q + 1) + (xcd - r) * q) + off; }
    const int nig = WGM * nN, gid = wgid / nig, fm = gid * WGM, gsz = (nM - fm) < WGM ? (nM - fm) : WGM;
    u.pm = fm + ((wgid % nig) % gsz); u.pn = (wgid % nig) / gsz;
}
struct GridOrder {
    int nM, nN, nZ, G, c, zpm;
    __device__ __forceinline__ bool next(int i, Unit& u) const {
        const int L = i * G + c; if (L >= nM * nN * nZ) return false;
        order_unit(L, nM, nN, u); if (zpm > 0) u.z = u.pm >= zpm ? 1 : 0; return true;
    }
};
struct SingleOrder {
    Unit u0;
    __device__ __forceinline__ bool next(int i, Unit& u) const { if (i != 0) return false; u = u0; return true; }
};

template <class Epi, class Sched>
__device__ __forceinline__ void gemm_phase(LAS unsigned char* lds, const Gemm g, const Sched& S, const Epi& E) {
    const int tid = threadIdx.x, wid = __builtin_amdgcn_readfirstlane(tid >> 6), lane = tid & 63, wr = wid >> 2, wc = wid & 3, fr = lane & 15, fq = lane >> 4;
    int K_ = g.K; asm volatile("" : "+s"(K_));
    const int nt = K_ / BK;
    unsigned voffA[2], voffB[2];
#pragma unroll
    for (int i = 0; i < 2; ++i) { int R, C; stage_rc(tid * 16 + i * 8192, R, C);
        voffA[i] = (unsigned)(R * g.lda + C) * 2u; voffB[i] = (unsigned)(R * g.ldb + C) * 2u; }
    const size_t kstep = (size_t)(BK * 2);
    const size_t hstepA = (size_t)HALF * g.lda * 2, hstepB = (size_t)HALF * g.ldb * 2;
    const size_t tstepA = 2 * hstepA, tstepB = 2 * hstepB;
    const unsigned ldsw = (unsigned)wid * 1024u;
    const int aoff = lds_byte(wr * 64 + fr, fq * 8), boff = lds_byte(wc * 32 + fr, fq * 8);
#define PG8_SA(b, h) (((b) * 2 + (h)) * HTB)
#define PG8_SB(b, h) ((4 + (b) * 2 + (h)) * HTB)
#define PG8_STAGE(bufoff, gbase, voff) do { _Pragma("unroll") for (int _i = 0; _i < 2; ++_i) \
        __builtin_amdgcn_global_load_lds((const unsigned*)((const char*)(gbase) + (voff)[_i]), (LAS unsigned*)(lds + (bufoff) + ldsw + _i * 8192), 16, 0, 0); } while (0)
#define PG8_LDA(dst, b, h) do { _Pragma("unroll") for (int m = 0; m < 4; ++m) _Pragma("unroll") for (int k = 0; k < 2; ++k) dst[m][k] = *(const LAS bf16x8*)(lds + PG8_SA(b, h) + aoff + m * 2048 + k * 1024); } while (0)
#define PG8_LDB(dst, b, h) do { _Pragma("unroll") for (int n = 0; n < 2; ++n) _Pragma("unroll") for (int k = 0; k < 2; ++k) dst[n][k] = *(const LAS bf16x8*)(lds + PG8_SB(b, h) + boff + n * 2048 + k * 1024); } while (0)
#define PG8_MMA(ai, bj, At, Bt) do { __builtin_amdgcn_s_setprio(1); _Pragma("unroll") for (int m = 0; m < 4; ++m) _Pragma("unroll") for (int n = 0; n < 2; ++n) _Pragma("unroll") for (int k = 0; k < 2; ++k) \
        acc[ai][bj][m][n] = __builtin_amdgcn_mfma_f32_16x16x32_bf16(Bt[n][k], At[m][k], acc[ai][bj][m][n], 0, 0, 0); __builtin_amdgcn_s_setprio(0); } while (0)
#define PG8_WAIT_V(n) asm volatile("s_waitcnt vmcnt(" #n ")" ::: "memory")
#define PG8_WAIT_L(n) asm volatile("s_waitcnt lgkmcnt(" #n ")" ::: "memory")
#define PG8_BAR __builtin_amdgcn_s_barrier()
#define PG8_SCHED __builtin_amdgcn_sched_barrier(0)
    Unit cur, nxt; int ui = 0;
    if (!S.next(0, cur)) return;
    f32x4 acc[2][2][4][2];
#pragma unroll
    for (int a = 0; a < 2; ++a)
#pragma unroll
        for (int b = 0; b < 2; ++b)
#pragma unroll
            for (int m = 0; m < 4; ++m)
#pragma unroll
                for (int n = 0; n < 2; ++n) acc[a][b][m][n] = (f32x4){0.f, 0.f, 0.f, 0.f};
    bf16x8 At[4][2], B0[2][2], B1[2][2];
    const char* cA = (const char*)g.A + (size_t)cur.z * g.zA + (size_t)cur.pm * tstepA;
    const char* cB = (const char*)g.Bt + (size_t)cur.z * g.zB + (size_t)cur.pn * tstepB;
    PG8_STAGE(PG8_SB(0, 0), cB, voffB); PG8_STAGE(PG8_SB(0, 1), cB + hstepB, voffB); PG8_STAGE(PG8_SA(0, 0), cA, voffA); PG8_STAGE(PG8_SA(0, 1), cA + hstepA, voffA);
    if (wr == 1) PG8_BAR;
    PG8_WAIT_V(2); PG8_BAR;
    PG8_STAGE(PG8_SB(1, 0), cB + kstep, voffB); PG8_STAGE(PG8_SA(1, 0), cA + kstep, voffA); PG8_STAGE(PG8_SB(1, 1), cB + hstepB + kstep, voffB);
    PG8_WAIT_V(6); PG8_BAR;
    for (;;) {
        const bool has_next = S.next(ui + 1, nxt);
        const char* nA = has_next ? (const char*)g.A + (size_t)nxt.z * g.zA + (size_t)nxt.pm * tstepA : cA;
        const char* nB = has_next ? (const char*)g.Bt + (size_t)nxt.z * g.zB + (size_t)nxt.pn * tstepB : cB;
        for (int t = 0; t < nt; t += 2) {
            const bool last = (t == nt - 2);
            const char* a1 = cA + (size_t)(t + 1) * kstep;
            const char* a2 = last ? nA : cA + (size_t)(t + 2) * kstep; const char* b2 = last ? nB : cB + (size_t)(t + 2) * kstep;
            const char* a3 = a2 + kstep; const char* b3 = b2 + kstep;
            PG8_LDB(B0, 0, 0); PG8_LDB(B1, 0, 1); PG8_SCHED; PG8_LDA(At, 0, 0); PG8_STAGE(PG8_SA(1, 1), a1 + hstepA, voffA);
            PG8_WAIT_V(8); PG8_WAIT_L(0); PG8_BAR; PG8_MMA(0, 0, At, B0); PG8_MMA(0, 1, At, B1); PG8_BAR; PG8_SCHED;
            PG8_LDA(At, 0, 1); PG8_STAGE(PG8_SB(0, 0), b2, voffB); PG8_STAGE(PG8_SB(0, 1), b2 + hstepB, voffB); PG8_STAGE(PG8_SA(0, 0), a2, voffA);
            PG8_WAIT_V(8); PG8_WAIT_L(0); PG8_BAR; PG8_MMA(1, 0, At, B0); PG8_MMA(1, 1, At, B1); PG8_BAR; PG8_SCHED;
            PG8_LDB(B0, 1, 0); PG8_LDB(B1, 1, 1); PG8_SCHED; PG8_LDA(At, 1, 0); PG8_STAGE(PG8_SA(0, 1), a2 + hstepA, voffA);
            PG8_WAIT_V(8); PG8_WAIT_L(0); PG8_BAR; PG8_MMA(0, 0, At, B0); PG8_MMA(0, 1, At, B1); PG8_BAR; PG8_SCHED;
            PG8_LDA(At, 1, 1); PG8_STAGE(PG8_SB(1, 0), b3, voffB); PG8_STAGE(PG8_SB(1, 1), b3 + hstepB, voffB); PG8_STAGE(PG8_SA(1, 0), a3, voffA);
            PG8_WAIT_V(8); PG8_WAIT_L(0); PG8_BAR; PG8_MMA(1, 0, At, B0); PG8_MMA(1, 1, At, B1); PG8_BAR; PG8_SCHED;
        }
        if (wr == 0) PG8_BAR;
        E(acc, cur, wr, wc, fr, fq);
        if (!has_next) break;
#pragma unroll
        for (int a = 0; a < 2; ++a)
#pragma unroll
            for (int b = 0; b < 2; ++b)
#pragma unroll
                for (int m = 0; m < 4; ++m)
#pragma unroll
                    for (int n = 0; n < 2; ++n) acc[a][b][m][n] = (f32x4){0.f, 0.f, 0.f, 0.f};
        cur = nxt; cA = nA; cB = nB; ++ui;
        if (wr == 1) PG8_BAR;
    }
    PG8_WAIT_V(0);
    PG8_BAR;
#undef PG8_SA
#undef PG8_SB
#undef PG8_STAGE
#undef PG8_LDA
#undef PG8_LDB
#undef PG8_MMA
#undef PG8_WAIT_V
#undef PG8_WAIT_L
#undef PG8_BAR
#undef PG8_SCHED
}

template <int ACT, bool F32>
__device__ __forceinline__ void tile_store(const f32x4 (&acc)[2][2][4][2], void* dst, int ld, int row0, int col0, const float* lbp) {
    f32x4 lb[2][2];
    if (ACT == 3) {
#pragma unroll
        for (int bj = 0; bj < 2; ++bj)
#pragma unroll
            for (int n = 0; n < 2; ++n) lb[bj][n] = *(const f32x4*)(lbp + bj * HALF + n * 16);
    }
#pragma unroll
    for (int ai = 0; ai < 2; ++ai)
#pragma unroll
        for (int m = 0; m < 4; ++m) {
            const size_t ro = (size_t)(row0 + ai * HALF + m * 16) * ld + col0;
#pragma unroll
            for (int bj = 0; bj < 2; ++bj)
#pragma unroll
                for (int n = 0; n < 2; ++n) {
                    f32x4 v = acc[ai][bj][m][n];
#pragma unroll
                    for (int j = 0; j < 4; ++j) {
                        if (ACT == 1) v[j] = siluf(v[j]);
                        if (ACT == 2) v[j] = sigmf(v[j]);
                        if (ACT == 3) v[j] = lb[bj][n][j] + (1.f - lb[bj][n][j]) * sigmf(v[j]);
                    }
                    if (F32) *(f32x4*)((float*)dst + ro + bj * HALF + n * 16) = v;
                    else { u32x2 w; w.x = pk2(v[0], v[1]); w.y = pk2(v[2], v[3]); *(u32x2*)((bf16_t*)dst + ro + bj * HALF + n * 16) = w; }
                }
            asm volatile("" ::: "memory");
        }
}

struct EpiSwiGLU {
    bf16_t* H;
    __device__ __forceinline__ void operator()(const f32x4 (&acc)[2][2][4][2], const Unit& u_, int wr, int wc, int fr, int fq) const {
        Unit u; u.pm = __builtin_amdgcn_readfirstlane(u_.pm); u.pn = __builtin_amdgcn_readfirstlane(u_.pn); u.z = __builtin_amdgcn_readfirstlane(u_.z); asm volatile("" : "+v"(fr), "+v"(fq), "+s"(u.pm), "+s"(u.pn), "+s"(u.z));
        const int row0 = u.pm * BM + wr * 64 + fr;
#pragma unroll
        for (int ai = 0; ai < 2; ++ai)
#pragma unroll
            for (int m = 0; m < 4; ++m) {
                bf16_t* rp = H + (size_t)(row0 + ai * HALF + m * 16) * DFF + 4 * fq;
#pragma unroll
                for (int bj = 0; bj < 2; ++bj) {
                    const int g = 8 * u.pn + 4 * bj + wc;
                    const f32x4 a = acc[ai][bj][m][0], b = acc[ai][bj][m][1];
                    u32x2 w; w.x = pk2(siluf(a[0]) * b[0], siluf(a[1]) * b[1]); w.y = pk2(siluf(a[2]) * b[2], siluf(a[3]) * b[3]);
                    *(u32x2*)(rp + 16 * g) = w;
                }
                asm volatile("" ::: "memory");
            }
    }
};
struct EpiPart {
    bf16_t* P;
    __device__ __forceinline__ void operator()(const f32x4 (&acc)[2][2][4][2], const Unit& u_, int wr, int wc, int fr, int fq) const {
        Unit u; u.pm = __builtin_amdgcn_readfirstlane(u_.pm); u.pn = __builtin_amdgcn_readfirstlane(u_.pn); u.z = __builtin_amdgcn_readfirstlane(u_.z); asm volatile("" : "+v"(fr), "+v"(fq), "+s"(u.pm), "+s"(u.pn), "+s"(u.z));
        tile_store<0, false>(acc, P + (size_t)u.z * NTOK * D, D, u.pm * BM + wr * 64 + fr, u.pn * BM + wc * 32 + 4 * fq, nullptr);
    }
};
struct EpiUp {
    bf16_t* T; const bf16_t* GATE;
    __device__ __forceinline__ void operator()(const f32x4 (&acc)[2][2][4][2], const Unit& u_, int wr, int wc, int fr, int fq) const {
        Unit u; u.pm = __builtin_amdgcn_readfirstlane(u_.pm); u.pn = __builtin_amdgcn_readfirstlane(u_.pn); u.z = __builtin_amdgcn_readfirstlane(u_.z); asm volatile("" : "+v"(fr), "+v"(fq), "+s"(u.pm), "+s"(u.pn), "+s"(u.z));
        const int row0 = u.pm * BM + wr * 64 + fr, col0 = u.pn * BM + wc * 32 + 4 * fq;
        const size_t zo = (size_t)u.z * NTOK * D;
#pragma unroll
        for (int ai = 0; ai < 2; ++ai)
#pragma unroll
            for (int m = 0; m < 4; ++m) {
                const size_t ro = zo + (size_t)(row0 + ai * HALF + m * 16) * D + col0;
#pragma unroll
                for (int bj = 0; bj < 2; ++bj)
#pragma unroll
                    for (int n = 0; n < 2; ++n) {
                        const u32x2 gw = *(const u32x2*)(GATE + ro + bj * HALF + n * 16);
                        const f32x4 v = acc[ai][bj][m][n];
                        u32x2 w; w.x = pk2(v[0] * bflo(gw.x), v[1] * bfhi(gw.x)); w.y = pk2(v[2] * bflo(gw.y), v[3] * bfhi(gw.y));
                        *(u32x2*)(T + ro + bj * HALF + n * 16) = w;
                    }
                asm volatile("" ::: "memory");
            }
    }
};
struct EpiIn {
    bf16_t *QC, *KVC, *HQ, *HV, *HG, *GATE, *KRP; float *FF, *FB, *KRO; const float* LB;
    __device__ __forceinline__ void operator()(const f32x4 (&acc)[2][2][4][2], const Unit& u_, int wr, int wc, int fr, int fq) const {
        Unit u; u.pm = __builtin_amdgcn_readfirstlane(u_.pm); u.pn = __builtin_amdgcn_readfirstlane(u_.pn); u.z = __builtin_amdgcn_readfirstlane(u_.z); asm volatile("" : "+v"(fr), "+v"(fq), "+s"(u.pm), "+s"(u.pn), "+s"(u.z));
        const int pn = u.pn, row0 = u.pm * BM + wr * 64 + fr, cw = wc * 32 + 4 * fq;
        if (pn == 0) { tile_store<0, false>(acc, QC, 384, row0, cw, nullptr); }
        else if (pn == 2) { tile_store<0, false>(acc, KVC, 256, row0, cw, nullptr); }
        else if (pn == 1) {
#pragma unroll
            for (int ai = 0; ai < 2; ++ai)
#pragma unroll
                for (int m = 0; m < 4; ++m) {
                    const int row = row0 + ai * HALF + m * 16;
#pragma unroll
                    for (int n = 0; n < 2; ++n) { const f32x4 v = acc[ai][0][m][n]; u32x2 w; w.x = pk2(v[0], v[1]); w.y = pk2(v[2], v[3]);
                        *(u32x2*)(QC + (size_t)row * 384 + 256 + cw + n * 16) = w; }
                    if (wc == 0) {
                        f32x4 v0 = acc[ai][1][m][0], v1 = acc[ai][1][m][1];
                        int kidx;
                        if (u.pm >= 16) { const int t = (row - NCTX) & 2047; v0 = rope4(v0, (float)(t >> 6), fq); v1 = rope4(v1, (float)(t & 63), fq);
                            kidx = NCTX + ((row - NCTX) >> 11) * 2304 + 256 + t; }
                        else { kidx = row; *(f32x4*)(KRO + (size_t)row * 32 + 4 * fq) = v0; *(f32x4*)(KRO + (size_t)row * 32 + 16 + 4 * fq) = v1; }
                        u32x2 w; w.x = pk2(v0[0], v0[1]); w.y = pk2(v0[2], v0[3]); *(u32x2*)(KRP + (size_t)kidx * 32 + 4 * fq) = w;
                        w.x = pk2(v1[0], v1[1]); w.y = pk2(v1[2], v1[3]); *(u32x2*)(KRP + (size_t)kidx * 32 + 16 + 4 * fq) = w;
                    }
                    asm volatile("" ::: "memory");
                }
        }
        else if (pn <= 12) {
            const int seg = (pn - 3) >> 1, c0 = ((pn - 3) & 1) * 256 + cw;
            if (seg == 0) tile_store<1, false>(acc, HQ, 512, row0, c0, nullptr);
            else if (seg == 1) tile_store<3, true>(acc, FF, 512, row0, c0, LB + c0);
            else if (seg == 2) tile_store<3, true>(acc, FB, 512, row0, c0, LB + 512 + c0);
            else if (seg == 3) tile_store<0, false>(acc, HV, 512, row0, c0, nullptr);
            else tile_store<1, false>(acc, HG, 512, row0, c0, nullptr);
        }
        else { const int z = (pn - 13) >> 2, c0 = ((pn - 13) & 3) * 256 + cw;
            tile_store<2, false>(acc, GATE + (size_t)z * NTOK * D, D, row0, c0, nullptr); }
    }
};
struct EpiQ {
    bf16_t* Q; const float* rinv;
    __device__ __forceinline__ void operator()(const f32x4 (&acc)[2][2][4][2], const Unit& u_, int wr, int wc, int fr, int fq) const {
        Unit u; u.pm = __builtin_amdgcn_readfirstlane(u_.pm); u.pn = __builtin_amdgcn_readfirstlane(u_.pn); u.z = __builtin_amdgcn_readfirstlane(u_.z); asm volatile("" : "+v"(fr), "+v"(fq), "+s"(u.pm), "+s"(u.pn), "+s"(u.z));
#pragma unroll
        for (int ai = 0; ai < 2; ++ai)
#pragma unroll
            for (int m = 0; m < 4; ++m) {
                const int rl = ai * HALF + wr * 64 + m * 16 + fr, row = u.pm * BM + rl;
                const float ri = rinv[row];
#pragma unroll
                for (int bj = 0; bj < 2; ++bj) {
                    const int g32 = 8 * u.pn + 4 * bj + wc;
                    const f32x4 v0 = acc[ai][bj][m][0] * ri, v1 = acc[ai][bj][m][1] * ri;
                    bf16_t* p = Q + (size_t)row * 768 + g32 * 32 + 4 * fq;
                    u32x2 w; w.x = pk2(v0[0], v0[1]); w.y = pk2(v0[2], v0[3]); *(u32x2*)p = w;
                    w.x = pk2(v1[0], v1[1]); w.y = pk2(v1[2], v1[3]); *(u32x2*)(p + 16) = w;
                }
                asm volatile("" ::: "memory");
            }
    }
};
struct EpiKV {
    bf16_t *KN, *VT; const float* rinv;
    __device__ __forceinline__ void operator()(const f32x4 (&acc)[2][2][4][2], const Unit& u_, int wr, int wc, int fr, int fq) const {
        Unit u; u.pm = __builtin_amdgcn_readfirstlane(u_.pm); u.pn = __builtin_amdgcn_readfirstlane(u_.pn); u.z = 0; asm volatile("" : "+v"(fr), "+v"(fq), "+s"(u.pm), "+s"(u.pn));
        const int pm = u.pm;
        int ab, kidx0;
        if (pm < 16) { ab = pm; kidx0 = pm * 256; }
        else if (pm < 32) { ab = 16 + ((pm - 16) >> 3); kidx0 = NCTX + (ab - 16) * 2304 + 256 + ((pm - 16) & 7) * 256; }
        else { ab = 16 + (pm - 32); kidx0 = NCTX + (ab - 16) * 2304; }
        const int Tk = ab < 16 ? 256 : 2304;
        const int j0 = kidx0 - (ab < 16 ? ab * 256 : NCTX + (ab - 16) * 2304);
#pragma unroll
        for (int bj = 0; bj < 2; ++bj) {
            const int h = 2 * u.pn + bj;
            if (wc < 2) {
                bf16_t* base = KN + (size_t)kidx0 * 512 + h * 64 + wc * 32 + 4 * fq;
#pragma unroll
                for (int ai = 0; ai < 2; ++ai)
#pragma unroll
                    for (int m = 0; m < 4; ++m) {
                        const int rl = ai * HALF + wr * 64 + m * 16 + fr;
                        const float ri = rinv[pm * BM + rl];
#pragma unroll
                        for (int n = 0; n < 2; ++n) {
                            const f32x4 v = acc[ai][bj][m][n] * ri;
                            u32x2 w; w.x = pk2(v[0], v[1]); w.y = pk2(v[2], v[3]);
                            *(u32x2*)(base + (size_t)rl * 512 + n * 16) = w;
                        }
                        asm volatile("" ::: "memory");
                    }
            } else {
                const size_t vb = ab < 16 ? (size_t)(ab * 8 + h) * 64 * 256 : (size_t)16 * 8 * 64 * 256 + (size_t)((ab - 16) * 8 + h) * 64 * 2304;
                bf16_t* base = VT + vb + (size_t)((wc - 2) * 32 + 4 * fq) * Tk + j0;
#pragma unroll
                for (int ai = 0; ai < 2; ++ai)
#pragma unroll
                    for (int m = 0; m < 4; ++m) {
                        const int rl = ai * HALF + wr * 64 + m * 16 + fr;
                        const float ri = rinv[pm * BM + rl];
#pragma unroll
                        for (int n = 0; n < 2; ++n) {
                            const f32x4 v = acc[ai][bj][m][n] * ri;
                            const unsigned w0 = pk2(v[0], v[1]), w1 = pk2(v[2], v[3]);
                            bf16_t* vp = base + (size_t)(n * 16) * Tk + rl;
                            vp[0] = (bf16_t)(w0 & 0xffffu); vp[Tk] = (bf16_t)(w0 >> 16); vp[2 * Tk] = (bf16_t)(w1 & 0xffffu); vp[3 * Tk] = (bf16_t)(w1 >> 16);
                        }
                        asm volatile("" ::: "memory");
                    }
            }
        }
    }
};
}

struct Args { const float* in[27]; float* out; unsigned char* ws; };
enum { I_XP = 0, I_XS, I_CCKV, I_CKR, I_ST, I_C, I_CCTX, I_WADA, I_BADA, I_NORMG, I_F1W1, I_F1W3, I_F1W2, I_F2W1, I_F2W3, I_F2W2, I_WIN, I_QNG, I_WQB, I_KVNG, I_WKVB,
       I_WUPA, I_HGGAMMA, I_HGNG, I_WUPR, I_WOUT, I_FING };

__device__ __forceinline__ int map_row(int mode, int n) {
    if (mode == 1) return 32 * (n >> 4) + (n & 15);
    if (mode == 2) return 32 * (n >> 4) + 16 + (n & 15);
    if (mode == 3) return n < 384 ? n : (n < 640 ? n + 128 : (n < 672 ? n - 256 : n + 96));
    return n;
}
__device__ __forceinline__ void tr_item(const float* W, int K, int N, bf16_t* WT, int mode, const float* ksc, LAS float* scr, int item, int lane) {
    const int nblk = N / 32, kb = item / nblk, nb = item % nblk, k0 = 64 * kb, n0 = 32 * nb;
    float tv[32];
#pragma unroll
    for (int i = 0; i < 32; ++i) { const int kk = 2 * i + (lane >> 5); tv[i] = W[(size_t)(k0 + kk) * N + n0 + (lane & 31)]; }
#pragma unroll
    for (int i = 0; i < 32; ++i) { const int kk = 2 * i + (lane >> 5); float v = tv[i]; if (ksc) v *= ksc[k0 + kk]; scr[kk * 33 + (lane & 31)] = v; }
    asm volatile("s_waitcnt lgkmcnt(0)" ::: "memory");
    const int c = lane & 7;
#pragma unroll
    for (int j = 0; j < 4; ++j) { const int n = (lane >> 3) + 8 * j; const LAS float* s = scr + (8 * c) * 33 + n;
        u32x4 o; o.x = pk2(s[0 * 33], s[1 * 33]); o.y = pk2(s[2 * 33], s[3 * 33]); o.z = pk2(s[4 * 33], s[5 * 33]); o.w = pk2(s[6 * 33], s[7 * 33]);
        *(u32x4*)(WT + (size_t)map_row(mode, n0 + n) * K + k0 + 8 * c) = o; }
    asm volatile("s_waitcnt lgkmcnt(0)" ::: "memory");
}

constexpr int TRI_F = 1408, TRI_IN = 2640, TRI_QB = 144, TRI_KVB = 128, TRI_UP = 256, TRI_OUT = 512;
constexpr int TR_A0 = 0, TR_A1 = 2 * TRI_F;
constexpr int TR_B0 = TR_A1, TR_B1 = TR_B0 + TRI_F + TRI_IN;
constexpr int TR_C0 = TR_B1, TR_C1 = TR_C0 + 3 * TRI_F + TRI_QB + 2 * TRI_KVB + 2 * TRI_UP + TRI_OUT;
__device__ __forceinline__ void tr_range(const Args& a, LAS unsigned char* lds, int lo, int hi, int gw, int nw) {
    const int lane = threadIdx.x & 63, wave = threadIdx.x >> 6;
    unsigned char* ws = a.ws;
    LAS float* scr = (LAS float*)(lds + wave * 8448);
    for (int it = lo + gw; it < hi; it += nw) {
        int r = it;
        if (r < TRI_F) { tr_item(a.in[I_F1W1], 1024, DFF, (bf16_t*)(ws + WS_W1A), 1, nullptr, scr, r, lane); continue; } r -= TRI_F;
        if (r < TRI_F) { tr_item(a.in[I_F1W3], 1024, DFF, (bf16_t*)(ws + WS_W1A), 2, nullptr, scr, r, lane); continue; } r -= TRI_F;
        if (r < TRI_F) { tr_item(a.in[I_F1W2], DFF, 1024, (bf16_t*)(ws + WS_W1B), 0, nullptr, scr, r, lane); continue; } r -= TRI_F;
        if (r < TRI_IN) { tr_item(a.in[I_WIN], 1024, DIN, (bf16_t*)(ws + WS_WIN), 3, nullptr, scr, r, lane); continue; } r -= TRI_IN;
        if (r < TRI_F) { tr_item(a.in[I_F2W1], 1024, DFF, (bf16_t*)(ws + WS_W2A), 1, nullptr, scr, r, lane); continue; } r -= TRI_F;
        if (r < TRI_F) { tr_item(a.in[I_F2W3], 1024, DFF, (bf16_t*)(ws + WS_W2A), 2, nullptr, scr, r, lane); continue; } r -= TRI_F;
        if (r < TRI_F) { tr_item(a.in[I_F2W2], DFF, 1024, (bf16_t*)(ws + WS_W2B), 0, nullptr, scr, r, lane); continue; } r -= TRI_F;
        if (r < TRI_QB) { tr_item(a.in[I_WQB], 384, 768, (bf16_t*)(ws + WS_WQB), 0, a.in[I_QNG], scr, r, lane); continue; } r -= TRI_QB;
        if (r < TRI_KVB) { tr_item(a.in[I_WKVB], 256, 1024, (bf16_t*)(ws + WS_WKVB), 0, a.in[I_KVNG], scr, r, lane); continue; } r -= TRI_KVB;
        if (r < TRI_KVB) { tr_item(a.in[I_WKVB], 256, 1024, (bf16_t*)(ws + WS_WKVB) + 1024 * 256, 0, nullptr, scr, r, lane); continue; } r -= TRI_KVB;
        if (r < TRI_UP) { tr_item(a.in[I_WUPA], 512, 1024, (bf16_t*)(ws + WS_WUP), 0, nullptr, scr, r, lane); continue; } r -= TRI_UP;
        if (r < TRI_UP) { tr_item(a.in[I_WUPR], 512, 1024, (bf16_t*)(ws + WS_WUP) + 1024 * 512, 0, nullptr, scr, r, lane); continue; } r -= TRI_UP;
        tr_item(a.in[I_WOUT], 1024, 1024, (bf16_t*)(ws + WS_WOUT), 0, nullptr, scr, r, lane);
    }
}
__device__ __forceinline__ void tr_in_tail(const Args& a, LAS unsigned char* lds, int nunits, int lo, int hi, int G) {
    const int r = nunits % G, wave = threadIdx.x >> 6;
    if (r == 0) tr_range(a, lds, lo, hi, (int)blockIdx.x * 8 + wave, G * 8);
    else if ((int)blockIdx.x >= r) tr_range(a, lds, lo, hi, ((int)blockIdx.x - r) * 8 + wave, (G - r) * 8);
}

__device__ __forceinline__ void phase_prep(const Args& a, LAS unsigned char* lds, int G) {
    const int tid = threadIdx.x, lane = tid & 63, wave = tid >> 6;
    unsigned char* ws = a.ws;
    for (int nb = blockIdx.x; nb < 72; nb += G) {
        LAS float* sc = (LAS float*)lds;
        for (int i = tid; i < 3072; i += NTHR) { const int s = i >> 10, k = i & 1023; const float v = (s == 0) ? a.in[I_CCTX][k] : a.in[I_C][(s - 1) * 1024 + k]; sc[i] = siluf(v); }
        __syncthreads();
        const float* wp = a.in[I_WADA] + (size_t)(wave * 128) * 9216 + nb * 128 + 2 * lane;
        float a00 = 0.f, a01 = 0.f, a10 = 0.f, a11 = 0.f, a20 = 0.f, a21 = 0.f;
#pragma unroll 32
        for (int kk = 0; kk < 128; ++kk) {
            const f32x2 w = *(const f32x2*)(wp + (size_t)kk * 9216);
            const float s0 = sc[wave * 128 + kk], s1 = sc[1024 + wave * 128 + kk], s2 = sc[2048 + wave * 128 + kk];
            a00 += s0 * w.x; a01 += s0 * w.y; a10 += s1 * w.x; a11 += s1 * w.y; a20 += s2 * w.x; a21 += s2 * w.y;
        }
        LAS float* red = sc + 3072;
        red[(wave * 3 + 0) * 128 + 2 * lane] = a00; red[(wave * 3 + 0) * 128 + 2 * lane + 1] = a01;
        red[(wave * 3 + 1) * 128 + 2 * lane] = a10; red[(wave * 3 + 1) * 128 + 2 * lane + 1] = a11;
        red[(wave * 3 + 2) * 128 + 2 * lane] = a20; red[(wave * 3 + 2) * 128 + 2 * lane + 1] = a21;
        __syncthreads();
        for (int i = tid; i < 384; i += NTHR) { const int s = i >> 7, col = i & 127; float v = a.in[I_BADA][nb * 128 + col];
#pragma unroll
            for (int w = 0; w < 8; ++w) v += red[(w * 3 + s) * 128 + col];
            ((float*)(ws + WS_MOD))[s * 9216 + nb * 128 + col] = v; }
        __syncthreads();
    }
    {
        const int nskip = G >= 144 ? 72 : 0;
        const int gw = ((int)blockIdx.x - nskip) * 8 + wave;
        if (gw >= 0) tr_range(a, lds, TR_A0, TR_A1, gw, (G - nskip) * 8);
    }
    {
        const int gt = blockIdx.x * NTHR + tid, NT = G * NTHR;
        for (int i = gt; i < 1024; i += NT) { const int dir = i >> 9, n = i & 511; const float g0 = a.in[I_HGGAMMA][dir * 1024 + n], g1 = a.in[I_HGGAMMA][dir * 1024 + 512 + n];
            ((float*)(ws + WS_LB))[i] = 1.f / (1.f + __expf(g1 - g0)); }
        for (int i = gt; i < 96 * 1024 / 2; i += NT) ((unsigned*)(ws + WS_WIN) + (size_t)416 * 1024 / 2)[i] = 0u;
        for (int i = gt; i < 512 * 32 / 2; i += NT) { const int e = 2 * i, r = e >> 5, cc = e & 31, b = r >> 8, j = r & 255; const f32x2 v = *(const f32x2*)(a.in[I_CKR] + e);
            *(unsigned*)((bf16_t*)(ws + WS_KRP) + (size_t)(NCTX + b * 2304 + j) * 32 + cc) = pk2(v.x, v.y); }
    }
}

template <int MODE>
__device__ __forceinline__ void phase_norm(const Args& a, int G) {
    const int tid = threadIdx.x, lane = tid & 63, wave = tid >> 6;
    unsigned char* ws = a.ws;
    const float* MOD = (const float*)(ws + WS_MOD);
    bf16_t* X = (bf16_t*)(ws + WS_X);
    const bf16_t* P0 = (const bf16_t*)(ws + WS_PART); const bf16_t* P1 = P0 + (size_t)NTOK * D;
    bf16_t* XN = (bf16_t*)(ws + WS_XN);
    constexpr int GI = MODE == 2 ? 2 : (MODE == 3 ? 5 : 8);
    constexpr float GS = MODE == 3 ? 1.0f : 0.5f;
    constexpr int SH = MODE == 1 ? 0 : (MODE == 2 ? 3 : 6), SC = SH + 1;
    for (int rb = blockIdx.x * 8 + wave; rb < NTOK / 4; rb += G * 8) {
        const int row0 = rb * 4;
        const int s = row0 < NCTX ? 0 : 1 + ((row0 - NCTX) >> 11);
        const float* md = MOD + (size_t)s * 9216;
        f32x4 v[4][4]; float ss[4] = {0.f, 0.f, 0.f, 0.f};
        f32x4 gt[4];
        if (MODE != 1) {
#pragma unroll
            for (int j = 0; j < 4; ++j) gt[j] = *(const f32x4*)(md + GI * 1024 + 4 * lane + 256 * j) * GS;
        }
#pragma unroll
        for (int i = 0; i < 4; ++i) {
            const int row = row0 + i;
            const float* xsrc = row < NCTX ? a.in[I_XP] + (size_t)row * D : a.in[I_XS] + (size_t)(row - NCTX) * D;
#pragma unroll
            for (int j = 0; j < 4; ++j) {
                const int c = 4 * lane + 256 * j;
                if (MODE == 1 || MODE == 2) v[i][j] = *(const f32x4*)(xsrc + c);
                else { const u32x2 xw = *(const u32x2*)(X + (size_t)row * D + c); v[i][j].x = bflo(xw.x); v[i][j].y = bfhi(xw.x); v[i][j].z = bflo(xw.y); v[i][j].w = bfhi(xw.y); }
                if (MODE != 1) {
                    const u32x2 q0 = *(const u32x2*)(P0 + (size_t)row * D + c), q1 = *(const u32x2*)(P1 + (size_t)row * D + c);
                    f32x4 ps; ps.x = bflo(q0.x) + bflo(q1.x); ps.y = bfhi(q0.x) + bfhi(q1.x); ps.z = bflo(q0.y) + bflo(q1.y); ps.w = bfhi(q0.y) + bfhi(q1.y);
                    v[i][j] = v[i][j] + gt[j] * ps;
                }
            }
        }
#pragma unroll
        for (int i = 0; i < 4; ++i) {
#pragma unroll
            for (int j = 0; j < 4; ++j) ss[i] += (v[i][j].x * v[i][j].x + v[i][j].y * v[i][j].y) + (v[i][j].z * v[i][j].z + v[i][j].w * v[i][j].w);
        }
#pragma unroll
        for (int o = 1; o < 64; o <<= 1) {
#pragma unroll
            for (int i = 0; i < 4; ++i) ss[i] += __shfl_xor(ss[i], o);
        }
        float rinv[4];
#pragma unroll
        for (int i = 0; i < 4; ++i) rinv[i] = rsqrtf(ss[i] * (1.f / D) + EPS);
#pragma unroll
        for (int j = 0; j < 4; ++j) {
            const int c = 4 * lane + 256 * j;
            if (MODE == 4) {
                const f32x4 g = *(const f32x4*)(a.in[I_FING] + c);
#pragma unroll
                for (int i = 0; i < 4; ++i) *(f32x4*)(a.out + OY + (size_t)(row0 + i) * D + c) = v[i][j] * rinv[i] * g;
            } else {
                const f32x4 g = *(const f32x4*)(a.in[I_NORMG] + (MODE - 1) * 1024 + c), sh = *(const f32x4*)(md + SH * 1024 + c), sc = *(const f32x4*)(md + SC * 1024 + c);
                const f32x4 gs = g * (1.f + sc);
#pragma unroll
                for (int i = 0; i < 4; ++i) {
                    const f32x4 o = v[i][j] * rinv[i] * gs + sh;
                    u32x2 w; w.x = pk2(o.x, o.y); w.y = pk2(o.z, o.w);
                    *(u32x2*)(XN + (size_t)(row0 + i) * D + c) = w;
                    if (MODE == 2 || MODE == 3) { u32x2 xw; xw.x = pk2(v[i][j].x, v[i][j].y); xw.y = pk2(v[i][j].z, v[i][j].w); *(u32x2*)(X + (size_t)(row0 + i) * D + c) = xw; }
                }
            }
        }
    }
}

constexpr int AT_KN = 0, AT_KR = 8192, AT_VT = 12288, AT_STAGE = 20480;
__device__ __forceinline__ void attn_item(LAS unsigned char* lds, const bf16_t* Q, const bf16_t* KN, const bf16_t* KRP, const bf16_t* VT, bf16_t* O, int ab, int h, int qt) {
    const int tid = threadIdx.x, lane = tid & 63, wave = __builtin_amdgcn_readfirstlane(tid >> 6), fr = lane & 15, fq = lane >> 4;
    const int Tk = ab < 16 ? 256 : 2304;
    const int kbase = ab < 16 ? ab * 256 : NCTX + (ab - 16) * 2304;
    const size_t vbase = ab < 16 ? (size_t)(ab * 8 + h) * 64 * 256 : (size_t)16 * 8 * 64 * 256 + (size_t)((ab - 16) * 8 + h) * 64 * 2304;
    const int qrow = (ab < 16 ? ab * 256 : NCTX + (ab - 16) * 2048) + qt * 128 + wave * 16 + fr;
    bf16x8 qf[3];
#pragma unroll
    for (int ks = 0; ks < 3; ++ks) qf[ks] = *(const bf16x8*)(Q + (size_t)qrow * 768 + h * 96 + ks * 32 + fq * 8);
    if (ab >= 16) {
        const int t = qt * 128 + wave * 16 + fr;
        const float pos = fq < 2 ? (float)(t >> 6) : (float)(t & 63);
        const u32x4 w = __builtin_bit_cast(u32x4, qf[2]);
        u32x4 pw; pw.x = __shfl_xor(w.x, 16); pw.y = __shfl_xor(w.y, 16); pw.z = __shfl_xor(w.z, 16); pw.w = __shfl_xor(w.w, 16);
        const float x[8] = {bflo(w.x), bfhi(w.x), bflo(w.y), bfhi(w.y), bflo(w.z), bfhi(w.z), bflo(w.w), bfhi(w.w)};
        const float pp[8] = {bflo(pw.x), bfhi(pw.x), bflo(pw.y), bfhi(pw.y), bflo(pw.z), bfhi(pw.z), bflo(pw.w), bfhi(pw.w)};
        const float iv[8] = {1.0f, 0.31622776601683794f, 0.1f, 0.031622776601683794f, 0.01f, 0.0031622776601683794f, 0.001f, 0.00031622776601683794f};
        float o[8];
#pragma unroll
        for (int i = 0; i < 8; ++i) {
            float rev = pos * iv[i] * 0.15915494309189535f; rev -= rintf(rev);
            const float s = __builtin_amdgcn_sinf(rev), c = __builtin_amdgcn_cosf(rev);
            o[i] = (fq & 1) ? (x[i] * c + pp[i] * s) : (x[i] * c - pp[i] * s);
        }
        u32x4 ow; ow.x = pk2(o[0], o[1]); ow.y = pk2(o[2], o[3]); ow.z = pk2(o[4], o[5]); ow.w = pk2(o[6], o[7]);
        qf[2] = __builtin_bit_cast(bf16x8, ow);
    }
    const int nt = Tk / 64;
    const int kk = wave * 8 + (lane >> 3), kc = (lane & 7) ^ (kk & 7);
    const char* gk = (const char*)(KN + (size_t)(kbase + kk) * 512 + h * 64 + kc * 8);
    const int rk = (wave & 3) * 16 + (lane >> 2), rc = (lane & 3) ^ ((rk >> 2) & 3);
    const char* gr = (const char*)(KRP + (size_t)(kbase + rk) * 32 + rc * 8);
    const int vd = wave * 8 + (lane >> 3), vc = (lane & 7) ^ (vd & 7);
    const char* gv = (const char*)(VT + vbase + (size_t)vd * Tk + vc * 8);
    const unsigned ldk = AT_KN + wave * 1024, ldr = AT_KR + (wave & 3) * 1024, ldv = AT_VT + wave * 1024;
#define AT_ISSUE(tile, stg) do { const int _t = (tile) < nt ? (tile) : nt - 1; const unsigned _s = (unsigned)(stg) * AT_STAGE; \
        __builtin_amdgcn_global_load_lds((const unsigned*)(gk + (size_t)_t * 65536), (LAS unsigned*)(lds + _s + ldk), 16, 0, 0); \
        __builtin_amdgcn_global_load_lds((const unsigned*)(gr + (size_t)_t * 4096), (LAS unsigned*)(lds + _s + ldr), 16, 0, 0); \
        __builtin_amdgcn_global_load_lds((const unsigned*)(gv + (size_t)_t * 128), (LAS unsigned*)(lds + _s + ldv), 16, 0, 0); } while (0)
    asm volatile("s_waitcnt vmcnt(0) lgkmcnt(0)" ::: "memory");
    __builtin_amdgcn_s_barrier();
    AT_ISSUE(0, 0); AT_ISSUE(1, 1);
    f32x4 oacc[4];
#pragma unroll
    for (int i = 0; i < 4; ++i) oacc[i] = (f32x4){0.f, 0.f, 0.f, 0.f};
    float mrun = -INFINITY, lrun = 0.f;
    const float cs = 0.10206207261596577f * 1.4426950408889634f;
    const int sw7 = fr & 7, sw3 = (fr >> 2) & 3;
    int stg = 0;
    for (int t = 0; t < nt; ++t) {
        asm volatile("s_waitcnt vmcnt(3)" ::: "memory");
        __builtin_amdgcn_s_barrier();
        asm volatile("" ::: "memory");
        { const int s2 = stg >= 1 ? stg - 1 : 2; AT_ISSUE(t + 2, s2); }
        const LAS unsigned char* sb = lds + stg * AT_STAGE;
        f32x4 s[4];
#pragma unroll
        for (int kb = 0; kb < 4; ++kb) {
            s[kb] = (f32x4){0.f, 0.f, 0.f, 0.f};
            const int key = kb * 16 + fr;
#pragma unroll
            for (int ks = 0; ks < 2; ++ks) {
                const bf16x8 kf = *(const LAS bf16x8*)(sb + AT_KN + key * 128 + (((ks * 4 + fq) ^ sw7) * 16));
                s[kb] = __builtin_amdgcn_mfma_f32_16x16x32_bf16(kf, qf[ks], s[kb], 0, 0, 0);
            }
            const bf16x8 kr = *(const LAS bf16x8*)(sb + AT_KR + key * 64 + ((fq ^ sw3) * 16));
            s[kb] = __builtin_amdgcn_mfma_f32_16x16x32_bf16(kr, qf[2], s[kb], 0, 0, 0);
        }
        float mx = fmaxf(fmaxf(s[0][0], s[0][1]), fmaxf(s[0][2], s[0][3]));
#pragma unroll
        for (int kb = 1; kb < 4; ++kb) mx = fmaxf(mx, fmaxf(fmaxf(s[kb][0], s[kb][1]), fmaxf(s[kb][2], s[kb][3])));
        mx = fmaxf(mx, __shfl_xor(mx, 16)); mx = fmaxf(mx, __shfl_xor(mx, 32));
        const float mn = fmaxf(mrun, mx);
        const float alpha = __builtin_amdgcn_exp2f((mrun - mn) * cs);
        mrun = mn;
        const float mc = mn * cs;
        float ps = 0.f;
#pragma unroll
        for (int kb = 0; kb < 4; ++kb)
#pragma unroll
            for (int j = 0; j < 4; ++j) { const float p = __builtin_amdgcn_exp2f(s[kb][j] * cs - mc); s[kb][j] = p; ps += p; }
        lrun = lrun * alpha + ps;
#pragma unroll
        for (int i = 0; i < 4; ++i) oacc[i] = oacc[i] * alpha;
        bf16x8 pf[2];
#pragma unroll
        for (int kp2 = 0; kp2 < 2; ++kp2) {
            u32x4 w; w.x = pk2(s[2 * kp2][0], s[2 * kp2][1]); w.y = pk2(s[2 * kp2][2], s[2 * kp2][3]);
            w.z = pk2(s[2 * kp2 + 1][0], s[2 * kp2 + 1][1]); w.w = pk2(s[2 * kp2 + 1][2], s[2 * kp2 + 1][3]);
            pf[kp2] = __builtin_bit_cast(bf16x8, w);
        }
#pragma unroll
        for (int db = 0; db < 4; ++db)
#pragma unroll
            for (int kp2 = 0; kp2 < 2; ++kp2) {
                const int d = db * 16 + fr, c0 = kp2 * 4 + (fq >> 1);
                const LAS unsigned char* vb = sb + AT_VT + d * 128 + (fq & 1) * 8;
                const u32x2 lo = *(const LAS u32x2*)(vb + ((c0 ^ sw7) * 16)), hi = *(const LAS u32x2*)(vb + (((c0 + 2) ^ sw7) * 16));
                u32x4 w; w.x = lo.x; w.y = lo.y; w.z = hi.x; w.w = hi.y;
                oacc[db] = __builtin_amdgcn_mfma_f32_16x16x32_bf16(__builtin_bit_cast(bf16x8, w), pf[kp2], oacc[db], 0, 0, 0);
            }
        stg = stg == 2 ? 0 : stg + 1;
    }
    asm volatile("s_waitcnt vmcnt(0)" ::: "memory");
    lrun += __shfl_xor(lrun, 16); lrun += __shfl_xor(lrun, 32);
    const float il = 1.f / lrun;
#pragma unroll
    for (int db = 0; db < 4; ++db) {
        u32x2 w; w.x = pk2(oacc[db][0] * il, oacc[db][1] * il); w.y = pk2(oacc[db][2] * il, oacc[db][3] * il);
        *(u32x2*)(O + (size_t)qrow * 512 + h * 64 + db * 16 + fq * 4) = w;
    }
#undef AT_ISSUE
}

typedef short s16x4 __attribute__((ext_vector_type(4)));
constexpr int HW_QE = 0, HW_KE = 2304, HW_KGT = 4608, HW_VT = 7680, HW_EG = 10752, HW_BYTES = 11008;
constexpr int HG_OB = 0, HG_WL = 65536;
__device__ __forceinline__ bf16_t f2bf(float x) { return (bf16_t)(pk2(x, 0.f) & 0xffffu); }
constexpr int HG_RAW = 88064;
template <bool WITH_O>
__device__ __forceinline__ void hgrn_block_scan(f32x4 (&S)[4][4], float& dtot, LAS unsigned char* lds, const bf16_t* HQ, const bf16_t* HV, const float* FF, const float* FB, int row0, int h) {
    const int tid = threadIdx.x, lane = tid & 63, wave = __builtin_amdgcn_readfirstlane(tid >> 6), fr = lane & 15, quad = lane >> 4;
    const bool scanner = wave < 2;
    const int dir = wave & 1;
#define HG_BAR() do { asm volatile("s_waitcnt lgkmcnt(0)" ::: "memory"); __builtin_amdgcn_s_barrier(); asm volatile("" ::: "memory"); } while (0)
    if (!scanner) {
        const int lt = tid - 128;
        const char* lsrc[3]; int ldst[3]; int lstep[3]; bool lval[3];
#pragma unroll
        for (int j = 0; j < 3; ++j) {
            const int i = lt + 384 * j; const int d = (i >> 9) & 1, r = i & 511;
            lval[j] = i < 1024 && (WITH_O || r < 256 || r >= 384);
            int row, dst; const char* s;
            if (r < 256) { row = r >> 4; const int ch = r & 15; s = (const char*)((d ? FB : FF) + (size_t)row0 * 512 + h * 64 + ch * 4); dst = ch * 16; lstep[j] = 2048; }
            else if (r < 384) { const int r2 = r - 256; row = r2 >> 3; const int ch = r2 & 7; s = (const char*)(HQ + (size_t)row0 * 512 + h * 64 + ch * 8); dst = 4096 + ch * 16; lstep[j] = 1024; }
            else { const int r2 = r - 384; row = r2 >> 3; const int ch = r2 & 7; s = (const char*)(HV + (size_t)row0 * 512 + h * 64 + ch * 8); dst = 6144 + ch * 16; lstep[j] = 1024; }
            const int rowbytes = r < 256 ? 256 : 128;
            lsrc[j] = s + (size_t)((d ? 240 : 0) + row) * lstep[j];
            lstep[j] = (d ? -16 : 16) * lstep[j];
            ldst[j] = d * 8192 + dst + (d ? 15 - row : row) * rowbytes;
        }
        u32x4 lnxt[3];
#pragma unroll
        for (int j = 0; j < 3; ++j) if (lval[j]) lnxt[j] = *(const u32x4*)lsrc[j];
#pragma unroll
        for (int j = 0; j < 3; ++j) if (lval[j]) *(LAS u32x4*)(lds + HG_RAW + ldst[j]) = lnxt[j];
#pragma unroll
        for (int j = 0; j < 3; ++j) if (lval[j]) lnxt[j] = *(const u32x4*)(lsrc[j] + (ptrdiff_t)lstep[j]);
        HG_BAR();
        for (int c = 0; c < 16; ++c) {
            if (c + 1 < 16) {
                asm volatile("s_waitcnt vmcnt(0)" ::: "memory");
#pragma unroll
                for (int j = 0; j < 3; ++j) if (lval[j]) *(LAS u32x4*)(lds + HG_RAW + ((c + 1) & 1) * 16384 + ldst[j]) = lnxt[j];
                if (c + 2 < 16) {
#pragma unroll
                    for (int j = 0; j < 3; ++j) if (lval[j]) lnxt[j] = *(const u32x4*)(lsrc[j] + (ptrdiff_t)(c + 2) * lstep[j]);
                }
            }
            HG_BAR();
        }
    } else {
        LAS unsigned char* wl = lds + HG_WL + dir * HW_BYTES;
        LAS unsigned char* qe = wl + HW_QE; LAS unsigned char* ke = wl + HW_KE; LAS unsigned char* kgT = wl + HW_KGT; LAS unsigned char* vT = wl + HW_VT;
        LAS float* eg = (LAS float*)(wl + HW_EG);
        LAS float* obuf = (LAS float*)(lds + HG_OB);
        HG_BAR();
        for (int c = 0; c < 16; ++c) {
            const LAS unsigned char* rb = lds + HG_RAW + (c & 1) * 16384 + dir * 8192;
            float b2 = 0.f; float kreg[16];
            float fin[16]; unsigned qin[16];
#pragma unroll
            for (int s = 0; s < 16; ++s) { fin[s] = *(const LAS float*)(rb + s * 256 + lane * 4);
                if (WITH_O) qin[s] = *(const LAS bf16_t*)(rb + 4096 + s * 128 + lane * 2); }
#pragma unroll
            for (int s = 0; s < 16; ++s) {
                const float fv = fin[s];
                b2 += __log2f(fv);
                const float kin = (1.f - fv) * __builtin_amdgcn_exp2f(-b2);
                kreg[s] = kin;
                if (WITH_O) {
                    *(LAS bf16_t*)(ke + s * 144 + lane * 2) = f2bf(kin);
                    const float qv = __uint_as_float(qin[s] << 16) * __builtin_amdgcn_exp2f(b2);
                    *(LAS bf16_t*)(qe + s * 144 + lane * 2) = f2bf(qv);
                }
            }
            const float egv = __builtin_amdgcn_exp2f(b2);
            eg[lane] = egv; dtot *= egv;
            {
                u32x4 w0, w1;
                w0.x = pk2(kreg[0] * egv, kreg[1] * egv); w0.y = pk2(kreg[2] * egv, kreg[3] * egv); w0.z = pk2(kreg[4] * egv, kreg[5] * egv); w0.w = pk2(kreg[6] * egv, kreg[7] * egv);
                w1.x = pk2(kreg[8] * egv, kreg[9] * egv); w1.y = pk2(kreg[10] * egv, kreg[11] * egv); w1.z = pk2(kreg[12] * egv, kreg[13] * egv); w1.w = pk2(kreg[14] * egv, kreg[15] * egv);
                *(LAS u32x4*)(kgT + lane * 48) = w0; *(LAS u32x4*)(kgT + lane * 48 + 16) = w1;
                unsigned vv[16];
#pragma unroll
                for (int s = 0; s < 16; ++s) vv[s] = *(const LAS bf16_t*)(rb + 6144 + s * 128 + lane * 2);
                u32x4 x0, x1;
                x0.x = vv[0] | (vv[1] << 16); x0.y = vv[2] | (vv[3] << 16); x0.z = vv[4] | (vv[5] << 16); x0.w = vv[6] | (vv[7] << 16);
                x1.x = vv[8] | (vv[9] << 16); x1.y = vv[10] | (vv[11] << 16); x1.z = vv[12] | (vv[13] << 16); x1.w = vv[14] | (vv[15] << 16);
                *(LAS u32x4*)(vT + lane * 48) = x0; *(LAS u32x4*)(vT + lane * 48 + 16) = x1;
            }
            asm volatile("s_waitcnt lgkmcnt(0)" ::: "memory");
            s16x4 bv[4];
#pragma unroll
            for (int vb = 0; vb < 4; ++vb) bv[vb] = *(const LAS s16x4*)(vT + (vb * 16 + fr) * 48 + quad * 8);
            if (WITH_O) {
                f32x4 at = (f32x4){0.f, 0.f, 0.f, 0.f};
#pragma unroll
                for (int kp = 0; kp < 2; ++kp) {
                    const bf16x8 ak = *(const LAS bf16x8*)(ke + fr * 144 + kp * 64 + quad * 16);
                    const bf16x8 bq = *(const LAS bf16x8*)(qe + fr * 144 + kp * 64 + quad * 16);
                    at = __builtin_amdgcn_mfma_f32_16x16x32_bf16(ak, bq, at, 0, 0, 0);
                }
#pragma unroll
                for (int r = 0; r < 4; ++r) at[r] = (quad * 4 + r <= fr) ? at[r] : 0.f;
                u32x2 pw; pw.x = pk2(at[0], at[1]); pw.y = pk2(at[2], at[3]);
                const s16x4 pa = __builtin_bit_cast(s16x4, pw);
                f32x4 o[4];
#pragma unroll
                for (int vb = 0; vb < 4; ++vb) o[vb] = __builtin_amdgcn_mfma_f32_16x16x16bf16_1k(pa, bv[vb], (f32x4){0.f, 0.f, 0.f, 0.f}, 0, 0, 0);
#pragma unroll
                for (int kb = 0; kb < 4; ++kb) {
                    const s16x4 aq = *(const LAS s16x4*)(qe + fr * 144 + kb * 32 + quad * 8);
#pragma unroll
                    for (int vb = 0; vb < 4; ++vb) {
                        u32x2 sw; sw.x = pk2(S[kb][vb][0], S[kb][vb][1]); sw.y = pk2(S[kb][vb][2], S[kb][vb][3]);
                        o[vb] = __builtin_amdgcn_mfma_f32_16x16x16bf16_1k(aq, __builtin_bit_cast(s16x4, sw), o[vb], 0, 0, 0);
                    }
                }
                {
                    LAS float* ob0 = obuf + (dir == 0 ? 16 * c + quad * 4 : 255 - 16 * c - quad * 4) * 64 + fr;
                    const int rs = dir == 0 ? 64 : -64;
#pragma unroll
                    for (int r = 0; r < 4; ++r)
#pragma unroll
                        for (int vb = 0; vb < 4; ++vb)
                            __hip_atomic_fetch_add(ob0 + r * rs + vb * 16, o[vb][r], __ATOMIC_RELAXED, __HIP_MEMORY_SCOPE_WORKGROUP);
                }
            }
#pragma unroll
            for (int kb = 0; kb < 4; ++kb) {
                const f32x4 ev = *(const LAS f32x4*)(eg + kb * 16 + quad * 4);
                const s16x4 akg = *(const LAS s16x4*)(kgT + (kb * 16 + fr) * 48 + quad * 8);
#pragma unroll
                for (int vb = 0; vb < 4; ++vb) S[kb][vb] = __builtin_amdgcn_mfma_f32_16x16x16bf16_1k(akg, bv[vb], S[kb][vb] * ev, 0, 0, 0);
            }
            HG_BAR();
        }
    }
#undef HG_BAR
    __syncthreads();
}

__device__ __forceinline__ void hgrn_pass1(const Args& a, LAS unsigned char* lds, int bi) {
    const int tid = threadIdx.x, lane = tid & 63, wave = tid >> 6, fr = lane & 15, quad = lane >> 4;
    unsigned char* ws = a.ws;
    const int dir = wave & 1, seg = bi & 7, h = (bi >> 3) & 7, b = bi >> 6;
    const int row0 = NCTX + b * 2048 + seg * 256;
    f32x4 S[4][4]; float dtot = 1.f;
#pragma unroll
    for (int kb = 0; kb < 4; ++kb)
#pragma unroll
        for (int vb = 0; vb < 4; ++vb) S[kb][vb] = (f32x4){0.f, 0.f, 0.f, 0.f};
    hgrn_block_scan<false>(S, dtot, lds, (const bf16_t*)(ws + WS_HQ), (const bf16_t*)(ws + WS_HV), (const float*)(ws + WS_FF), (const float*)(ws + WS_FB), row0, h);
    if (wave < 2) {
        const int item = bi * 2 + dir;
        float* sl = (float*)(ws + WS_SLOC) + (size_t)item * 4096 + quad * 256 + fr;
#pragma unroll
        for (int kb = 0; kb < 4; ++kb) {
            float* pk = sl + kb * 1024; asm volatile("" : "+v"(pk));
#pragma unroll
            for (int vb = 0; vb < 4; ++vb)
#pragma unroll
                for (int r = 0; r < 4; ++r) pk[r * 64 + vb * 16] = S[kb][vb][r];
        }
        ((float*)(ws + WS_GDEC))[(size_t)item * 64 + lane] = dtot;
    }
}

__device__ __forceinline__ void hgrn_pass2(const Args& a, LAS unsigned char* lds, int item) {
    const int tid = threadIdx.x, lane = tid & 63, wave = tid >> 6, fr = lane & 15, quad = lane >> 4;
    unsigned char* ws = a.ws;
    const bool ctx = item < 128;
    int b, h, seg = 0, row0;
    if (ctx) { b = item >> 3; h = item & 7; row0 = b * 256; }
    else { const int it = item - 128; seg = it & 7; h = (it >> 3) & 7; b = it >> 6; row0 = NCTX + b * 2048 + seg * 256; }
    LAS float* ob = (LAS float*)(lds + HG_OB);
    for (int i = tid; i < 256 * 64 / 4; i += NTHR) ((LAS f32x4*)ob)[i] = (f32x4){0.f, 0.f, 0.f, 0.f};
    const int dir = wave & 1;
    f32x4 S[4][4]; float dtot = 1.f;
#pragma unroll
    for (int kb = 0; kb < 4; ++kb)
#pragma unroll
        for (int vb = 0; vb < 4; ++vb) S[kb][vb] = (f32x4){0.f, 0.f, 0.f, 0.f};
    if (wave < 2 && !ctx) {
        const int it2 = ((b * 8 + h) * 8 + seg) * 2 + dir;
        const float* s0 = (const float*)(ws + WS_SENT) + (size_t)it2 * 4096 + quad * 256 + fr;
#pragma unroll
        for (int kb = 0; kb < 4; ++kb) {
            const float* pk = s0 + kb * 1024; asm volatile("" : "+v"(pk));
#pragma unroll
            for (int vb = 0; vb < 4; ++vb)
#pragma unroll
                for (int r = 0; r < 4; ++r) S[kb][vb][r] = pk[r * 64 + vb * 16];
        }
    }
    hgrn_block_scan<true>(S, dtot, lds, (const bf16_t*)(ws + WS_HQ), (const bf16_t*)(ws + WS_HV), (const float*)(ws + WS_FF), (const float*)(ws + WS_FB), row0, h);
    if (wave < 2 && ctx) {
        float* so = a.out + OST + (size_t)((b * 2 + dir) * 8 + h) * 4096 + quad * 256 + fr;
#pragma unroll
        for (int kb = 0; kb < 4; ++kb) {
            float* pk = so + kb * 1024; asm volatile("" : "+v"(pk));
#pragma unroll
            for (int vb = 0; vb < 4; ++vb)
#pragma unroll
                for (int r = 0; r < 4; ++r) pk[r * 64 + vb * 16] = S[kb][vb][r];
        }
    }
    const float gn = a.in[I_HGNG][lane];
    const bf16_t* HG = (const bf16_t*)(ws + WS_HG);
    bf16_t* OR = (bf16_t*)(ws + WS_O) + (size_t)NTOK * 512;
    {
        const size_t off0 = (size_t)(row0 + wave * 32) * 512 + h * 64 + lane;
        bf16_t gt[32];
#pragma unroll
        for (int i = 0; i < 32; ++i) gt[i] = HG[off0 + (size_t)i * 512];
#pragma unroll
        for (int i = 0; i < 32; ++i) {
            const float v = ob[(wave * 32 + i) * 64 + lane];
            const float rinv = rsqrtf(wave_sum(v * v) * (1.f / 64.f) + EPS);
            const float gate = __uint_as_float((unsigned)gt[i] << 16);
            OR[off0 + (size_t)i * 512] = f2bf(v * rinv * gn * gate);
        }
    }
    __syncthreads();
}


template <int NST>
__device__ __forceinline__ void attn_group_item(const Args& a, LAS unsigned char* lds, unsigned ring_off, int wa, int ab, int h, int qt) {
    const int tid = threadIdx.x, lane = tid & 63, fr = lane & 15, fq = lane >> 4;
    unsigned char* ws = a.ws;
    const bf16_t* Q = (const bf16_t*)(ws + WS_Q); const bf16_t* KN = (const bf16_t*)(ws + WS_KN); const bf16_t* KRP = (const bf16_t*)(ws + WS_KRP); const bf16_t* VT = (const bf16_t*)(ws + WS_VT);
    bf16_t* O = (bf16_t*)(ws + WS_O);
    const float cs = 0.10206207261596577f * 1.4426950408889634f;
    const int sw7 = fr & 7, sw3 = (fr >> 2) & 3;
        const int Tk = ab < 16 ? 256 : 2304;
        const int kbase = ab < 16 ? ab * 256 : NCTX + (ab - 16) * 2304;
        const size_t vbase = ab < 16 ? (size_t)(ab * 8 + h) * 64 * 256 : (size_t)16 * 8 * 64 * 256 + (size_t)((ab - 16) * 8 + h) * 64 * 2304;
        const int qrow = (ab < 16 ? ab * 256 : NCTX + (ab - 16) * 2048) + qt * 128 + wa * 32 + fr;
        bf16x8 qf[2][3];
#pragma unroll
        for (int sb = 0; sb < 2; ++sb)
#pragma unroll
            for (int ks = 0; ks < 3; ++ks) qf[sb][ks] = *(const bf16x8*)(Q + (size_t)(qrow + 16 * sb) * 768 + h * 96 + ks * 32 + fq * 8);
        if (ab >= 16) {
#pragma unroll
            for (int sb = 0; sb < 2; ++sb) {
                const int t = qt * 128 + wa * 32 + 16 * sb + fr;
                const float pos = fq < 2 ? (float)(t >> 6) : (float)(t & 63);
                const u32x4 w = __builtin_bit_cast(u32x4, qf[sb][2]);
                u32x4 pw; pw.x = __shfl_xor(w.x, 16); pw.y = __shfl_xor(w.y, 16); pw.z = __shfl_xor(w.z, 16); pw.w = __shfl_xor(w.w, 16);
                const float x[8] = {bflo(w.x), bfhi(w.x), bflo(w.y), bfhi(w.y), bflo(w.z), bfhi(w.z), bflo(w.w), bfhi(w.w)};
                const float pp[8] = {bflo(pw.x), bfhi(pw.x), bflo(pw.y), bfhi(pw.y), bflo(pw.z), bfhi(pw.z), bflo(pw.w), bfhi(pw.w)};
                const float iv[8] = {1.0f, 0.31622776601683794f, 0.1f, 0.031622776601683794f, 0.01f, 0.0031622776601683794f, 0.001f, 0.00031622776601683794f};
                float o[8];
#pragma unroll
                for (int i = 0; i < 8; ++i) {
                    float rev = pos * iv[i] * 0.15915494309189535f; rev -= rintf(rev);
                    const float s = __builtin_amdgcn_sinf(rev), c = __builtin_amdgcn_cosf(rev);
                    o[i] = (fq & 1) ? (x[i] * c + pp[i] * s) : (x[i] * c - pp[i] * s);
                }
                u32x4 ow; ow.x = pk2(o[0], o[1]); ow.y = pk2(o[2], o[3]); ow.z = pk2(o[4], o[5]); ow.w = pk2(o[6], o[7]);
                qf[sb][2] = __builtin_bit_cast(bf16x8, ow);
            }
        }
        const int nt = Tk / 64;
        const char* gk[2]; const char* gv[2];
#pragma unroll
        for (int j = 0; j < 2; ++j) {
            const int kk = (2 * wa + j) * 8 + (lane >> 3), kc = (lane & 7) ^ (kk & 7);
            gk[j] = (const char*)(KN + (size_t)(kbase + kk) * 512 + h * 64 + kc * 8);
            const int vd = (2 * wa + j) * 8 + (lane >> 3), vc = (lane & 7) ^ (vd & 7);
            gv[j] = (const char*)(VT + vbase + (size_t)vd * Tk + vc * 8);
        }
        const int rk = wa * 16 + (lane >> 2), rc = (lane & 3) ^ ((rk >> 2) & 3);
        const char* gr = (const char*)(KRP + (size_t)(kbase + rk) * 32 + rc * 8);
#define F_ISSUE(tile, stg) do { const int _t = (tile) < nt ? (tile) : nt - 1; const unsigned _s = ring_off + (unsigned)(stg) * AT_STAGE; \
        __builtin_amdgcn_global_load_lds((const unsigned*)(gk[0] + (size_t)_t * 65536), (LAS unsigned*)(lds + _s + AT_KN + (2 * wa) * 1024), 16, 0, 0); \
        __builtin_amdgcn_global_load_lds((const unsigned*)(gk[1] + (size_t)_t * 65536), (LAS unsigned*)(lds + _s + AT_KN + (2 * wa + 1) * 1024), 16, 0, 0); \
        __builtin_amdgcn_global_load_lds((const unsigned*)(gr + (size_t)_t * 4096), (LAS unsigned*)(lds + _s + AT_KR + wa * 1024), 16, 0, 0); \
        __builtin_amdgcn_global_load_lds((const unsigned*)(gv[0] + (size_t)_t * 128), (LAS unsigned*)(lds + _s + AT_VT + (2 * wa) * 1024), 16, 0, 0); \
        __builtin_amdgcn_global_load_lds((const unsigned*)(gv[1] + (size_t)_t * 128), (LAS unsigned*)(lds + _s + AT_VT + (2 * wa + 1) * 1024), 16, 0, 0); } while (0)
        asm volatile("s_waitcnt vmcnt(0) lgkmcnt(0)" ::: "memory");
        __builtin_amdgcn_s_barrier();
        asm volatile("" ::: "memory");
        F_ISSUE(0, 0); if (NST == 3) F_ISSUE(1, 1);
        f32x4 oacc[2][4];
#pragma unroll
        for (int sb = 0; sb < 2; ++sb)
#pragma unroll
            for (int i = 0; i < 4; ++i) oacc[sb][i] = (f32x4){0.f, 0.f, 0.f, 0.f};
        float mrun[2] = {-INFINITY, -INFINITY}, lrun[2] = {0.f, 0.f};
        int stg = 0;
        for (int t = 0; t < nt; ++t) {
            if (NST == 3) asm volatile("s_waitcnt vmcnt(5)" ::: "memory"); else asm volatile("s_waitcnt vmcnt(0)" ::: "memory");
            __builtin_amdgcn_s_barrier();
            asm volatile("" ::: "memory");
            if (NST == 3) { const int s2 = stg >= 1 ? stg - 1 : 2; F_ISSUE(t + 2, s2); } else { F_ISSUE(t + 1, stg ^ 1); }
            const LAS unsigned char* sbp = lds + ring_off + stg * AT_STAGE;
            f32x4 s[2][4];
#pragma unroll
            for (int kb = 0; kb < 4; ++kb) {
                s[0][kb] = (f32x4){0.f, 0.f, 0.f, 0.f}; s[1][kb] = (f32x4){0.f, 0.f, 0.f, 0.f};
                const int key = kb * 16 + fr;
#pragma unroll
                for (int ks = 0; ks < 2; ++ks) {
                    const bf16x8 kf = *(const LAS bf16x8*)(sbp + AT_KN + key * 128 + (((ks * 4 + fq) ^ sw7) * 16));
                    s[0][kb] = __builtin_amdgcn_mfma_f32_16x16x32_bf16(kf, qf[0][ks], s[0][kb], 0, 0, 0);
                    s[1][kb] = __builtin_amdgcn_mfma_f32_16x16x32_bf16(kf, qf[1][ks], s[1][kb], 0, 0, 0);
                }
                const bf16x8 kr = *(const LAS bf16x8*)(sbp + AT_KR + key * 64 + ((fq ^ sw3) * 16));
                s[0][kb] = __builtin_amdgcn_mfma_f32_16x16x32_bf16(kr, qf[0][2], s[0][kb], 0, 0, 0);
                s[1][kb] = __builtin_amdgcn_mfma_f32_16x16x32_bf16(kr, qf[1][2], s[1][kb], 0, 0, 0);
            }
            bf16x8 pf[2][2];
#pragma unroll
            for (int sb = 0; sb < 2; ++sb) {
                float mx = fmaxf(fmaxf(s[sb][0][0], s[sb][0][1]), fmaxf(s[sb][0][2], s[sb][0][3]));
#pragma unroll
                for (int kb = 1; kb < 4; ++kb) mx = fmaxf(mx, fmaxf(fmaxf(s[sb][kb][0], s[sb][kb][1]), fmaxf(s[sb][kb][2], s[sb][kb][3])));
                const bool upd = __builtin_amdgcn_ballot_w64((mx - mrun[sb]) * cs > 8.f) != 0ull;
                if (upd) {
                    mx = fmaxf(mx, __shfl_xor(mx, 16)); mx = fmaxf(mx, __shfl_xor(mx, 32));
                    const float mn = fmaxf(mrun[sb], mx);
                    const float alpha = __builtin_amdgcn_exp2f((mrun[sb] - mn) * cs);
                    mrun[sb] = mn;
                    lrun[sb] *= alpha;
#pragma unroll
                    for (int i = 0; i < 4; ++i) oacc[sb][i] = oacc[sb][i] * alpha;
                }
                const float mc = mrun[sb] * cs;
                float ps = 0.f;
#pragma unroll
                for (int kb = 0; kb < 4; ++kb)
#pragma unroll
                    for (int j = 0; j < 4; ++j) { const float p = __builtin_amdgcn_exp2f(s[sb][kb][j] * cs - mc); s[sb][kb][j] = p; ps += p; }
                lrun[sb] += ps;
#pragma unroll
                for (int kp2 = 0; kp2 < 2; ++kp2) {
                    u32x4 w; w.x = pk2(s[sb][2 * kp2][0], s[sb][2 * kp2][1]); w.y = pk2(s[sb][2 * kp2][2], s[sb][2 * kp2][3]);
                    w.z = pk2(s[sb][2 * kp2 + 1][0], s[sb][2 * kp2 + 1][1]); w.w = pk2(s[sb][2 * kp2 + 1][2], s[sb][2 * kp2 + 1][3]);
                    pf[sb][kp2] = __builtin_bit_cast(bf16x8, w);
                }
            }
#pragma unroll
            for (int db = 0; db < 4; ++db)
#pragma unroll
                for (int kp2 = 0; kp2 < 2; ++kp2) {
                    const int d = db * 16 + fr, c0 = kp2 * 4 + (fq >> 1);
                    const LAS unsigned char* vb = sbp + AT_VT + d * 128 + (fq & 1) * 8;
                    const u32x2 lo = *(const LAS u32x2*)(vb + ((c0 ^ sw7) * 16)), hi = *(const LAS u32x2*)(vb + (((c0 + 2) ^ sw7) * 16));
                    u32x4 w; w.x = lo.x; w.y = lo.y; w.z = hi.x; w.w = hi.y;
                    const bf16x8 vf = __builtin_bit_cast(bf16x8, w);
                    oacc[0][db] = __builtin_amdgcn_mfma_f32_16x16x32_bf16(vf, pf[0][kp2], oacc[0][db], 0, 0, 0);
                    oacc[1][db] = __builtin_amdgcn_mfma_f32_16x16x32_bf16(vf, pf[1][kp2], oacc[1][db], 0, 0, 0);
                }
            stg = (stg == NST - 1) ? 0 : stg + 1;
        }
        asm volatile("s_waitcnt vmcnt(0)" ::: "memory");
#pragma unroll
        for (int sb = 0; sb < 2; ++sb) {
            float l = lrun[sb]; l += __shfl_xor(l, 16); l += __shfl_xor(l, 32);
            const float il = 1.f / l;
#pragma unroll
            for (int db = 0; db < 4; ++db) {
                u32x2 w; w.x = pk2(oacc[sb][db][0] * il, oacc[sb][db][1] * il); w.y = pk2(oacc[sb][db][2] * il, oacc[sb][db][3] * il);
                *(u32x2*)(O + (size_t)(qrow + 16 * sb) * 512 + h * 64 + db * 16 + fq * 4) = w;
            }
        }
#undef F_ISSUE
}

constexpr int F_RING = 0, F_WL = 61440, F_RAW = 83456, F_NB = 32;
__device__ __forceinline__ void p7_fused(const Args& a, LAS unsigned char* lds, int blk) {
    const int tid = threadIdx.x, lane = tid & 63, wave = __builtin_amdgcn_readfirstlane(tid >> 6), fr = lane & 15, fq = lane >> 4;
    unsigned char* ws = a.ws;
#define F_BAR() do { asm volatile("s_waitcnt lgkmcnt(0)" ::: "memory"); __builtin_amdgcn_s_barrier(); asm volatile("" ::: "memory"); } while (0)
    const bool ctx = blk < 128;
    int hb, hh, hseg = 0, hrow0;
    if (ctx) { hb = blk >> 3; hh = blk & 7; hrow0 = hb * 256; }
    else { const int it = blk - 128; hseg = it & 7; hh = (it >> 3) & 7; hb = it >> 6; hrow0 = NCTX + hb * 2048 + hseg * 256; }
    if (wave < 4) {
        attn_group_item<3>(a, lds, F_RING, wave, 16 + (blk >> 7), (blk >> 4) & 7, blk & 15);
    } else if (wave >= 6) {
        const int lt = tid - 384;
        const bf16_t* HQ = (const bf16_t*)(ws + WS_HQ); const bf16_t* HV = (const bf16_t*)(ws + WS_HV);
        const char* lsrc[8]; int ldst[8];
#pragma unroll
        for (int j = 0; j < 8; ++j) {
            const int d = j >> 2, ty = j & 3;
            int row, dst, rowbytes, tokbytes; const char* s;
            if (ty < 2) { const int r = ty * 128 + lt; row = r >> 4; const int ch = r & 15; s = (const char*)((const float*)(ws + (d ? WS_FB : WS_FF)) + (size_t)hrow0 * 512 + hh * 64 + ch * 4); dst = ch * 16; rowbytes = 256; tokbytes = 2048; }
            else { row = lt >> 3; const int ch = lt & 7; s = (const char*)((ty == 2 ? HQ : HV) + (size_t)hrow0 * 512 + hh * 64 + ch * 8); dst = (ty == 2 ? 4096 : 6144) + ch * 16; rowbytes = 128; tokbytes = 1024; }
            lsrc[j] = s + (size_t)((d ? 240 : 0) + row) * tokbytes;
            ldst[j] = F_RAW + d * 8192 + dst + (d ? 15 - row : row) * rowbytes;
        }
        u32x4 lnxt[8];
#pragma unroll
        for (int j = 0; j < 8; ++j) lnxt[j] = *(const u32x4*)lsrc[j];
#pragma unroll
        for (int j = 0; j < 8; ++j) *(LAS u32x4*)(lds + ldst[j]) = lnxt[j];
#pragma unroll
        for (int j = 0; j < 8; ++j) { const int d = j >> 2, tokbytes = (j & 3) < 2 ? 2048 : 1024; lnxt[j] = *(const u32x4*)(lsrc[j] + (ptrdiff_t)((d ? -16 : 16) * tokbytes)); }
        for (int n = 0; n < F_NB; ++n) {
            F_BAR();
            const int c = n >> 1;
            if ((n & 1) == 0 && c + 1 < 16) {
                asm volatile("s_waitcnt vmcnt(0)" ::: "memory");
#pragma unroll
                for (int j = 0; j < 8; ++j) *(LAS u32x4*)(lds + ((c + 1) & 1) * 16384 + ldst[j]) = lnxt[j];
                if (c + 2 < 16) {
#pragma unroll
                    for (int j = 0; j < 8; ++j) { const int d = j >> 2, tokbytes = (j & 3) < 2 ? 2048 : 1024; lnxt[j] = *(const u32x4*)(lsrc[j] + (ptrdiff_t)(c + 2) * ((d ? -16 : 16) * tokbytes)); }
                }
            }
        }
        attn_group_item<2>(a, lds, F_WL, wave - 4, blk >> 4, (blk >> 1) & 7, blk & 1);
    } else {
        const int dir = wave & 1, quad = fq;
        f32x4 S[4][4];
#pragma unroll
        for (int kb = 0; kb < 4; ++kb)
#pragma unroll
            for (int vb = 0; vb < 4; ++vb) S[kb][vb] = (f32x4){0.f, 0.f, 0.f, 0.f};
        if (!ctx) {
            const int it2 = ((hb * 8 + hh) * 8 + hseg) * 2 + dir;
            const float* s0 = (const float*)(ws + WS_SENT) + (size_t)it2 * 4096 + quad * 256 + fr;
#pragma unroll
            for (int kb = 0; kb < 4; ++kb) {
                const float* pk = s0 + kb * 1024; asm volatile("" : "+v"(pk));
#pragma unroll
                for (int vb = 0; vb < 4; ++vb)
#pragma unroll
                    for (int r = 0; r < 4; ++r) S[kb][vb][r] = pk[r * 64 + vb * 16];
            }
        }
        LAS unsigned char* wl = lds + F_WL + dir * HW_BYTES;
        LAS unsigned char* qe = wl + HW_QE; LAS unsigned char* ke = wl + HW_KE; LAS unsigned char* kgT = wl + HW_KGT; LAS unsigned char* vT = wl + HW_VT;
        LAS float* eg = (LAS float*)(wl + HW_EG);
        bf16_t* OX = (bf16_t*)(ws + (dir ? WS_OBW : WS_OFW));
        for (int n = 0; n < F_NB; ++n) {
            F_BAR();
            const int c = n >> 1;
            if (n < 32 && (n & 1) == 0) {
                const LAS unsigned char* rb = lds + F_RAW + (c & 1) * 16384 + dir * 8192;
                float b2 = 0.f; float kreg[16];
                float fin[16]; unsigned qin[16];
#pragma unroll
                for (int s = 0; s < 16; ++s) { fin[s] = *(const LAS float*)(rb + s * 256 + lane * 4); qin[s] = *(const LAS bf16_t*)(rb + 4096 + s * 128 + lane * 2); }
#pragma unroll
                for (int s = 0; s < 16; ++s) {
                    const float fv = fin[s];
                    b2 += __log2f(fv);
                    const float kin = (1.f - fv) * __builtin_amdgcn_exp2f(-b2);
                    kreg[s] = kin;
                    *(LAS bf16_t*)(ke + s * 144 + lane * 2) = f2bf(kin);
                    const float qv = __uint_as_float(qin[s] << 16) * __builtin_amdgcn_exp2f(b2);
                    *(LAS bf16_t*)(qe + s * 144 + lane * 2) = f2bf(qv);
                }
                const float egv = __builtin_amdgcn_exp2f(b2);
                eg[lane] = egv;
                {
                    u32x4 w0, w1;
                    w0.x = pk2(kreg[0] * egv, kreg[1] * egv); w0.y = pk2(kreg[2] * egv, kreg[3] * egv); w0.z = pk2(kreg[4] * egv, kreg[5] * egv); w0.w = pk2(kreg[6] * egv, kreg[7] * egv);
                    w1.x = pk2(kreg[8] * egv, kreg[9] * egv); w1.y = pk2(kreg[10] * egv, kreg[11] * egv); w1.z = pk2(kreg[12] * egv, kreg[13] * egv); w1.w = pk2(kreg[14] * egv, kreg[15] * egv);
                    *(LAS u32x4*)(kgT + lane * 48) = w0; *(LAS u32x4*)(kgT + lane * 48 + 16) = w1;
                    unsigned vv[16];
#pragma unroll
                    for (int s = 0; s < 16; ++s) vv[s] = *(const LAS bf16_t*)(rb + 6144 + s * 128 + lane * 2);
                    u32x4 x0, x1;
                    x0.x = vv[0] | (vv[1] << 16); x0.y = vv[2] | (vv[3] << 16); x0.z = vv[4] | (vv[5] << 16); x0.w = vv[6] | (vv[7] << 16);
                    x1.x = vv[8] | (vv[9] << 16); x1.y = vv[10] | (vv[11] << 16); x1.z = vv[12] | (vv[13] << 16); x1.w = vv[14] | (vv[15] << 16);
                    *(LAS u32x4*)(vT + lane * 48) = x0; *(LAS u32x4*)(vT + lane * 48 + 16) = x1;
                }
            }
            if (n < 32 && (n & 1) == 1) {
                s16x4 bv[4];
#pragma unroll
                for (int vb = 0; vb < 4; ++vb) bv[vb] = *(const LAS s16x4*)(vT + (vb * 16 + fr) * 48 + quad * 8);
                f32x4 at = (f32x4){0.f, 0.f, 0.f, 0.f};
#pragma unroll
                for (int kp = 0; kp < 2; ++kp) {
                    const bf16x8 ak = *(const LAS bf16x8*)(ke + fr * 144 + kp * 64 + quad * 16);
                    const bf16x8 bq = *(const LAS bf16x8*)(qe + fr * 144 + kp * 64 + quad * 16);
                    at = __builtin_amdgcn_mfma_f32_16x16x32_bf16(ak, bq, at, 0, 0, 0);
                }
#pragma unroll
                for (int r = 0; r < 4; ++r) at[r] = (quad * 4 + r <= fr) ? at[r] : 0.f;
                u32x2 pw; pw.x = pk2(at[0], at[1]); pw.y = pk2(at[2], at[3]);
                const s16x4 pa = __builtin_bit_cast(s16x4, pw);
                f32x4 o[4];
#pragma unroll
                for (int vb = 0; vb < 4; ++vb) o[vb] = __builtin_amdgcn_mfma_f32_16x16x16bf16_1k(pa, bv[vb], (f32x4){0.f, 0.f, 0.f, 0.f}, 0, 0, 0);
#pragma unroll
                for (int kb = 0; kb < 4; ++kb) {
                    const s16x4 aq = *(const LAS s16x4*)(qe + fr * 144 + kb * 32 + quad * 8);
#pragma unroll
                    for (int vb = 0; vb < 4; ++vb) {
                        u32x2 sw; sw.x = pk2(S[kb][vb][0], S[kb][vb][1]); sw.y = pk2(S[kb][vb][2], S[kb][vb][3]);
                        o[vb] = __builtin_amdgcn_mfma_f32_16x16x16bf16_1k(aq, __builtin_bit_cast(s16x4, sw), o[vb], 0, 0, 0);
                    }
                }
                {
                    const int tl0 = dir == 0 ? 16 * c + quad * 4 : 255 - 16 * c - quad * 4;
                    bf16_t* op = OX + (size_t)(hrow0 + tl0) * 512 + hh * 64 + fr;
                    const ptrdiff_t rs = dir == 0 ? 512 : -512;
#pragma unroll
                    for (int r = 0; r < 4; ++r)
#pragma unroll
                        for (int vb = 0; vb < 4; ++vb) op[r * rs + vb * 16] = f2bf(o[vb][r]);
                }
#pragma unroll
                for (int kb = 0; kb < 4; ++kb) {
                    const f32x4 ev = *(const LAS f32x4*)(eg + kb * 16 + quad * 4);
                    const s16x4 akg = *(const LAS s16x4*)(kgT + (kb * 16 + fr) * 48 + quad * 8);
#pragma unroll
                    for (int vb = 0; vb < 4; ++vb) S[kb][vb] = __builtin_amdgcn_mfma_f32_16x16x16bf16_1k(akg, bv[vb], S[kb][vb] * ev, 0, 0, 0);
                }
                if (n == 31 && ctx) {
                    float* so = a.out + OST + (size_t)((hb * 2 + dir) * 8 + hh) * 4096 + quad * 256 + fr;
#pragma unroll
                    for (int kb = 0; kb < 4; ++kb) {
                        float* pk = so + kb * 1024; asm volatile("" : "+v"(pk));
#pragma unroll
                        for (int vb = 0; vb < 4; ++vb)
#pragma unroll
                            for (int r = 0; r < 4; ++r) pk[r * 64 + vb * 16] = S[kb][vb][r];
                    }
                }
            }
        }
        attn_group_item<2>(a, lds, F_WL, wave - 4, blk >> 4, (blk >> 1) & 7, blk & 1);
    }
#undef F_BAR
    __syncthreads();
}

__device__ __forceinline__ void phase_hgfin(const Args& a, int G) {
    const int tid = threadIdx.x, lane = tid & 63, wave = tid >> 6;
    unsigned char* ws = a.ws;
    const bf16_t* OF = (const bf16_t*)(ws + WS_OFW); const bf16_t* OB = (const bf16_t*)(ws + WS_OBW); const bf16_t* HG = (const bf16_t*)(ws + WS_HG);
    bf16_t* OR = (bf16_t*)(ws + WS_O) + (size_t)NTOK * 512;
    const f32x4 g0 = *(const f32x4*)(a.in[I_HGNG] + (lane & 7) * 8), g1 = *(const f32x4*)(a.in[I_HGNG] + (lane & 7) * 8 + 4);
#pragma unroll 4
    for (int row = blockIdx.x * 8 + wave; row < NTOK; row += G * 8) {
        const size_t off = (size_t)row * 512 + lane * 8;
        const u32x4 wf = *(const u32x4*)(OF + off), wb = *(const u32x4*)(OB + off), wg = *(const u32x4*)(HG + off);
        float v[8] = {bflo(wf.x) + bflo(wb.x), bfhi(wf.x) + bfhi(wb.x), bflo(wf.y) + bflo(wb.y), bfhi(wf.y) + bfhi(wb.y),
                      bflo(wf.z) + bflo(wb.z), bfhi(wf.z) + bfhi(wb.z), bflo(wf.w) + bflo(wb.w), bfhi(wf.w) + bfhi(wb.w)};
        float ss = 0.f;
#pragma unroll
        for (int i = 0; i < 8; ++i) ss += v[i] * v[i];
        ss += __shfl_xor(ss, 1); ss += __shfl_xor(ss, 2); ss += __shfl_xor(ss, 4);
        const float ri = rsqrtf(ss * (1.f / 64.f) + EPS);
        u32x4 o;
        o.x = pk2(v[0] * ri * g0.x * bflo(wg.x), v[1] * ri * g0.y * bfhi(wg.x)); o.y = pk2(v[2] * ri * g0.z * bflo(wg.y), v[3] * ri * g0.w * bfhi(wg.y));
        o.z = pk2(v[4] * ri * g1.x * bflo(wg.z), v[5] * ri * g1.y * bfhi(wg.z)); o.w = pk2(v[6] * ri * g1.z * bflo(wg.w), v[7] * ri * g1.w * bfhi(wg.w));
        *(u32x4*)(OR + off) = o;
    }
}


#define XB_TMO      128
#define XB_XCNT(j)  (256  + 64 * (j))
#define XB_XSUB(j)  (1280 + 64 * (j))
#define XB_XGEN(j)  (2304 + 64 * (j))
#define XB_TOP      3328
#define XB_TOPGEN   3392
#define XCD_BAR_WORDS 3456
#define XB_SPIN_CAP (1u << 18)
__device__ __forceinline__ unsigned xb_ld(unsigned* p)              { return __hip_atomic_load(p, __ATOMIC_RELAXED, __HIP_MEMORY_SCOPE_AGENT); }
__device__ __forceinline__ unsigned xb_add(unsigned* p, unsigned v) { return __hip_atomic_fetch_add(p, v, __ATOMIC_RELAXED, __HIP_MEMORY_SCOPE_AGENT); }
__device__ __forceinline__ unsigned xb_xcc_id() { return (unsigned)__builtin_amdgcn_s_getreg((3 << 11) | 20) & 0xFu; }
#define XB_SPIN(cond, bar) do { unsigned _sp = 0; while (cond) { __builtin_amdgcn_s_sleep(1); \
    if ((++_sp & 255u) == 0u) { if (xb_ld(&(bar)[XB_TMO])) break; if (_sp > XB_SPIN_CAP) { atomicAdd(&(bar)[XB_TMO], 1u); break; } } } } while (0)
struct XcdBarrier { unsigned* bar; unsigned x; volatile LAS unsigned* st; };
__device__ __forceinline__ XcdBarrier xcd_barrier_post(unsigned* bar, volatile LAS unsigned* st) {
    XcdBarrier b; b.bar = bar; b.x = xb_xcc_id(); b.st = st;
    if (threadIdx.x == 0) (void)xb_add(&bar[XB_XCNT(b.x)], 1u);
    return b;
}
__device__ __forceinline__ void xcd_barrier_complete(unsigned* bar, unsigned x, unsigned& nloc, unsigned& nx) {
    const unsigned G = gridDim.x * gridDim.y * gridDim.z;
    unsigned sum, cnt, mine, sp = 0u;
    for (;;) {
        sum = 0u; cnt = 0u; mine = 0u;
#pragma unroll
        for (unsigned j = 0; j < 16; ++j) { const unsigned c = xb_ld(&bar[XB_XCNT(j)]); sum += c; cnt += (c > 0u) ? 1u : 0u; mine = (j == x) ? c : mine; }
        if (sum == G) break;
        __builtin_amdgcn_s_sleep(1);
        if ((++sp & 255u) == 0u) { if (xb_ld(&bar[XB_TMO])) break; if (sp > XB_SPIN_CAP) { atomicAdd(&bar[XB_TMO], 1u); break; } }
    }
    nloc = mine > 0u ? mine : 1u; nx = cnt > 0u ? cnt : 1u;
}
__device__ __forceinline__ void xcd_barrier(const XcdBarrier& b) {
    asm volatile("s_waitcnt vmcnt(0)" ::: "memory");
    __syncthreads();
    if (threadIdx.x == 0) {
        unsigned* bar = b.bar;
        __builtin_amdgcn_s_waitcnt(0);
        unsigned nloc = b.st[0], nx = b.st[1];
        if (nloc == 0u) { xcd_barrier_complete(bar, b.x, nloc, nx); b.st[0] = nloc; b.st[1] = nx; }
        const unsigned old = xb_add(&bar[XB_XSUB(b.x)], 1u);
        const unsigned gen = old / nloc;
        if (old + 1u == (gen + 1u) * nloc) {
            __builtin_amdgcn_fence(__ATOMIC_RELEASE, "agent");
            asm volatile("s_waitcnt vmcnt(0)" ::: "memory");
            const unsigned og = xb_add(&bar[XB_TOP], 1u);
            const unsigned tg = og / nx;
            if (og + 1u == (tg + 1u) * nx) xb_add(&bar[XB_TOPGEN], 1u);
            else XB_SPIN(xb_ld(&bar[XB_TOPGEN]) == tg, bar);
            __builtin_amdgcn_fence(__ATOMIC_ACQUIRE, "agent");
            xb_add(&bar[XB_XGEN(b.x)], 1u);
            asm volatile("s_waitcnt vmcnt(0)" ::: "memory");
        } else {
            XB_SPIN(xb_ld(&bar[XB_XGEN(b.x)]) == gen, bar);
            __builtin_amdgcn_fence(__ATOMIC_ACQUIRE, "agent");
            asm volatile("s_waitcnt vmcnt(0)" ::: "memory");
        }
    }
    __syncthreads();
}

#ifndef PHMASK
#define PHMASK 0xFFFFF
#endif
#define PH(n) ((PHMASK >> (n)) & 1)
__global__ void __launch_bounds__(NTHR, 2) fwd_megakernel(Args a) {
    extern __shared__ __attribute__((aligned(16))) unsigned char lds_raw[];
    LAS unsigned char* lds = (LAS unsigned char*)lds_raw;
    volatile LAS unsigned* bar_st = (volatile LAS unsigned*)(lds + LDS_BYTES - 16);
    if (threadIdx.x < 4) bar_st[threadIdx.x] = 0u;
    __syncthreads();
    XcdBarrier gbar = xcd_barrier_post((unsigned*)(a.ws + WS_BAR), bar_st);
    const int G = gridDim.x, tid = threadIdx.x;
    unsigned char* ws = a.ws;
    using namespace pg8;

    if (PH(0)) {
    phase_prep(a, lds, G);
    }
    xcd_barrier(gbar);
    if (PH(1)) {
    phase_norm<1>(a, G);
    }
    xcd_barrier(gbar);
    if (PH(2)) {
    { Gemm g{(const bf16_t*)(ws + WS_XN), (const bf16_t*)(ws + WS_W1A), D, D, D, 0, 0}; GridOrder S{32, 22, 1, G, (int)blockIdx.x, 0}; EpiSwiGLU E{(bf16_t*)(ws + WS_HFF)};
      gemm_phase(lds, g, S, E); }
    tr_in_tail(a, lds, 32 * 22, TR_B0, TR_B1, G);
    }
    xcd_barrier(gbar);
    if (PH(3)) {
    { Gemm g{(const bf16_t*)(ws + WS_HFF), (const bf16_t*)(ws + WS_W1B), DFF, DFF, DFF / 2, (size_t)DFF, (size_t)DFF}; GridOrder S{32, 4, 2, G, (int)blockIdx.x, 0}; EpiPart E{(bf16_t*)(ws + WS_PART)};
      gemm_phase(lds, g, S, E); }
    }
    xcd_barrier(gbar);
    if (PH(4)) {
    phase_norm<2>(a, G);
    }
    xcd_barrier(gbar);
    if (PH(5)) {
    { Gemm g{(const bf16_t*)(ws + WS_XN), (const bf16_t*)(ws + WS_WIN), D, D, D, 0, 0}; GridOrder S{32, 21, 1, G, (int)blockIdx.x, 0};
      EpiIn E{(bf16_t*)(ws + WS_QC), (bf16_t*)(ws + WS_KVC), (bf16_t*)(ws + WS_HQ), (bf16_t*)(ws + WS_HV), (bf16_t*)(ws + WS_HG), (bf16_t*)(ws + WS_GATE), (bf16_t*)(ws + WS_KRP),
              (float*)(ws + WS_FF), (float*)(ws + WS_FB), a.out + OKR, (const float*)(ws + WS_LB)};
      gemm_phase(lds, g, S, E); }
    tr_in_tail(a, lds, 32 * 21, TR_C0, TR_C1, G);
    }
    xcd_barrier(gbar);
    if (PH(6)) {
        const int lane = tid & 63, wave = tid >> 6;
        float* RQ = (float*)(ws + WS_RQ); float* RKV = (float*)(ws + WS_RKV);
        const int nsk = G >= 192 ? 128 : 0;
        for (int rb = ((int)blockIdx.x - nsk) * 8 + wave; rb >= 0 && rb < NTOK / 4; rb += (G - nsk) * 8) {
            const int row0 = rb * 4;
            u32x4 wq[4], wk[4];
#pragma unroll
            for (int i = 0; i < 4; ++i) {
                wq[i] = (u32x4){0u, 0u, 0u, 0u}; wk[i] = (u32x4){0u, 0u, 0u, 0u};
                if (lane < 48) wq[i] = *(const u32x4*)((const bf16_t*)(ws + WS_QC) + (size_t)(row0 + i) * 384 + lane * 8);
                if (lane < 32) wk[i] = *(const u32x4*)((const bf16_t*)(ws + WS_KVC) + (size_t)(row0 + i) * 256 + lane * 8);
            }
            float sq[4], sk[4];
#pragma unroll
            for (int i = 0; i < 4; ++i) {
                { const u32x4 w = wq[i]; const float e0 = bflo(w.x), e1 = bfhi(w.x), e2 = bflo(w.y), e3 = bfhi(w.y), e4 = bflo(w.z), e5 = bfhi(w.z), e6 = bflo(w.w), e7 = bfhi(w.w);
                  sq[i] = (e0 * e0 + e1 * e1) + (e2 * e2 + e3 * e3) + (e4 * e4 + e5 * e5) + (e6 * e6 + e7 * e7); }
                { const u32x4 w = wk[i]; const float e0 = bflo(w.x), e1 = bfhi(w.x), e2 = bflo(w.y), e3 = bfhi(w.y), e4 = bflo(w.z), e5 = bfhi(w.z), e6 = bflo(w.w), e7 = bfhi(w.w);
                  sk[i] = (e0 * e0 + e1 * e1) + (e2 * e2 + e3 * e3) + (e4 * e4 + e5 * e5) + (e6 * e6 + e7 * e7); }
            }
#pragma unroll
            for (int o = 1; o < 64; o <<= 1) {
#pragma unroll
                for (int i = 0; i < 4; ++i) { sq[i] += __shfl_xor(sq[i], o); sk[i] += __shfl_xor(sk[i], o); }
            }
#pragma unroll
            for (int i = 0; i < 4; ++i) {
                const int row = row0 + i;
                const float ri = rsqrtf(sk[i] * (1.f / 256.f) + EPS);
                if (lane == 0) { RQ[row] = rsqrtf(sq[i] * (1.f / 384.f) + EPS); RKV[row] = ri; }
                if (row < NCTX && lane < 32) {
                    const u32x4 w = wk[i];
                    const f32x4 g0 = *(const f32x4*)(a.in[I_KVNG] + lane * 8), g1 = *(const f32x4*)(a.in[I_KVNG] + lane * 8 + 4);
                    f32x4 o0, o1; o0.x = bflo(w.x) * ri * g0.x; o0.y = bfhi(w.x) * ri * g0.y; o0.z = bflo(w.y) * ri * g0.z; o0.w = bfhi(w.y) * ri * g0.w;
                    o1.x = bflo(w.z) * ri * g1.x; o1.y = bfhi(w.z) * ri * g1.y; o1.z = bflo(w.w) * ri * g1.z; o1.w = bfhi(w.w) * ri * g1.w;
                    float* op = a.out + OCKV + (size_t)row * 256 + lane * 8;
                    *(f32x4*)op = o0; *(f32x4*)(op + 4) = o1;
                }
            }
        }
        for (int i = blockIdx.x * NTHR + tid; i < 512; i += G * NTHR) RKV[NTOK + i] = 1.f;
        for (int i = blockIdx.x * NTHR + tid; i < 512 * 256 / 2; i += G * NTHR) { const f32x2 v = *(const f32x2*)(a.in[I_CCKV] + 2 * (size_t)i); ((unsigned*)(ws + WS_KVC) + (size_t)NTOK * 256 / 2)[i] = pk2(v.x, v.y); }
        __syncthreads();
        for (int it = blockIdx.x; it < 128; it += G) hgrn_pass1(a, lds, it);
    }
    xcd_barrier(gbar);
    if (PH(6)) {
        { Gemm g{(const bf16_t*)(ws + WS_QC), (const bf16_t*)(ws + WS_WQB), 384, 384, 384, 0, 0}; GridOrder S{32, 3, 1, G, (int)blockIdx.x, 0}; EpiQ E{(bf16_t*)(ws + WS_Q), (const float*)(ws + WS_RQ)};
          gemm_phase(lds, g, S, E); }
        { Gemm g{(const bf16_t*)(ws + WS_KVC), (const bf16_t*)(ws + WS_WKVB), 256, 256, 256, 0, (size_t)1024 * 256 * 2}; GridOrder S{34, 4, 1, G, (int)((blockIdx.x + G - 96 % G) % G), 32}; EpiKV E{(bf16_t*)(ws + WS_KN), (bf16_t*)(ws + WS_VT), (const float*)(ws + WS_RKV)};
          gemm_phase(lds, g, S, E); }
        __syncthreads();
        for (int it = blockIdx.x; it < 256; it += G) {
            const int dir = it & 1, seg = (it >> 1) & 7, bh = it >> 4;
            const float* s0 = a.in[I_ST] + (size_t)(((bh >> 3) * 2 + dir) * 8 + (bh & 7)) * 4096;
            f32x4 e0 = *(const f32x4*)(s0 + tid * 4), e1 = *(const f32x4*)(s0 + 2048 + tid * 4);
            const int k0 = tid >> 4, k1 = 32 + (tid >> 4);
            const int nsteps = dir == 0 ? seg : 7 - seg;
            for (int st = 0; st < nsteps; ++st) {
                const int sj = dir == 0 ? st : 7 - st;
                const int pit = (bh * 8 + sj) * 2 + dir;
                const float* sl = (const float*)(ws + WS_SLOC) + (size_t)pit * 4096;
                const float* gd = (const float*)(ws + WS_GDEC) + (size_t)pit * 64;
                const f32x4 l0 = *(const f32x4*)(sl + tid * 4), l1 = *(const f32x4*)(sl + 2048 + tid * 4);
                const float g0 = gd[k0], g1 = gd[k1];
                e0 = g0 * e0 + l0; e1 = g1 * e1 + l1;
            }
            float* se = (float*)(ws + WS_SENT) + (size_t)it * 4096;
            *(f32x4*)(se + tid * 4) = e0; *(f32x4*)(se + 2048 + tid * 4) = e1;
        }
    }
    xcd_barrier(gbar);
    if (PH(7)) {
        p7_fused(a, lds, (int)blockIdx.x);
    }
    xcd_barrier(gbar);
    if (PH(7)) {
        phase_hgfin(a, G);
    }
    xcd_barrier(gbar);
    if (PH(8)) {
    { Gemm g{(const bf16_t*)(ws + WS_O), (const bf16_t*)(ws + WS_WUP), 512, 512, 512, (size_t)NTOK * 512 * 2, (size_t)1024 * 512 * 2}; GridOrder S{32, 4, 2, G, (int)blockIdx.x, 0};
      EpiUp E{(bf16_t*)(ws + WS_T), (const bf16_t*)(ws + WS_GATE)};
      gemm_phase(lds, g, S, E); }
    }
    xcd_barrier(gbar);
    if (PH(9)) {
    { Gemm g{(const bf16_t*)(ws + WS_T), (const bf16_t*)(ws + WS_WOUT), D, D, D, (size_t)NTOK * D * 2, 0}; GridOrder S{32, 4, 2, G, (int)blockIdx.x, 0}; EpiPart E{(bf16_t*)(ws + WS_PART)};
      gemm_phase(lds, g, S, E); }
    }
    xcd_barrier(gbar);
    if (PH(10)) {
    phase_norm<3>(a, G);
    }
    xcd_barrier(gbar);
    if (PH(11)) {
    { Gemm g{(const bf16_t*)(ws + WS_XN), (const bf16_t*)(ws + WS_W2A), D, D, D, 0, 0}; GridOrder S{32, 22, 1, G, (int)blockIdx.x, 0}; EpiSwiGLU E{(bf16_t*)(ws + WS_HFF)};
      gemm_phase(lds, g, S, E); }
    }
    xcd_barrier(gbar);
    if (PH(12)) {
    { Gemm g{(const bf16_t*)(ws + WS_HFF), (const bf16_t*)(ws + WS_W2B), DFF, DFF, DFF / 2, (size_t)DFF, (size_t)DFF}; GridOrder S{32, 4, 2, G, (int)blockIdx.x, 0}; EpiPart E{(bf16_t*)(ws + WS_PART)};
      gemm_phase(lds, g, S, E); }
    }
    xcd_barrier(gbar);
    if (PH(13)) {
    phase_norm<4>(a, G);
    }
}

extern "C" void kernel_launch(void* const* d_in, const int* in_sizes, int n_in, void* d_out, int out_size, void* d_ws, size_t ws_size, hipStream_t stream) {
    static int grid = 0;
    if (grid == 0) {
        int dev = 0, cus = 0, per_cu = 0;
        if (n_in != 27 || ws_size < WS_END) { fprintf(stderr, "kernel_launch: unexpected n_in %d / ws_size %zu\n", n_in, ws_size); grid = -1; return; }
        hipGetDevice(&dev);
        hipDeviceGetAttribute(&cus, hipDeviceAttributeMultiprocessorCount, dev);
        if (hipFuncSetAttribute((const void*)fwd_megakernel, hipFuncAttributeMaxDynamicSharedMemorySize, LDS_BYTES) != hipSuccess) { fprintf(stderr, "kernel_launch: hipFuncSetAttribute failed\n"); grid = -1; return; }
        if (hipOccupancyMaxActiveBlocksPerMultiprocessor(&per_cu, (const void*)fwd_megakernel, NTHR, LDS_BYTES) != hipSuccess || per_cu < 1) { fprintf(stderr, "kernel_launch: occupancy query says %d blocks/CU\n", per_cu); grid = -1; return; }
        grid = cus;
    }
    if (grid < 0) return;
    if (hipMemsetAsync((char*)d_ws + WS_BAR, 0, 16384, stream) != hipSuccess) { fprintf(stderr, "kernel_launch: memset of barrier words failed\n"); return; }
    Args a{};
    for (int i = 0; i < 27; ++i) a.in[i] = (const float*)d_in[i];
    a.out = (float*)d_out; a.ws = (unsigned char*)d_ws;
    void* args[] = {&a};
    hipError_t e = hipLaunchCooperativeKernel((const void*)fwd_megakernel, dim3(grid), dim3(NTHR), args, LDS_BYTES, stream);
    if (e != hipSuccess) fprintf(stderr, "cooperative launch failed: %s (grid %d)\n", hipGetErrorString(e), grid);
}
```

```cpp
#include <hip/hip_runtime.h>
#include <hip/hip_cooperative_groups.h>
#include <cstdio>
#include <cstdint>
namespace cg = cooperative_groups;

#define LAS __attribute__((address_space(3)))
typedef unsigned short bf16_t;
typedef short bf16x8 __attribute__((ext_vector_type(8)));
typedef float f32x4 __attribute__((ext_vector_type(4)));
typedef float f32x2 __attribute__((ext_vector_type(2)));
typedef unsigned u32x4 __attribute__((ext_vector_type(4)));
typedef unsigned u32x2 __attribute__((ext_vector_type(2)));

constexpr int D = 1024, NTOK = 8192, NCTX = 4096, DFF = 2816;
constexpr int DIN = 5280, DIN_P = 5376;
constexpr float EPS = 1e-6f;
constexpr int NTHR = 512;
constexpr int LDS_BYTES = 147456;
constexpr int LDS_X = 131072;

constexpr size_t OY = 0, OCKV = 8388608, OKR = 9437184, OST = 9568256;

constexpr size_t MiB = 1u << 20;
constexpr size_t WS_MOD = 0;
constexpr size_t WS_LB = 512 * 1024;
constexpr size_t WS_RQ = 640 * 1024;
constexpr size_t WS_RKV = 704 * 1024;
constexpr size_t WS_BAR = 768 * 1024;
constexpr size_t WS_SLOC = 1 * MiB;
constexpr size_t WS_GDEC = 5 * MiB;
constexpr size_t WS_W1A = 6 * MiB;
constexpr size_t WS_W1B = 17 * MiB;
constexpr size_t WS_W2A = 23 * MiB;
constexpr size_t WS_W2B = 34 * MiB;
constexpr size_t WS_WIN = 40 * MiB;
constexpr size_t WS_WQB = 51 * MiB;
constexpr size_t WS_WKVB = 52 * MiB;
constexpr size_t WS_WUP = 53 * MiB;
constexpr size_t WS_WOUT = 55 * MiB;
constexpr size_t WS_XN = 57 * MiB;
constexpr size_t WS_OFW = 61 * MiB;
constexpr size_t WS_OBW = 153 * MiB;
constexpr size_t WS_SENT = 57 * MiB;
constexpr size_t WS_X = 73 * MiB;
constexpr size_t WS_PART = 105 * MiB;
constexpr size_t WS_HFF = 169 * MiB;
constexpr size_t WS_GATE = 105 * MiB;
constexpr size_t WS_O = 137 * MiB;
constexpr size_t WS_T = 169 * MiB;
constexpr size_t WS_QC = 153 * MiB;
constexpr size_t WS_KVC = 159 * MiB;
constexpr size_t WS_FF = 165 * MiB;
constexpr size_t WS_FB = 181 * MiB;
constexpr size_t WS_HQ = 197 * MiB;
constexpr size_t WS_HV = 205 * MiB;
constexpr size_t WS_HG = 213 * MiB;
constexpr size_t WS_Q = 221 * MiB;
constexpr size_t WS_KN = 233 * MiB;
constexpr size_t WS_VT = 242 * MiB;
constexpr size_t WS_KRP = 251 * MiB;
constexpr size_t WS_END = 252 * MiB;

typedef __bf16 nbf16x2 __attribute__((ext_vector_type(2)));
__device__ __forceinline__ unsigned pk2(float lo, float hi) { f32x2 v = {lo, hi}; return __builtin_bit_cast(unsigned, __builtin_convertvector(v, nbf16x2)); }
__device__ __forceinline__ float bflo(unsigned w) { return __uint_as_float(w << 16); }
__device__ __forceinline__ float bfhi(unsigned w) { return __uint_as_float(w & 0xffff0000u); }
__device__ __forceinline__ float sigmf(float x) { return __builtin_amdgcn_rcpf(1.f + __builtin_amdgcn_exp2f(-1.4426950408889634f * x)); }
__device__ __forceinline__ float siluf(float x) { return x * sigmf(x); }
__device__ __forceinline__ float wave_sum(float v) {
#pragma unroll
    for (int o = 1; o < 64; o <<= 1) v += __shfl_xor(v, o);
    return v;
}
__device__ __forceinline__ f32x4 rope4(f32x4 x, float pos, int fq) {
    f32x4 p, o;
#pragma unroll
    for (int j = 0; j < 4; ++j) p[j] = __shfl_xor(x[j], 32);
    const bool lo = fq < 2;
    const bool hi4 = (fq & 1) != 0;
    const float inv0 = hi4 ? 0.01f : 1.0f, inv1 = hi4 ? 0.0031622776601683794f : 0.31622776601683794f,
                inv2 = hi4 ? 0.001f : 0.1f, inv3 = hi4 ? 0.00031622776601683794f : 0.031622776601683794f;
    const float iv[4] = {inv0, inv1, inv2, inv3};
#pragma unroll
    for (int j = 0; j < 4; ++j) {
        float rev = pos * iv[j] * 0.15915494309189535f;
        rev -= rintf(rev);
        const float s = __builtin_amdgcn_sinf(rev), c = __builtin_amdgcn_cosf(rev);
        o[j] = lo ? (x[j] * c - p[j] * s) : (x[j] * c + p[j] * s);
    }
    return o;
}

namespace pg8 {
constexpr int BM = 256, BK = 64, HALF = 128, HTB = HALF * BK * 2, STAGE_BYTES = 8 * HTB, NXCD = 8, WGM = 8;
__device__ __forceinline__ int lds_byte(int r, int c) { const int st = (r >> 4) * 2 + (c >> 5), rr = r & 15, cc = c & 31, ob = rr * 64 + cc * 2; return st * 1024 + (ob ^ (((ob >> 9) & 1) << 5)); }
__device__ __forceinline__ void stage_rc(int b, int& R, int& C) { const int st = b / 1024, sb = b % 1024, swz = sb ^ (((sb >> 9) & 1) << 5); R = (st >> 1) * 16 + swz / 64; C = (st & 1) * 32 + (swz % 64) / 2; }

__device__ __forceinline__ int perm32(int rho) { const int n = rho >> 4, i = rho & 15; return 8 * (i >> 2) + 4 * n + (i & 3); }
struct Unit { int pm, pn, z; };
struct Gemm { const bf16_t* A; const bf16_t* Bt; int lda, ldb, K; size_t zA, zB; };

__device__ __forceinline__ void order_unit(int L, int nM, int nN, Unit& u) {
    const int nwg = nM * nN;
    u.z = L / nwg; int wgid = L - u.z * nwg;
    { const int q = nwg / NXCD, r = nwg % NXCD, xcd = wgid % NXCD, off = wgid / NXCD; wgid = (xcd < r ? xcd * (q + 1) : r * (q + 1) + (xcd - r) * q) + off; }
    const int nig = WGM * nN, gid = wgid / nig, fm = gid * WGM, gsz = (nM - fm) < WGM ? (nM - fm) : WGM;
    u.pm = fm + ((wgid % nig) % gsz); u.pn = (wgid % nig) / gsz;
}
struct GridOrder {
    int nM, nN, nZ, G, c, zpm;
    __device__ __forceinline__ bool next(int i, Unit& u) const {
        const int L = i * G + c; if (L >= nM * nN * nZ) return false;
        order_unit(L, nM, nN, u); if (zpm > 0) u.z = u.pm >= zpm ? 1 : 0; return true;
    }
};
struct SingleOrder {
    Unit u0;
    __device__ __forceinline__ bool next(int i, Unit& u) const { if (i != 0) return false; u = u0; return true; }
};

template <class Epi, class Sched>
__device__ __forceinline__ void gemm_phase(LAS unsigned char* lds, const Gemm g, const Sched& S, const Epi& E) {
    const int tid = threadIdx.x, wid = __builtin_amdgcn_readfirstlane(tid >> 6), lane = tid & 63, wr = wid >> 2, wc = wid & 3, fr = lane & 15, fq = lane >> 4;
    int K_ = g.K; asm volatile("" : "+s"(K_));
    const int nt = K_ / BK;
    unsigned voffA[2], voffB[2];
#pragma unroll
    for (int i = 0; i < 2; ++i) { int R, C; stage_rc(tid * 16 + i * 8192, R, C);
        const int Rb = Epi::PERM ? ((R & ~31) + perm32(R & 31)) : R;
        voffA[i] = (unsigned)(R * g.lda + C) * 2u; voffB[i] = (unsigned)(Rb * g.ldb + C) * 2u; }
    const size_t kstep = (size_t)(BK * 2);
    const size_t hstepA = (size_t)HALF * g.lda * 2, hstepB = (size_t)HALF * g.ldb * 2;
    const size_t tstepA = 2 * hstepA, tstepB = 2 * hstepB;
    const unsigned ldsw = (unsigned)wid * 1024u;
    const int aoff = lds_byte(wr * 64 + fr, fq * 8), boff = lds_byte(wc * 32 + fr, fq * 8);
#define PG8_SA(b, h) (((b) * 2 + (h)) * HTB)
#define PG8_SB(b, h) ((4 + (b) * 2 + (h)) * HTB)
#define PG8_STAGE(bufoff, gbase, voff) do { _Pragma("unroll") for (int _i = 0; _i < 2; ++_i) \
        __builtin_amdgcn_global_load_lds((const unsigned*)((const char*)(gbase) + (voff)[_i]), (LAS unsigned*)(lds + (bufoff) + ldsw + _i * 8192), 16, 0, 0); } while (0)
#define PG8_LDA(dst, b, h) do { _Pragma("unroll") for (int m = 0; m < 4; ++m) _Pragma("unroll") for (int k = 0; k < 2; ++k) dst[m][k] = *(const LAS bf16x8*)(lds + PG8_SA(b, h) + aoff + m * 2048 + k * 1024); } while (0)
#define PG8_LDB(dst, b, h) do { _Pragma("unroll") for (int n = 0; n < 2; ++n) _Pragma("unroll") for (int k = 0; k < 2; ++k) dst[n][k] = *(const LAS bf16x8*)(lds + PG8_SB(b, h) + boff + n * 2048 + k * 1024); } while (0)
#define PG8_MMA(ai, bj, At, Bt) do { __builtin_amdgcn_s_setprio(1); _Pragma("unroll") for (int m = 0; m < 4; ++m) _Pragma("unroll") for (int n = 0; n < 2; ++n) _Pragma("unroll") for (int k = 0; k < 2; ++k) \
        acc[ai][bj][m][n] = __builtin_amdgcn_mfma_f32_16x16x32_bf16(Bt[n][k], At[m][k], acc[ai][bj][m][n], 0, 0, 0); __builtin_amdgcn_s_setprio(0); } while (0)
#define PG8_WAIT_V(n) asm volatile("s_waitcnt vmcnt(" #n ")" ::: "memory")
#define PG8_WAIT_L(n) asm volatile("s_waitcnt lgkmcnt(" #n ")" ::: "memory")
#define PG8_BAR __builtin_amdgcn_s_barrier()
#define PG8_SCHED __builtin_amdgcn_sched_barrier(0)
    Unit cur, nxt; int ui = 0;
    if (!S.next(0, cur)) return;
    f32x4 acc[2][2][4][2];
#pragma unroll
    for (int a = 0; a < 2; ++a)
#pragma unroll
        for (int b = 0; b < 2; ++b)
#pragma unroll
            for (int m = 0; m < 4; ++m)
#pragma unroll
                for (int n = 0; n < 2; ++n) acc[a][b][m][n] = (f32x4){0.f, 0.f, 0.f, 0.f};
    bf16x8 At[4][2], B0[2][2], B1[2][2];
    const char* cA = (const char*)g.A + (size_t)cur.z * g.zA + (size_t)cur.pm * tstepA;
    const char* cB = (const char*)g.Bt + (size_t)cur.z * g.zB + (size_t)cur.pn * tstepB;
    PG8_STAGE(PG8_SB(0, 0), cB, voffB); PG8_STAGE(PG8_SB(0, 1), cB + hstepB, voffB); PG8_STAGE(PG8_SA(0, 0), cA, voffA); PG8_STAGE(PG8_SA(0, 1), cA + hstepA, voffA);
    if (wr == 1) PG8_BAR;
    PG8_WAIT_V(2); PG8_BAR;
    PG8_STAGE(PG8_SB(1, 0), cB + kstep, voffB); PG8_STAGE(PG8_SA(1, 0), cA + kstep, voffA); PG8_STAGE(PG8_SB(1, 1), cB + hstepB + kstep, voffB);
    PG8_WAIT_V(6); PG8_BAR;
    for (;;) {
        const bool has_next = S.next(ui + 1, nxt);
        const char* nA = has_next ? (const char*)g.A + (size_t)nxt.z * g.zA + (size_t)nxt.pm * tstepA : cA;
        const char* nB = has_next ? (const char*)g.Bt + (size_t)nxt.z * g.zB + (size_t)nxt.pn * tstepB : cB;
        for (int t = 0; t < nt; t += 2) {
            const bool last = (t == nt - 2);
            const char* a1 = cA + (size_t)(t + 1) * kstep;
            const char* a2 = last ? nA : cA + (size_t)(t + 2) * kstep; const char* b2 = last ? nB : cB + (size_t)(t + 2) * kstep;
            const char* a3 = a2 + kstep; const char* b3 = b2 + kstep;
            PG8_LDB(B0, 0, 0); PG8_LDB(B1, 0, 1); PG8_SCHED; PG8_LDA(At, 0, 0); PG8_STAGE(PG8_SA(1, 1), a1 + hstepA, voffA);
            PG8_WAIT_V(8); PG8_WAIT_L(0); PG8_BAR; PG8_MMA(0, 0, At, B0); PG8_MMA(0, 1, At, B1); PG8_BAR; PG8_SCHED;
            PG8_LDA(At, 0, 1); PG8_STAGE(PG8_SB(0, 0), b2, voffB); PG8_STAGE(PG8_SB(0, 1), b2 + hstepB, voffB); PG8_STAGE(PG8_SA(0, 0), a2, voffA);
            PG8_WAIT_V(8); PG8_WAIT_L(0); PG8_BAR; PG8_MMA(1, 0, At, B0); PG8_MMA(1, 1, At, B1); PG8_BAR; PG8_SCHED;
            PG8_LDB(B0, 1, 0); PG8_LDB(B1, 1, 1); PG8_SCHED; PG8_LDA(At, 1, 0); PG8_STAGE(PG8_SA(0, 1), a2 + hstepA, voffA);
            PG8_WAIT_V(8); PG8_WAIT_L(0); PG8_BAR; PG8_MMA(0, 0, At, B0); PG8_MMA(0, 1, At, B1); PG8_BAR; PG8_SCHED;
            PG8_LDA(At, 1, 1); PG8_STAGE(PG8_SB(1, 0), b3, voffB); PG8_STAGE(PG8_SB(1, 1), b3 + hstepB, voffB); PG8_STAGE(PG8_SA(1, 0), a3, voffA);
            PG8_WAIT_V(8); PG8_WAIT_L(0); PG8_BAR; PG8_MMA(1, 0, At, B0); PG8_MMA(1, 1, At, B1); PG8_BAR; PG8_SCHED;
        }
        if (wr == 0) PG8_BAR;
        E(acc, cur, wr, wc, fr, fq);
        if (!has_next) break;
#pragma unroll
        for (int a = 0; a < 2; ++a)
#pragma unroll
            for (int b = 0; b < 2; ++b)
#pragma unroll
                for (int m = 0; m < 4; ++m)
#pragma unroll
                    for (int n = 0; n < 2; ++n) acc[a][b][m][n] = (f32x4){0.f, 0.f, 0.f, 0.f};
        cur = nxt; cA = nA; cB = nB; ++ui;
        if (wr == 1) PG8_BAR;
    }
    PG8_WAIT_V(0);
    PG8_BAR;
#undef PG8_SA
#undef PG8_SB
#undef PG8_STAGE
#undef PG8_LDA
#undef PG8_LDB
#undef PG8_MMA
#undef PG8_WAIT_V
#undef PG8_WAIT_L
#undef PG8_BAR
#undef PG8_SCHED
}

template <int ACT, bool F32>
__device__ __forceinline__ void tile_store(const f32x4 (&acc)[2][2][4][2], void* dst, int ld, int row0, int col0, const float* lbp) {
    f32x4 lb[2][2];
    if (ACT == 3) {
#pragma unroll
        for (int bj = 0; bj < 2; ++bj)
#pragma unroll
            for (int n = 0; n < 2; ++n) lb[bj][n] = *(const f32x4*)(lbp + bj * HALF + n * 16);
    }
#pragma unroll
    for (int ai = 0; ai < 2; ++ai)
#pragma unroll
        for (int m = 0; m < 4; ++m) {
            const size_t ro = (size_t)(row0 + ai * HALF + m * 16) * ld + col0;
#pragma unroll
            for (int bj = 0; bj < 2; ++bj)
#pragma unroll
                for (int n = 0; n < 2; ++n) {
                    f32x4 v = acc[ai][bj][m][n];
#pragma unroll
                    for (int j = 0; j < 4; ++j) {
                        if (ACT == 1) v[j] = siluf(v[j]);
                        if (ACT == 2) v[j] = sigmf(v[j]);
                        if (ACT == 3) v[j] = lb[bj][n][j] + (1.f - lb[bj][n][j]) * sigmf(v[j]);
                    }
                    if (F32) *(f32x4*)((float*)dst + ro + bj * HALF + n * 16) = v;
                    else { u32x2 w; w.x = pk2(v[0], v[1]); w.y = pk2(v[2], v[3]); *(u32x2*)((bf16_t*)dst + ro + bj * HALF + n * 16) = w; }
                }
            asm volatile("" ::: "memory");
        }
}

struct EpiSwiGLU {
    static constexpr bool PERM = false;
    bf16_t* H;
    __device__ __forceinline__ void operator()(const f32x4 (&acc)[2][2][4][2], const Unit& u_, int wr, int wc, int fr, int fq) const {
        Unit u; u.pm = __builtin_amdgcn_readfirstlane(u_.pm); u.pn = __builtin_amdgcn_readfirstlane(u_.pn); u.z = __builtin_amdgcn_readfirstlane(u_.z); asm volatile("" : "+v"(fr), "+v"(fq), "+s"(u.pm), "+s"(u.pn), "+s"(u.z));
        const int row0 = u.pm * BM + wr * 64 + fr;
#pragma unroll
        for (int ai = 0; ai < 2; ++ai)
#pragma unroll
            for (int m = 0; m < 4; ++m) {
                bf16_t* rp = H + (size_t)(row0 + ai * HALF + m * 16) * DFF + 4 * fq;
#pragma unroll
                for (int bj = 0; bj < 2; ++bj) {
                    const int g = 8 * u.pn + 4 * bj + wc;
                    const f32x4 a = acc[ai][bj][m][0], b = acc[ai][bj][m][1];
                    u32x2 w; w.x = pk2(siluf(a[0]) * b[0], siluf(a[1]) * b[1]); w.y = pk2(siluf(a[2]) * b[2], siluf(a[3]) * b[3]);
                    *(u32x2*)(rp + 16 * g) = w;
                }
                asm volatile("" ::: "memory");
            }
    }
};
struct EpiPart {
    static constexpr bool PERM = true;
    bf16_t* P;
    __device__ __forceinline__ void operator()(const f32x4 (&acc)[2][2][4][2], const Unit& u_, int wr, int wc, int fr, int fq) const {
        Unit u; u.pm = __builtin_amdgcn_readfirstlane(u_.pm); u.pn = __builtin_amdgcn_readfirstlane(u_.pn); u.z = __builtin_amdgcn_readfirstlane(u_.z); asm volatile("" : "+v"(fr), "+v"(fq), "+s"(u.pm), "+s"(u.pn), "+s"(u.z));
        bf16_t* base = P + (size_t)u.z * NTOK * D + (size_t)(u.pm * BM + wr * 64 + fr) * D + u.pn * BM + wc * 32 + 8 * fq;
#pragma unroll
        for (int ai = 0; ai < 2; ++ai)
#pragma unroll
            for (int m = 0; m < 4; ++m) {
                bf16_t* rp = base + (size_t)(ai * HALF + m * 16) * D;
#pragma unroll
                for (int bj = 0; bj < 2; ++bj) {
                    const f32x4 v0 = acc[ai][bj][m][0], v1 = acc[ai][bj][m][1];
                    u32x4 w; w.x = pk2(v0[0], v0[1]); w.y = pk2(v0[2], v0[3]); w.z = pk2(v1[0], v1[1]); w.w = pk2(v1[2], v1[3]);
                    *(u32x4*)(rp + bj * HALF) = w;
                }
                asm volatile("" ::: "memory");
            }
    }
};
struct EpiUp {
    static constexpr bool PERM = true;
    bf16_t* T; const bf16_t* GATE;
    __device__ __forceinline__ void operator()(const f32x4 (&acc)[2][2][4][2], const Unit& u_, int wr, int wc, int fr, int fq) const {
        Unit u; u.pm = __builtin_amdgcn_readfirstlane(u_.pm); u.pn = __builtin_amdgcn_readfirstlane(u_.pn); u.z = __builtin_amdgcn_readfirstlane(u_.z); asm volatile("" : "+v"(fr), "+v"(fq), "+s"(u.pm), "+s"(u.pn), "+s"(u.z));
        const size_t off0 = (size_t)u.z * NTOK * D + (size_t)(u.pm * BM + wr * 64 + fr) * D + u.pn * BM + wc * 32 + 8 * fq;
#pragma unroll
        for (int ai = 0; ai < 2; ++ai)
#pragma unroll
            for (int m = 0; m < 4; ++m) {
                const size_t ro = off0 + (size_t)(ai * HALF + m * 16) * D;
#pragma unroll
                for (int bj = 0; bj < 2; ++bj) {
                    const u32x4 gw = *(const u32x4*)(GATE + ro + bj * HALF);
                    const f32x4 v0 = acc[ai][bj][m][0], v1 = acc[ai][bj][m][1];
                    u32x4 w; w.x = pk2(v0[0] * bflo(gw.x), v0[1] * bfhi(gw.x)); w.y = pk2(v0[2] * bflo(gw.y), v0[3] * bfhi(gw.y));
                    w.z = pk2(v1[0] * bflo(gw.z), v1[1] * bfhi(gw.z)); w.w = pk2(v1[2] * bflo(gw.w), v1[3] * bfhi(gw.w));
                    *(u32x4*)(T + ro + bj * HALF) = w;
                }
                asm volatile("" ::: "memory");
            }
    }
};
struct EpiIn {
    static constexpr bool PERM = false;
    bf16_t *QC, *KVC, *HQ, *HV, *HG, *GATE, *KRP; float *FF, *FB, *KRO; const float* LB;
    __device__ __forceinline__ void operator()(const f32x4 (&acc)[2][2][4][2], const Unit& u_, int wr, int wc, int fr, int fq) const {
        Unit u; u.pm = __builtin_amdgcn_readfirstlane(u_.pm); u.pn = __builtin_amdgcn_readfirstlane(u_.pn); u.z = __builtin_amdgcn_readfirstlane(u_.z); asm volatile("" : "+v"(fr), "+v"(fq), "+s"(u.pm), "+s"(u.pn), "+s"(u.z));
        const int pn = u.pn, row0 = u.pm * BM + wr * 64 + fr, cw = wc * 32 + 4 * fq;
        if (pn == 0) { tile_store<0, false>(acc, QC, 384, row0, cw, nullptr); }
        else if (pn == 2) { tile_store<0, false>(acc, KVC, 256, row0, cw, nullptr); }
        else if (pn == 1) {
#pragma unroll
            for (int ai = 0; ai < 2; ++ai)
#pragma unroll
                for (int m = 0; m < 4; ++m) {
                    const int row = row0 + ai * HALF + m * 16;
#pragma unroll
                    for (int n = 0; n < 2; ++n) { const f32x4 v = acc[ai][0][m][n]; u32x2 w; w.x = pk2(v[0], v[1]); w.y = pk2(v[2], v[3]);
                        *(u32x2*)(QC + (size_t)row * 384 + 256 + cw + n * 16) = w; }
                    if (wc == 0) {
                        f32x4 v0 = acc[ai][1][m][0], v1 = acc[ai][1][m][1];
                        int kidx;
                        if (u.pm >= 16) { const int t = (row - NCTX) & 2047; v0 = rope4(v0, (float)(t >> 6), fq); v1 = rope4(v1, (float)(t & 63), fq);
                            kidx = NCTX + ((row - NCTX) >> 11) * 2304 + 256 + t; }
                        else { kidx = row; *(f32x4*)(KRO + (size_t)row * 32 + 4 * fq) = v0; *(f32x4*)(KRO + (size_t)row * 32 + 16 + 4 * fq) = v1; }
                        u32x2 w; w.x = pk2(v0[0], v0[1]); w.y = pk2(v0[2], v0[3]); *(u32x2*)(KRP + (size_t)kidx * 32 + 4 * fq) = w;
                        w.x = pk2(v1[0], v1[1]); w.y = pk2(v1[2], v1[3]); *(u32x2*)(KRP + (size_t)kidx * 32 + 16 + 4 * fq) = w;
                    }
                    asm volatile("" ::: "memory");
                }
        }
        else if (pn <= 12) {
            const int seg = (pn - 3) >> 1, c0 = ((pn - 3) & 1) * 256 + cw;
            if (seg == 0) tile_store<1, false>(acc, HQ, 512, row0, c0, nullptr);
            else if (seg == 1) tile_store<3, true>(acc, FF, 512, row0, c0, LB + c0);
            else if (seg == 2) tile_store<3, true>(acc, FB, 512, row0, c0, LB + 512 + c0);
            else if (seg == 3) tile_store<0, false>(acc, HV, 512, row0, c0, nullptr);
            else tile_store<1, false>(acc, HG, 512, row0, c0, nullptr);
        }
        else { const int z = (pn - 13) >> 2, c0 = ((pn - 13) & 3) * 256 + cw;
            tile_store<2, false>(acc, GATE + (size_t)z * NTOK * D, D, row0, c0, nullptr); }
    }
};
struct EpiQ {
    static constexpr bool PERM = false;
    bf16_t* Q; const float* rinv;
    __device__ __forceinline__ void operator()(const f32x4 (&acc)[2][2][4][2], const Unit& u_, int wr, int wc, int fr, int fq) const {
        Unit u; u.pm = __builtin_amdgcn_readfirstlane(u_.pm); u.pn = __builtin_amdgcn_readfirstlane(u_.pn); u.z = __builtin_amdgcn_readfirstlane(u_.z); asm volatile("" : "+v"(fr), "+v"(fq), "+s"(u.pm), "+s"(u.pn), "+s"(u.z));
#pragma unroll
        for (int ai = 0; ai < 2; ++ai)
#pragma unroll
            for (int m = 0; m < 4; ++m) {
                const int rl = ai * HALF + wr * 64 + m * 16 + fr, row = u.pm * BM + rl;
                const float ri = rinv[row];
#pragma unroll
                for (int bj = 0; bj < 2; ++bj) {
                    const int g32 = 8 * u.pn + 4 * bj + wc;
                    const f32x4 v0 = acc[ai][bj][m][0] * ri, v1 = acc[ai][bj][m][1] * ri;
                    bf16_t* p = Q + (size_t)row * 768 + g32 * 32 + 4 * fq;
                    u32x2 w; w.x = pk2(v0[0], v0[1]); w.y = pk2(v0[2], v0[3]); *(u32x2*)p = w;
                    w.x = pk2(v1[0], v1[1]); w.y = pk2(v1[2], v1[3]); *(u32x2*)(p + 16) = w;
                }
                asm volatile("" ::: "memory");
            }
    }
};
struct EpiKV {
    static constexpr bool PERM = false;
    bf16_t *KN, *VT; const float* rinv;
    __device__ __forceinline__ void operator()(const f32x4 (&acc)[2][2][4][2], const Unit& u_, int wr, int wc, int fr, int fq) const {
        Unit u; u.pm = __builtin_amdgcn_readfirstlane(u_.pm); u.pn = __builtin_amdgcn_readfirstlane(u_.pn); u.z = 0; asm volatile("" : "+v"(fr), "+v"(fq), "+s"(u.pm), "+s"(u.pn));
        const int pm = u.pm;
        int ab, kidx0;
        if (pm < 16) { ab = pm; kidx0 = pm * 256; }
        else if (pm < 32) { ab = 16 + ((pm - 16) >> 3); kidx0 = NCTX + (ab - 16) * 2304 + 256 + ((pm - 16) & 7) * 256; }
        else { ab = 16 + (pm - 32); kidx0 = NCTX + (ab - 16) * 2304; }
        const int Tk = ab < 16 ? 256 : 2304;
        const int j0 = kidx0 - (ab < 16 ? ab * 256 : NCTX + (ab - 16) * 2304);
#pragma unroll
        for (int bj = 0; bj < 2; ++bj) {
            const int h = 2 * u.pn + bj;
            if (wc < 2) {
                bf16_t* base = KN + (size_t)kidx0 * 512 + h * 64 + wc * 32 + 4 * fq;
#pragma unroll
                for (int ai = 0; ai < 2; ++ai)
#pragma unroll
                    for (int m = 0; m < 4; ++m) {
                        const int rl = ai * HALF + wr * 64 + m * 16 + fr;
                        const float ri = rinv[pm * BM + rl];
#pragma unroll
                        for (int n = 0; n < 2; ++n) {
                            const f32x4 v = acc[ai][bj][m][n] * ri;
                            u32x2 w; w.x = pk2(v[0], v[1]); w.y = pk2(v[2], v[3]);
                            *(u32x2*)(base + (size_t)rl * 512 + n * 16) = w;
                        }
                        asm volatile("" ::: "memory");
                    }
            } else {
                const size_t vb = ab < 16 ? (size_t)(ab * 8 + h) * 64 * 256 : (size_t)16 * 8 * 64 * 256 + (size_t)((ab - 16) * 8 + h) * 64 * 2304;
                bf16_t* base = VT + vb + (size_t)((wc - 2) * 32 + 4 * fq) * Tk + j0;
#pragma unroll
                for (int ai = 0; ai < 2; ++ai)
#pragma unroll
                    for (int m = 0; m < 4; ++m) {
                        const int rl = ai * HALF + wr * 64 + m * 16 + fr;
                        const float ri = rinv[pm * BM + rl];
#pragma unroll
                        for (int n = 0; n < 2; ++n) {
                            const f32x4 v = acc[ai][bj][m][n] * ri;
                            const unsigned w0 = pk2(v[0], v[1]), w1 = pk2(v[2], v[3]);
                            bf16_t* vp = base + (size_t)(n * 16) * Tk + rl;
                            vp[0] = (bf16_t)(w0 & 0xffffu); vp[Tk] = (bf16_t)(w0 >> 16); vp[2 * Tk] = (bf16_t)(w1 & 0xffffu); vp[3 * Tk] = (bf16_t)(w1 >> 16);
                        }
                        asm volatile("" ::: "memory");
                    }
            }
        }
    }
};
}

struct Args { const float* in[27]; float* out; unsigned char* ws; };
enum { I_XP = 0, I_XS, I_CCKV, I_CKR, I_ST, I_C, I_CCTX, I_WADA, I_BADA, I_NORMG, I_F1W1, I_F1W3, I_F1W2, I_F2W1, I_F2W3, I_F2W2, I_WIN, I_QNG, I_WQB, I_KVNG, I_WKVB,
       I_WUPA, I_HGGAMMA, I_HGNG, I_WUPR, I_WOUT, I_FING };

__device__ __forceinline__ int map_row(int mode, int n) {
    if (mode == 1) return 32 * (n >> 4) + (n & 15);
    if (mode == 2) return 32 * (n >> 4) + 16 + (n & 15);
    if (mode == 3) return n < 384 ? n : (n < 640 ? n + 128 : (n < 672 ? n - 256 : n + 96));
    return n;
}
__device__ __forceinline__ void tr_item(const float* W, int K, int N, bf16_t* WT, int mode, const float* ksc, LAS float* scr, int item, int lane) {
    const int nblk = N / 32, kb = item / nblk, nb = item % nblk, k0 = 64 * kb, n0 = 32 * nb;
    float tv[32];
#pragma unroll
    for (int i = 0; i < 32; ++i) { const int kk = 2 * i + (lane >> 5); tv[i] = W[(size_t)(k0 + kk) * N + n0 + (lane & 31)]; }
#pragma unroll
    for (int i = 0; i < 32; ++i) { const int kk = 2 * i + (lane >> 5); float v = tv[i]; if (ksc) v *= ksc[k0 + kk]; scr[kk * 33 + (lane & 31)] = v; }
    asm volatile("s_waitcnt lgkmcnt(0)" ::: "memory");
    const int c = lane & 7;
#pragma unroll
    for (int j = 0; j < 4; ++j) { const int n = (lane >> 3) + 8 * j; const LAS float* s = scr + (8 * c) * 33 + n;
        u32x4 o; o.x = pk2(s[0 * 33], s[1 * 33]); o.y = pk2(s[2 * 33], s[3 * 33]); o.z = pk2(s[4 * 33], s[5 * 33]); o.w = pk2(s[6 * 33], s[7 * 33]);
        *(u32x4*)(WT + (size_t)map_row(mode, n0 + n) * K + k0 + 8 * c) = o; }
    asm volatile("s_waitcnt lgkmcnt(0)" ::: "memory");
}

constexpr int TRI_F = 1408, TRI_IN = 2640, TRI_QB = 144, TRI_KVB = 128, TRI_UP = 256, TRI_OUT = 512;
constexpr int TR_A0 = 0, TR_A1 = 2 * TRI_F;
constexpr int TR_B0 = TR_A1, TR_B1 = TR_B0 + TRI_F + TRI_IN;
constexpr int TR_C0 = TR_B1, TR_C1 = TR_C0 + 3 * TRI_F + TRI_QB + 2 * TRI_KVB + 2 * TRI_UP + TRI_OUT;
__device__ __forceinline__ void tr_range(const Args& a, LAS unsigned char* lds, int lo, int hi, int gw, int nw) {
    const int lane = threadIdx.x & 63, wave = threadIdx.x >> 6;
    unsigned char* ws = a.ws;
    LAS float* scr = (LAS float*)(lds + wave * 8448);
    for (int it = lo + gw; it < hi; it += nw) {
        int r = it;
        if (r < TRI_F) { tr_item(a.in[I_F1W1], 1024, DFF, (bf16_t*)(ws + WS_W1A), 1, nullptr, scr, r, lane); continue; } r -= TRI_F;
        if (r < TRI_F) { tr_item(a.in[I_F1W3], 1024, DFF, (bf16_t*)(ws + WS_W1A), 2, nullptr, scr, r, lane); continue; } r -= TRI_F;
        if (r < TRI_F) { tr_item(a.in[I_F1W2], DFF, 1024, (bf16_t*)(ws + WS_W1B), 0, nullptr, scr, r, lane); continue; } r -= TRI_F;
        if (r < TRI_IN) { tr_item(a.in[I_WIN], 1024, DIN, (bf16_t*)(ws + WS_WIN), 3, nullptr, scr, r, lane); continue; } r -= TRI_IN;
        if (r < TRI_F) { tr_item(a.in[I_F2W1], 1024, DFF, (bf16_t*)(ws + WS_W2A), 1, nullptr, scr, r, lane); continue; } r -= TRI_F;
        if (r < TRI_F) { tr_item(a.in[I_F2W3], 1024, DFF, (bf16_t*)(ws + WS_W2A), 2, nullptr, scr, r, lane); continue; } r -= TRI_F;
        if (r < TRI_F) { tr_item(a.in[I_F2W2], DFF, 1024, (bf16_t*)(ws + WS_W2B), 0, nullptr, scr, r, lane); continue; } r -= TRI_F;
        if (r < TRI_QB) { tr_item(a.in[I_WQB], 384, 768, (bf16_t*)(ws + WS_WQB), 0, a.in[I_QNG], scr, r, lane); continue; } r -= TRI_QB;
        if (r < TRI_KVB) { tr_item(a.in[I_WKVB], 256, 1024, (bf16_t*)(ws + WS_WKVB), 0, a.in[I_KVNG], scr, r, lane); continue; } r -= TRI_KVB;
        if (r < TRI_KVB) { tr_item(a.in[I_WKVB], 256, 1024, (bf16_t*)(ws + WS_WKVB) + 1024 * 256, 0, nullptr, scr, r, lane); continue; } r -= TRI_KVB;
        if (r < TRI_UP) { tr_item(a.in[I_WUPA], 512, 1024, (bf16_t*)(ws + WS_WUP), 0, nullptr, scr, r, lane); continue; } r -= TRI_UP;
        if (r < TRI_UP) { tr_item(a.in[I_WUPR], 512, 1024, (bf16_t*)(ws + WS_WUP) + 1024 * 512, 0, nullptr, scr, r, lane); continue; } r -= TRI_UP;
        tr_item(a.in[I_WOUT], 1024, 1024, (bf16_t*)(ws + WS_WOUT), 0, nullptr, scr, r, lane);
    }
}
__device__ __forceinline__ void tr_in_tail(const Args& a, LAS unsigned char* lds, int nunits, int lo, int hi, int G) {
    const int r = nunits % G, wave = threadIdx.x >> 6;
    if (r == 0) tr_range(a, lds, lo, hi, (int)blockIdx.x * 8 + wave, G * 8);
    else if ((int)blockIdx.x >= r) tr_range(a, lds, lo, hi, ((int)blockIdx.x - r) * 8 + wave, (G - r) * 8);
}

__device__ __forceinline__ void phase_prep(const Args& a, LAS unsigned char* lds, int G) {
    const int tid = threadIdx.x, lane = tid & 63, wave = tid >> 6;
    unsigned char* ws = a.ws;
    for (int nb = blockIdx.x; nb < 72; nb += G) {
        LAS float* sc = (LAS float*)lds;
        for (int i = tid; i < 3072; i += NTHR) { const int s = i >> 10, k = i & 1023; const float v = (s == 0) ? a.in[I_CCTX][k] : a.in[I_C][(s - 1) * 1024 + k]; sc[i] = siluf(v); }
        __syncthreads();
        const float* wp = a.in[I_WADA] + (size_t)(wave * 128) * 9216 + nb * 128 + 2 * lane;
        float a00 = 0.f, a01 = 0.f, a10 = 0.f, a11 = 0.f, a20 = 0.f, a21 = 0.f;
#pragma unroll 32
        for (int kk = 0; kk < 128; ++kk) {
            const f32x2 w = *(const f32x2*)(wp + (size_t)kk * 9216);
            const float s0 = sc[wave * 128 + kk], s1 = sc[1024 + wave * 128 + kk], s2 = sc[2048 + wave * 128 + kk];
            a00 += s0 * w.x; a01 += s0 * w.y; a10 += s1 * w.x; a11 += s1 * w.y; a20 += s2 * w.x; a21 += s2 * w.y;
        }
        LAS float* red = sc + 3072;
        red[(wave * 3 + 0) * 128 + 2 * lane] = a00; red[(wave * 3 + 0) * 128 + 2 * lane + 1] = a01;
        red[(wave * 3 + 1) * 128 + 2 * lane] = a10; red[(wave * 3 + 1) * 128 + 2 * lane + 1] = a11;
        red[(wave * 3 + 2) * 128 + 2 * lane] = a20; red[(wave * 3 + 2) * 128 + 2 * lane + 1] = a21;
        __syncthreads();
        for (int i = tid; i < 384; i += NTHR) { const int s = i >> 7, col = i & 127; float v = a.in[I_BADA][nb * 128 + col];
#pragma unroll
            for (int w = 0; w < 8; ++w) v += red[(w * 3 + s) * 128 + col];
            ((float*)(ws + WS_MOD))[s * 9216 + nb * 128 + col] = v; }
        __syncthreads();
    }
    {
        const int nskip = G >= 144 ? 72 : 0;
        const int gw = ((int)blockIdx.x - nskip) * 8 + wave;
        if (gw >= 0) tr_range(a, lds, TR_A0, TR_A1, gw, (G - nskip) * 8);
    }
    {
        const int gt = blockIdx.x * NTHR + tid, NT = G * NTHR;
        for (int i = gt; i < 1024; i += NT) { const int dir = i >> 9, n = i & 511; const float g0 = a.in[I_HGGAMMA][dir * 1024 + n], g1 = a.in[I_HGGAMMA][dir * 1024 + 512 + n];
            ((float*)(ws + WS_LB))[i] = 1.f / (1.f + __expf(g1 - g0)); }
        for (int i = gt; i < 96 * 1024 / 2; i += NT) ((unsigned*)(ws + WS_WIN) + (size_t)416 * 1024 / 2)[i] = 0u;
        for (int i = gt; i < 512 * 32 / 2; i += NT) { const int e = 2 * i, r = e >> 5, cc = e & 31, b = r >> 8, j = r & 255; const f32x2 v = *(const f32x2*)(a.in[I_CKR] + e);
            *(unsigned*)((bf16_t*)(ws + WS_KRP) + (size_t)(NCTX + b * 2304 + j) * 32 + cc) = pk2(v.x, v.y); }
    }
}

template <int MODE>
__device__ __forceinline__ void phase_norm(const Args& a, int G) {
    const int tid = threadIdx.x, lane = tid & 63, wave = tid >> 6;
    unsigned char* ws = a.ws;
    const float* MOD = (const float*)(ws + WS_MOD);
    bf16_t* X = (bf16_t*)(ws + WS_X);
    const bf16_t* P0 = (const bf16_t*)(ws + WS_PART); const bf16_t* P1 = P0 + (size_t)NTOK * D;
    bf16_t* XN = (bf16_t*)(ws + WS_XN);
    constexpr int GI = MODE == 2 ? 2 : (MODE == 3 ? 5 : 8);
    constexpr float GS = MODE == 3 ? 1.0f : 0.5f;
    constexpr int SH = MODE == 1 ? 0 : (MODE == 2 ? 3 : 6), SC = SH + 1;
    for (int rb = blockIdx.x * 8 + wave; rb < NTOK / 4; rb += G * 8) {
        const int row0 = rb * 4;
        const int s = row0 < NCTX ? 0 : 1 + ((row0 - NCTX) >> 11);
        const float* md = MOD + (size_t)s * 9216;
        f32x4 v[4][4]; float ss[4] = {0.f, 0.f, 0.f, 0.f};
        f32x4 gt[4];
        if (MODE != 1) {
#pragma unroll
            for (int j = 0; j < 4; ++j) gt[j] = *(const f32x4*)(md + GI * 1024 + 4 * lane + 256 * j) * GS;
        }
#pragma unroll
        for (int i = 0; i < 4; ++i) {
            const int row = row0 + i;
            const float* xsrc = row < NCTX ? a.in[I_XP] + (size_t)row * D : a.in[I_XS] + (size_t)(row - NCTX) * D;
#pragma unroll
            for (int j = 0; j < 4; ++j) {
                const int c = 4 * lane + 256 * j;
                if (MODE == 1 || MODE == 2) v[i][j] = *(const f32x4*)(xsrc + c);
                else { const u32x2 xw = *(const u32x2*)(X + (size_t)row * D + c); v[i][j].x = bflo(xw.x); v[i][j].y = bfhi(xw.x); v[i][j].z = bflo(xw.y); v[i][j].w = bfhi(xw.y); }
                if (MODE != 1) {
                    const u32x2 q0 = *(const u32x2*)(P0 + (size_t)row * D + c), q1 = *(const u32x2*)(P1 + (size_t)row * D + c);
                    f32x4 ps; ps.x = bflo(q0.x) + bflo(q1.x); ps.y = bfhi(q0.x) + bfhi(q1.x); ps.z = bflo(q0.y) + bflo(q1.y); ps.w = bfhi(q0.y) + bfhi(q1.y);
                    v[i][j] = v[i][j] + gt[j] * ps;
                }
            }
        }
#pragma unroll
        for (int i = 0; i < 4; ++i) {
#pragma unroll
            for (int j = 0; j < 4; ++j) ss[i] += (v[i][j].x * v[i][j].x + v[i][j].y * v[i][j].y) + (v[i][j].z * v[i][j].z + v[i][j].w * v[i][j].w);
        }
#pragma unroll
        for (int o = 1; o < 64; o <<= 1) {
#pragma unroll
            for (int i = 0; i < 4; ++i) ss[i] += __shfl_xor(ss[i], o);
        }
        float rinv[4];
#pragma unroll
        for (int i = 0; i < 4; ++i) rinv[i] = rsqrtf(ss[i] * (1.f / D) + EPS);
#pragma unroll
        for (int j = 0; j < 4; ++j) {
            const int c = 4 * lane + 256 * j;
            if (MODE == 4) {
                const f32x4 g = *(const f32x4*)(a.in[I_FING] + c);
#pragma unroll
                for (int i = 0; i < 4; ++i) *(f32x4*)(a.out + OY + (size_t)(row0 + i) * D + c) = v[i][j] * rinv[i] * g;
            } else {
                const f32x4 g = *(const f32x4*)(a.in[I_NORMG] + (MODE - 1) * 1024 + c), sh = *(const f32x4*)(md + SH * 1024 + c), sc = *(const f32x4*)(md + SC * 1024 + c);
                const f32x4 gs = g * (1.f + sc);
#pragma unroll
                for (int i = 0; i < 4; ++i) {
                    const f32x4 o = v[i][j] * rinv[i] * gs + sh;
                    u32x2 w; w.x = pk2(o.x, o.y); w.y = pk2(o.z, o.w);
                    *(u32x2*)(XN + (size_t)(row0 + i) * D + c) = w;
                    if (MODE == 2 || MODE == 3) { u32x2 xw; xw.x = pk2(v[i][j].x, v[i][j].y); xw.y = pk2(v[i][j].z, v[i][j].w); *(u32x2*)(X + (size_t)(row0 + i) * D + c) = xw; }
                }
            }
        }
    }
}

constexpr int AT_KN = 0, AT_KR = 8192, AT_VT = 12288, AT_STAGE = 20480;
__device__ __forceinline__ void attn_item(LAS unsigned char* lds, const bf16_t* Q, const bf16_t* KN, const bf16_t* KRP, const bf16_t* VT, bf16_t* O, int ab, int h, int qt) {
    const int tid = threadIdx.x, lane = tid & 63, wave = __builtin_amdgcn_readfirstlane(tid >> 6), fr = lane & 15, fq = lane >> 4;
    const int Tk = ab < 16 ? 256 : 2304;
    const int kbase = ab < 16 ? ab * 256 : NCTX + (ab - 16) * 2304;
    const size_t vbase = ab < 16 ? (size_t)(ab * 8 + h) * 64 * 256 : (size_t)16 * 8 * 64 * 256 + (size_t)((ab - 16) * 8 + h) * 64 * 2304;
    const int qrow = (ab < 16 ? ab * 256 : NCTX + (ab - 16) * 2048) + qt * 128 + wave * 16 + fr;
    bf16x8 qf[3];
#pragma unroll
    for (int ks = 0; ks < 3; ++ks) qf[ks] = *(const bf16x8*)(Q + (size_t)qrow * 768 + h * 96 + ks * 32 + fq * 8);
    if (ab >= 16) {
        const int t = qt * 128 + wave * 16 + fr;
        const float pos = fq < 2 ? (float)(t >> 6) : (float)(t & 63);
        const u32x4 w = __builtin_bit_cast(u32x4, qf[2]);
        u32x4 pw; pw.x = __shfl_xor(w.x, 16); pw.y = __shfl_xor(w.y, 16); pw.z = __shfl_xor(w.z, 16); pw.w = __shfl_xor(w.w, 16);
        const float x[8] = {bflo(w.x), bfhi(w.x), bflo(w.y), bfhi(w.y), bflo(w.z), bfhi(w.z), bflo(w.w), bfhi(w.w)};
        const float pp[8] = {bflo(pw.x), bfhi(pw.x), bflo(pw.y), bfhi(pw.y), bflo(pw.z), bfhi(pw.z), bflo(pw.w), bfhi(pw.w)};
        const float iv[8] = {1.0f, 0.31622776601683794f, 0.1f, 0.031622776601683794f, 0.01f, 0.0031622776601683794f, 0.001f, 0.00031622776601683794f};
        float o[8];
#pragma unroll
        for (int i = 0; i < 8; ++i) {
            float rev = pos * iv[i] * 0.15915494309189535f; rev -= rintf(rev);
            const float s = __builtin_amdgcn_sinf(rev), c = __builtin_amdgcn_cosf(rev);
            o[i] = (fq & 1) ? (x[i] * c + pp[i] * s) : (x[i] * c - pp[i] * s);
        }
        u32x4 ow; ow.x = pk2(o[0], o[1]); ow.y = pk2(o[2], o[3]); ow.z = pk2(o[4], o[5]); ow.w = pk2(o[6], o[7]);
        qf[2] = __builtin_bit_cast(bf16x8, ow);
    }
    const int nt = Tk / 64;
    const int kk = wave * 8 + (lane >> 3), kc = (lane & 7) ^ (kk & 7);
    const char* gk = (const char*)(KN + (size_t)(kbase + kk) * 512 + h * 64 + kc * 8);
    const int rk = (wave & 3) * 16 + (lane >> 2), rc = (lane & 3) ^ ((rk >> 2) & 3);
    const char* gr = (const char*)(KRP + (size_t)(kbase + rk) * 32 + rc * 8);
    const int vd = wave * 8 + (lane >> 3), vc = (lane & 7) ^ (vd & 7);
    const char* gv = (const char*)(VT + vbase + (size_t)vd * Tk + vc * 8);
    const unsigned ldk = AT_KN + wave * 1024, ldr = AT_KR + (wave & 3) * 1024, ldv = AT_VT + wave * 1024;
#define AT_ISSUE(tile, stg) do { const int _t = (tile) < nt ? (tile) : nt - 1; const unsigned _s = (unsigned)(stg) * AT_STAGE; \
        __builtin_amdgcn_global_load_lds((const unsigned*)(gk + (size_t)_t * 65536), (LAS unsigned*)(lds + _s + ldk), 16, 0, 0); \
        __builtin_amdgcn_global_load_lds((const unsigned*)(gr + (size_t)_t * 4096), (LAS unsigned*)(lds + _s + ldr), 16, 0, 0); \
        __builtin_amdgcn_global_load_lds((const unsigned*)(gv + (size_t)_t * 128), (LAS unsigned*)(lds + _s + ldv), 16, 0, 0); } while (0)
    asm volatile("s_waitcnt vmcnt(0) lgkmcnt(0)" ::: "memory");
    __builtin_amdgcn_s_barrier();
    AT_ISSUE(0, 0); AT_ISSUE(1, 1);
    f32x4 oacc[4];
#pragma unroll
    for (int i = 0; i < 4; ++i) oacc[i] = (f32x4){0.f, 0.f, 0.f, 0.f};
    float mrun = -INFINITY, lrun = 0.f;
    const float cs = 0.10206207261596577f * 1.4426950408889634f;
    const int sw7 = fr & 7, sw3 = (fr >> 2) & 3;
    int stg = 0;
    for (int t = 0; t < nt; ++t) {
        asm volatile("s_waitcnt vmcnt(3)" ::: "memory");
        __builtin_amdgcn_s_barrier();
        asm volatile("" ::: "memory");
        { const int s2 = stg >= 1 ? stg - 1 : 2; AT_ISSUE(t + 2, s2); }
        const LAS unsigned char* sb = lds + stg * AT_STAGE;
        f32x4 s[4];
#pragma unroll
        for (int kb = 0; kb < 4; ++kb) {
            s[kb] = (f32x4){0.f, 0.f, 0.f, 0.f};
            const int key = kb * 16 + fr;
#pragma unroll
            for (int ks = 0; ks < 2; ++ks) {
                const bf16x8 kf = *(const LAS bf16x8*)(sb + AT_KN + key * 128 + (((ks * 4 + fq) ^ sw7) * 16));
                s[kb] = __builtin_amdgcn_mfma_f32_16x16x32_bf16(kf, qf[ks], s[kb], 0, 0, 0);
            }
            const bf16x8 kr = *(const LAS bf16x8*)(sb + AT_KR + key * 64 + ((fq ^ sw3) * 16));
            s[kb] = __builtin_amdgcn_mfma_f32_16x16x32_bf16(kr, qf[2], s[kb], 0, 0, 0);
        }
        float mx = fmaxf(fmaxf(s[0][0], s[0][1]), fmaxf(s[0][2], s[0][3]));
#pragma unroll
        for (int kb = 1; kb < 4; ++kb) mx = fmaxf(mx, fmaxf(fmaxf(s[kb][0], s[kb][1]), fmaxf(s[kb][2], s[kb][3])));
        mx = fmaxf(mx, __shfl_xor(mx, 16)); mx = fmaxf(mx, __shfl_xor(mx, 32));
        const float mn = fmaxf(mrun, mx);
        const float alpha = __builtin_amdgcn_exp2f((mrun - mn) * cs);
        mrun = mn;
        const float mc = mn * cs;
        float ps = 0.f;
#pragma unroll
        for (int kb = 0; kb < 4; ++kb)
#pragma unroll
            for (int j = 0; j < 4; ++j) { const float p = __builtin_amdgcn_exp2f(s[kb][j] * cs - mc); s[kb][j] = p; ps += p; }
        lrun = lrun * alpha + ps;
#pragma unroll
        for (int i = 0; i < 4; ++i) oacc[i] = oacc[i] * alpha;
        bf16x8 pf[2];
#pragma unroll
        for (int kp2 = 0; kp2 < 2; ++kp2) {
            u32x4 w; w.x = pk2(s[2 * kp2][0], s[2 * kp2][1]); w.y = pk2(s[2 * kp2][2], s[2 * kp2][3]);
            w.z = pk2(s[2 * kp2 + 1][0], s[2 * kp2 + 1][1]); w.w = pk2(s[2 * kp2 + 1][2], s[2 * kp2 + 1][3]);
            pf[kp2] = __builtin_bit_cast(bf16x8, w);
        }
#pragma unroll
        for (int db = 0; db < 4; ++db)
#pragma unroll
            for (int kp2 = 0; kp2 < 2; ++kp2) {
                const int d = db * 16 + fr, c0 = kp2 * 4 + (fq >> 1);
                const LAS unsigned char* vb = sb + AT_VT + d * 128 + (fq & 1) * 8;
                const u32x2 lo = *(const LAS u32x2*)(vb + ((c0 ^ sw7) * 16)), hi = *(const LAS u32x2*)(vb + (((c0 + 2) ^ sw7) * 16));
                u32x4 w; w.x = lo.x; w.y = lo.y; w.z = hi.x; w.w = hi.y;
                oacc[db] = __builtin_amdgcn_mfma_f32_16x16x32_bf16(__builtin_bit_cast(bf16x8, w), pf[kp2], oacc[db], 0, 0, 0);
            }
        stg = stg == 2 ? 0 : stg + 1;
    }
    asm volatile("s_waitcnt vmcnt(0)" ::: "memory");
    lrun += __shfl_xor(lrun, 16); lrun += __shfl_xor(lrun, 32);
    const float il = 1.f / lrun;
#pragma unroll
    for (int db = 0; db < 4; ++db) {
        u32x2 w; w.x = pk2(oacc[db][0] * il, oacc[db][1] * il); w.y = pk2(oacc[db][2] * il, oacc[db][3] * il);
        *(u32x2*)(O + (size_t)qrow * 512 + h * 64 + db * 16 + fq * 4) = w;
    }
#undef AT_ISSUE
}

typedef short s16x4 __attribute__((ext_vector_type(4)));
constexpr int HW_QE = 0, HW_KE = 2304, HW_KGT = 4608, HW_VT = 7680, HW_EG = 10752, HW_BYTES = 11008;
constexpr int HG_OB = 0, HG_WL = 65536;
__device__ __forceinline__ bf16_t f2bf(float x) { return (bf16_t)(pk2(x, 0.f) & 0xffffu); }
constexpr int HG_RAW = 88064;
template <bool WITH_O>
__device__ __forceinline__ void hgrn_block_scan(f32x4 (&S)[4][4], float& dtot, LAS unsigned char* lds, const bf16_t* HQ, const bf16_t* HV, const float* FF, const float* FB, int row0, int h) {
    const int tid = threadIdx.x, lane = tid & 63, wave = __builtin_amdgcn_readfirstlane(tid >> 6), fr = lane & 15, quad = lane >> 4;
    const bool scanner = wave < 2;
    const int dir = wave & 1;
#define HG_BAR() do { asm volatile("s_waitcnt lgkmcnt(0)" ::: "memory"); __builtin_amdgcn_s_barrier(); asm volatile("" ::: "memory"); } while (0)
    if (!scanner) {
        const int lt = tid - 128;
        const char* lsrc[3]; int ldst[3]; int lstep[3]; bool lval[3];
#pragma unroll
        for (int j = 0; j < 3; ++j) {
            const int i = lt + 384 * j; const int d = (i >> 9) & 1, r = i & 511;
            lval[j] = i < 1024 && (WITH_O || r < 256 || r >= 384);
            int row, dst; const char* s;
            if (r < 256) { row = r >> 4; const int ch = r & 15; s = (const char*)((d ? FB : FF) + (size_t)row0 * 512 + h * 64 + ch * 4); dst = ch * 16; lstep[j] = 2048; }
            else if (r < 384) { const int r2 = r - 256; row = r2 >> 3; const int ch = r2 & 7; s = (const char*)(HQ + (size_t)row0 * 512 + h * 64 + ch * 8); dst = 4096 + ch * 16; lstep[j] = 1024; }
            else { const int r2 = r - 384; row = r2 >> 3; const int ch = r2 & 7; s = (const char*)(HV + (size_t)row0 * 512 + h * 64 + ch * 8); dst = 6144 + ch * 16; lstep[j] = 1024; }
            const int rowbytes = r < 256 ? 256 : 128;
            lsrc[j] = s + (size_t)((d ? 240 : 0) + row) * lstep[j];
            lstep[j] = (d ? -16 : 16) * lstep[j];
            ldst[j] = d * 8192 + dst + (d ? 15 - row : row) * rowbytes;
        }
        u32x4 lnxt[3];
#pragma unroll
        for (int j = 0; j < 3; ++j) if (lval[j]) lnxt[j] = *(const u32x4*)lsrc[j];
#pragma unroll
        for (int j = 0; j < 3; ++j) if (lval[j]) *(LAS u32x4*)(lds + HG_RAW + ldst[j]) = lnxt[j];
#pragma unroll
        for (int j = 0; j < 3; ++j) if (lval[j]) lnxt[j] = *(const u32x4*)(lsrc[j] + (ptrdiff_t)lstep[j]);
        HG_BAR();
        for (int c = 0; c < 16; ++c) {
            if (c + 1 < 16) {
                asm volatile("s_waitcnt vmcnt(0)" ::: "memory");
#pragma unroll
                for (int j = 0; j < 3; ++j) if (lval[j]) *(LAS u32x4*)(lds + HG_RAW + ((c + 1) & 1) * 16384 + ldst[j]) = lnxt[j];
                if (c + 2 < 16) {
#pragma unroll
                    for (int j = 0; j < 3; ++j) if (lval[j]) lnxt[j] = *(const u32x4*)(lsrc[j] + (ptrdiff_t)(c + 2) * lstep[j]);
                }
            }
            HG_BAR();
        }
    } else {
        LAS unsigned char* wl = lds + HG_WL + dir * HW_BYTES;
        LAS unsigned char* qe = wl + HW_QE; LAS unsigned char* ke = wl + HW_KE; LAS unsigned char* kgT = wl + HW_KGT; LAS unsigned char* vT = wl + HW_VT;
        LAS float* eg = (LAS float*)(wl + HW_EG);
        LAS float* obuf = (LAS float*)(lds + HG_OB);
        HG_BAR();
        for (int c = 0; c < 16; ++c) {
            const LAS unsigned char* rb = lds + HG_RAW + (c & 1) * 16384 + dir * 8192;
            float b2 = 0.f; float kreg[16];
            float fin[16]; unsigned qin[16];
#pragma unroll
            for (int s = 0; s < 16; ++s) { fin[s] = *(const LAS float*)(rb + s * 256 + lane * 4);
                if (WITH_O) qin[s] = *(const LAS bf16_t*)(rb + 4096 + s * 128 + lane * 2); }
#pragma unroll
            for (int s = 0; s < 16; ++s) {
                const float fv = fin[s];
                b2 += __log2f(fv);
                const float kin = (1.f - fv) * __builtin_amdgcn_exp2f(-b2);
                kreg[s] = kin;
                if (WITH_O) {
                    *(LAS bf16_t*)(ke + s * 144 + lane * 2) = f2bf(kin);
                    const float qv = __uint_as_float(qin[s] << 16) * __builtin_amdgcn_exp2f(b2);
                    *(LAS bf16_t*)(qe + s * 144 + lane * 2) = f2bf(qv);
                }
            }
            const float egv = __builtin_amdgcn_exp2f(b2);
            eg[lane] = egv; dtot *= egv;
            {
                u32x4 w0, w1;
                w0.x = pk2(kreg[0] * egv, kreg[1] * egv); w0.y = pk2(kreg[2] * egv, kreg[3] * egv); w0.z = pk2(kreg[4] * egv, kreg[5] * egv); w0.w = pk2(kreg[6] * egv, kreg[7] * egv);
                w1.x = pk2(kreg[8] * egv, kreg[9] * egv); w1.y = pk2(kreg[10] * egv, kreg[11] * egv); w1.z = pk2(kreg[12] * egv, kreg[13] * egv); w1.w = pk2(kreg[14] * egv, kreg[15] * egv);
                *(LAS u32x4*)(kgT + lane * 48) = w0; *(LAS u32x4*)(kgT + lane * 48 + 16) = w1;
                unsigned vv[16];
#pragma unroll
                for (int s = 0; s < 16; ++s) vv[s] = *(const LAS bf16_t*)(rb + 6144 + s * 128 + lane * 2);
                u32x4 x0, x1;
                x0.x = vv[0] | (vv[1] << 16); x0.y = vv[2] | (vv[3] << 16); x0.z = vv[4] | (vv[5] << 16); x0.w = vv[6] | (vv[7] << 16);
                x1.x = vv[8] | (vv[9] << 16); x1.y = vv[10] | (vv[11] << 16); x1.z = vv[12] | (vv[13] << 16); x1.w = vv[14] | (vv[15] << 16);
                *(LAS u32x4*)(vT + lane * 48) = x0; *(LAS u32x4*)(vT + lane * 48 + 16) = x1;
            }
            asm volatile("s_waitcnt lgkmcnt(0)" ::: "memory");
            s16x4 bv[4];
#pragma unroll
            for (int vb = 0; vb < 4; ++vb) bv[vb] = *(const LAS s16x4*)(vT + (vb * 16 + fr) * 48 + quad * 8);
            if (WITH_O) {
                f32x4 at = (f32x4){0.f, 0.f, 0.f, 0.f};
#pragma unroll
                for (int kp = 0; kp < 2; ++kp) {
                    const bf16x8 ak = *(const LAS bf16x8*)(ke + fr * 144 + kp * 64 + quad * 16);
                    const bf16x8 bq = *(const LAS bf16x8*)(qe + fr * 144 + kp * 64 + quad * 16);
                    at = __builtin_amdgcn_mfma_f32_16x16x32_bf16(ak, bq, at, 0, 0, 0);
                }
#pragma unroll
                for (int r = 0; r < 4; ++r) at[r] = (quad * 4 + r <= fr) ? at[r] : 0.f;
                u32x2 pw; pw.x = pk2(at[0], at[1]); pw.y = pk2(at[2], at[3]);
                const s16x4 pa = __builtin_bit_cast(s16x4, pw);
                f32x4 o[4];
#pragma unroll
                for (int vb = 0; vb < 4; ++vb) o[vb] = __builtin_amdgcn_mfma_f32_16x16x16bf16_1k(pa, bv[vb], (f32x4){0.f, 0.f, 0.f, 0.f}, 0, 0, 0);
#pragma unroll
                for (int kb = 0; kb < 4; ++kb) {
                    const s16x4 aq = *(const LAS s16x4*)(qe + fr * 144 + kb * 32 + quad * 8);
#pragma unroll
                    for (int vb = 0; vb < 4; ++vb) {
                        u32x2 sw; sw.x = pk2(S[kb][vb][0], S[kb][vb][1]); sw.y = pk2(S[kb][vb][2], S[kb][vb][3]);
                        o[vb] = __builtin_amdgcn_mfma_f32_16x16x16bf16_1k(aq, __builtin_bit_cast(s16x4, sw), o[vb], 0, 0, 0);
                    }
                }
                {
                    LAS float* ob0 = obuf + (dir == 0 ? 16 * c + quad * 4 : 255 - 16 * c - quad * 4) * 64 + fr;
                    const int rs = dir == 0 ? 64 : -64;
#pragma unroll
                    for (int r = 0; r < 4; ++r)
#pragma unroll
                        for (int vb = 0; vb < 4; ++vb)
                            __hip_atomic_fetch_add(ob0 + r * rs + vb * 16, o[vb][r], __ATOMIC_RELAXED, __HIP_MEMORY_SCOPE_WORKGROUP);
                }
            }
#pragma unroll
            for (int kb = 0; kb < 4; ++kb) {
                const f32x4 ev = *(const LAS f32x4*)(eg + kb * 16 + quad * 4);
                const s16x4 akg = *(const LAS s16x4*)(kgT + (kb * 16 + fr) * 48 + quad * 8);
#pragma unroll
                for (int vb = 0; vb < 4; ++vb) S[kb][vb] = __builtin_amdgcn_mfma_f32_16x16x16bf16_1k(akg, bv[vb], S[kb][vb] * ev, 0, 0, 0);
            }
            HG_BAR();
        }
    }
#undef HG_BAR
    __syncthreads();
}

__device__ __forceinline__ void hgrn_pass1(const Args& a, LAS unsigned char* lds, int bi) {
    const int tid = threadIdx.x, lane = tid & 63, wave = tid >> 6, fr = lane & 15, quad = lane >> 4;
    unsigned char* ws = a.ws;
    const int dir = wave & 1, seg = bi & 7, h = (bi >> 3) & 7, b = bi >> 6;
    const int row0 = NCTX + b * 2048 + seg * 256;
    f32x4 S[4][4]; float dtot = 1.f;
#pragma unroll
    for (int kb = 0; kb < 4; ++kb)
#pragma unroll
        for (int vb = 0; vb < 4; ++vb) S[kb][vb] = (f32x4){0.f, 0.f, 0.f, 0.f};
    hgrn_block_scan<false>(S, dtot, lds, (const bf16_t*)(ws + WS_HQ), (const bf16_t*)(ws + WS_HV), (const float*)(ws + WS_FF), (const float*)(ws + WS_FB), row0, h);
    if (wave < 2) {
        const int item = bi * 2 + dir;
        float* sl = (float*)(ws + WS_SLOC) + (size_t)item * 4096 + quad * 256 + fr;
#pragma unroll
        for (int kb = 0; kb < 4; ++kb) {
            float* pk = sl + kb * 1024; asm volatile("" : "+v"(pk));
#pragma unroll
            for (int vb = 0; vb < 4; ++vb)
#pragma unroll
                for (int r = 0; r < 4; ++r) pk[r * 64 + vb * 16] = S[kb][vb][r];
        }
        ((float*)(ws + WS_GDEC))[(size_t)item * 64 + lane] = dtot;
    }
}

__device__ __forceinline__ void hgrn_pass2(const Args& a, LAS unsigned char* lds, int item) {
    const int tid = threadIdx.x, lane = tid & 63, wave = tid >> 6, fr = lane & 15, quad = lane >> 4;
    unsigned char* ws = a.ws;
    const bool ctx = item < 128;
    int b, h, seg = 0, row0;
    if (ctx) { b = item >> 3; h = item & 7; row0 = b * 256; }
    else { const int it = item - 128; seg = it & 7; h = (it >> 3) & 7; b = it >> 6; row0 = NCTX + b * 2048 + seg * 256; }
    LAS float* ob = (LAS float*)(lds + HG_OB);
    for (int i = tid; i < 256 * 64 / 4; i += NTHR) ((LAS f32x4*)ob)[i] = (f32x4){0.f, 0.f, 0.f, 0.f};
    const int dir = wave & 1;
    f32x4 S[4][4]; float dtot = 1.f;
#pragma unroll
    for (int kb = 0; kb < 4; ++kb)
#pragma unroll
        for (int vb = 0; vb < 4; ++vb) S[kb][vb] = (f32x4){0.f, 0.f, 0.f, 0.f};
    if (wave < 2 && !ctx) {
        const int it2 = ((b * 8 + h) * 8 + seg) * 2 + dir;
        const float* s0 = (const float*)(ws + WS_SENT) + (size_t)it2 * 4096 + quad * 256 + fr;
#pragma unroll
        for (int kb = 0; kb < 4; ++kb) {
            const float* pk = s0 + kb * 1024; asm volatile("" : "+v"(pk));
#pragma unroll
            for (int vb = 0; vb < 4; ++vb)
#pragma unroll
                for (int r = 0; r < 4; ++r) S[kb][vb][r] = pk[r * 64 + vb * 16];
        }
    }
    hgrn_block_scan<true>(S, dtot, lds, (const bf16_t*)(ws + WS_HQ), (const bf16_t*)(ws + WS_HV), (const float*)(ws + WS_FF), (const float*)(ws + WS_FB), row0, h);
    if (wave < 2 && ctx) {
        float* so = a.out + OST + (size_t)((b * 2 + dir) * 8 + h) * 4096 + quad * 256 + fr;
#pragma unroll
        for (int kb = 0; kb < 4; ++kb) {
            float* pk = so + kb * 1024; asm volatile("" : "+v"(pk));
#pragma unroll
            for (int vb = 0; vb < 4; ++vb)
#pragma unroll
                for (int r = 0; r < 4; ++r) pk[r * 64 + vb * 16] = S[kb][vb][r];
        }
    }
    const float gn = a.in[I_HGNG][lane];
    const bf16_t* HG = (const bf16_t*)(ws + WS_HG);
    bf16_t* OR = (bf16_t*)(ws + WS_O) + (size_t)NTOK * 512;
    {
        const size_t off0 = (size_t)(row0 + wave * 32) * 512 + h * 64 + lane;
        bf16_t gt[32];
#pragma unroll
        for (int i = 0; i < 32; ++i) gt[i] = HG[off0 + (size_t)i * 512];
#pragma unroll
        for (int i = 0; i < 32; ++i) {
            const float v = ob[(wave * 32 + i) * 64 + lane];
            const float rinv = rsqrtf(wave_sum(v * v) * (1.f / 64.f) + EPS);
            const float gate = __uint_as_float((unsigned)gt[i] << 16);
            OR[off0 + (size_t)i * 512] = f2bf(v * rinv * gn * gate);
        }
    }
    __syncthreads();
}


template <int NST>
__device__ __forceinline__ void attn_group_item(const Args& a, LAS unsigned char* lds, unsigned ring_off, int wa, int ab, int h, int qt) {
    const int tid = threadIdx.x, lane = tid & 63, fr = lane & 15, fq = lane >> 4;
    unsigned char* ws = a.ws;
    const bf16_t* Q = (const bf16_t*)(ws + WS_Q); const bf16_t* KN = (const bf16_t*)(ws + WS_KN); const bf16_t* KRP = (const bf16_t*)(ws + WS_KRP); const bf16_t* VT = (const bf16_t*)(ws + WS_VT);
    bf16_t* O = (bf16_t*)(ws + WS_O);
    const float cs = 0.10206207261596577f * 1.4426950408889634f;
    const int sw7 = fr & 7, sw3 = (fr >> 2) & 3;
        const int Tk = ab < 16 ? 256 : 2304;
        const int kbase = ab < 16 ? ab * 256 : NCTX + (ab - 16) * 2304;
        const size_t vbase = ab < 16 ? (size_t)(ab * 8 + h) * 64 * 256 : (size_t)16 * 8 * 64 * 256 + (size_t)((ab - 16) * 8 + h) * 64 * 2304;
        const int qrow = (ab < 16 ? ab * 256 : NCTX + (ab - 16) * 2048) + qt * 128 + wa * 32 + fr;
        bf16x8 qf[2][3];
#pragma unroll
        for (int sb = 0; sb < 2; ++sb)
#pragma unroll
            for (int ks = 0; ks < 3; ++ks) qf[sb][ks] = *(const bf16x8*)(Q + (size_t)(qrow + 16 * sb) * 768 + h * 96 + ks * 32 + fq * 8);
        if (ab >= 16) {
#pragma unroll
            for (int sb = 0; sb < 2; ++sb) {
                const int t = qt * 128 + wa * 32 + 16 * sb + fr;
                const float pos = fq < 2 ? (float)(t >> 6) : (float)(t & 63);
                const u32x4 w = __builtin_bit_cast(u32x4, qf[sb][2]);
                u32x4 pw; pw.x = __shfl_xor(w.x, 16); pw.y = __shfl_xor(w.y, 16); pw.z = __shfl_xor(w.z, 16); pw.w = __shfl_xor(w.w, 16);
                const float x[8] = {bflo(w.x), bfhi(w.x), bflo(w.y), bfhi(w.y), bflo(w.z), bfhi(w.z), bflo(w.w), bfhi(w.w)};
                const float pp[8] = {bflo(pw.x), bfhi(pw.x), bflo(pw.y), bfhi(pw.y), bflo(pw.z), bfhi(pw.z), bflo(pw.w), bfhi(pw.w)};
                const float iv[8] = {1.0f, 0.31622776601683794f, 0.1f, 0.031622776601683794f, 0.01f, 0.0031622776601683794f, 0.001f, 0.00031622776601683794f};
                float o[8];
#pragma unroll
                for (int i = 0; i < 8; ++i) {
                    float rev = pos * iv[i] * 0.15915494309189535f; rev -= rintf(rev);
                    const float s = __builtin_amdgcn_sinf(rev), c = __builtin_amdgcn_cosf(rev);
                    o[i] = (fq & 1) ? (x[i] * c + pp[i] * s) : (x[i] * c - pp[i] * s);
                }
                u32x4 ow; ow.x = pk2(o[0], o[1]); ow.y = pk2(o[2], o[3]); ow.z = pk2(o[4], o[5]); ow.w = pk2(o[6], o[7]);
                qf[sb][2] = __builtin_bit_cast(bf16x8, ow);
            }
        }
        const int nt = Tk / 64;
        const char* gk[2]; const char* gv[2];
#pragma unroll
        for (int j = 0; j < 2; ++j) {
            const int kk = (2 * wa + j) * 8 + (lane >> 3), kc = (lane & 7) ^ (kk & 7);
            gk[j] = (const char*)(KN + (size_t)(kbase + kk) * 512 + h * 64 + kc * 8);
            const int vd = (2 * wa + j) * 8 + (lane >> 3), vc = (lane & 7) ^ (vd & 7);
            gv[j] = (const char*)(VT + vbase + (size_t)vd * Tk + vc * 8);
        }
        const int rk = wa * 16 + (lane >> 2), rc = (lane & 3) ^ ((rk >> 2) & 3);
        const char* gr = (const char*)(KRP + (size_t)(kbase + rk) * 32 + rc * 8);
#define F_ISSUE(tile, stg) do { const int _t = (tile) < nt ? (tile) : nt - 1; const unsigned _s = ring_off + (unsigned)(stg) * AT_STAGE; \
        __builtin_amdgcn_global_load_lds((const unsigned*)(gk[0] + (size_t)_t * 65536), (LAS unsigned*)(lds + _s + AT_KN + (2 * wa) * 1024), 16, 0, 0); \
        __builtin_amdgcn_global_load_lds((const unsigned*)(gk[1] + (size_t)_t * 65536), (LAS unsigned*)(lds + _s + AT_KN + (2 * wa + 1) * 1024), 16, 0, 0); \
        __builtin_amdgcn_global_load_lds((const unsigned*)(gr + (size_t)_t * 4096), (LAS unsigned*)(lds + _s + AT_KR + wa * 1024), 16, 0, 0); \
        __builtin_amdgcn_global_load_lds((const unsigned*)(gv[0] + (size_t)_t * 128), (LAS unsigned*)(lds + _s + AT_VT + (2 * wa) * 1024), 16, 0, 0); \
        __builtin_amdgcn_global_load_lds((const unsigned*)(gv[1] + (size_t)_t * 128), (LAS unsigned*)(lds + _s + AT_VT + (2 * wa + 1) * 1024), 16, 0, 0); } while (0)
        asm volatile("s_waitcnt vmcnt(0) lgkmcnt(0)" ::: "memory");
        __builtin_amdgcn_s_barrier();
        asm volatile("" ::: "memory");
        F_ISSUE(0, 0); if (NST == 3) F_ISSUE(1, 1);
        f32x4 oacc[2][4];
#pragma unroll
        for (int sb = 0; sb < 2; ++sb)
#pragma unroll
            for (int i = 0; i < 4; ++i) oacc[sb][i] = (f32x4){0.f, 0.f, 0.f, 0.f};
        float mrun[2] = {-INFINITY, -INFINITY}, lrun[2] = {0.f, 0.f};
        int stg = 0;
        for (int t = 0; t < nt; ++t) {
            if (NST == 3) asm volatile("s_waitcnt vmcnt(5)" ::: "memory"); else asm volatile("s_waitcnt vmcnt(0)" ::: "memory");
            __builtin_amdgcn_s_barrier();
            asm volatile("" ::: "memory");
            if (NST == 3) { const int s2 = stg >= 1 ? stg - 1 : 2; F_ISSUE(t + 2, s2); } else { F_ISSUE(t + 1, stg ^ 1); }
            const LAS unsigned char* sbp = lds + ring_off + stg * AT_STAGE;
            f32x4 s[2][4];
#pragma unroll
            for (int kb = 0; kb < 4; ++kb) {
                s[0][kb] = (f32x4){0.f, 0.f, 0.f, 0.f}; s[1][kb] = (f32x4){0.f, 0.f, 0.f, 0.f};
                const int key = kb * 16 + fr;
#pragma unroll
                for (int ks = 0; ks < 2; ++ks) {
                    const bf16x8 kf = *(const LAS bf16x8*)(sbp + AT_KN + key * 128 + (((ks * 4 + fq) ^ sw7) * 16));
                    s[0][kb] = __builtin_amdgcn_mfma_f32_16x16x32_bf16(kf, qf[0][ks], s[0][kb], 0, 0, 0);
                    s[1][kb] = __builtin_amdgcn_mfma_f32_16x16x32_bf16(kf, qf[1][ks], s[1][kb], 0, 0, 0);
                }
                const bf16x8 kr = *(const LAS bf16x8*)(sbp + AT_KR + key * 64 + ((fq ^ sw3) * 16));
                s[0][kb] = __builtin_amdgcn_mfma_f32_16x16x32_bf16(kr, qf[0][2], s[0][kb], 0, 0, 0);
                s[1][kb] = __builtin_amdgcn_mfma_f32_16x16x32_bf16(kr, qf[1][2], s[1][kb], 0, 0, 0);
            }
            bf16x8 pf[2][2];
#pragma unroll
            for (int sb = 0; sb < 2; ++sb) {
                float mx = fmaxf(fmaxf(s[sb][0][0], s[sb][0][1]), fmaxf(s[sb][0][2], s[sb][0][3]));
#pragma unroll
                for (int kb = 1; kb < 4; ++kb) mx = fmaxf(mx, fmaxf(fmaxf(s[sb][kb][0], s[sb][kb][1]), fmaxf(s[sb][kb][2], s[sb][kb][3])));
                const bool upd = __builtin_amdgcn_ballot_w64((mx - mrun[sb]) * cs > 8.f) != 0ull;
                if (upd) {
                    mx = fmaxf(mx, __shfl_xor(mx, 16)); mx = fmaxf(mx, __shfl_xor(mx, 32));
                    const float mn = fmaxf(mrun[sb], mx);
                    const float alpha = __builtin_amdgcn_exp2f((mrun[sb] - mn) * cs);
                    mrun[sb] = mn;
                    lrun[sb] *= alpha;
#pragma unroll
                    for (int i = 0; i < 4; ++i) oacc[sb][i] = oacc[sb][i] * alpha;
                }
                const float mc = mrun[sb] * cs;
                float ps = 0.f;
#pragma unroll
                for (int kb = 0; kb < 4; ++kb)
#pragma unroll
                    for (int j = 0; j < 4; ++j) { const float p = __builtin_amdgcn_exp2f(s[sb][kb][j] * cs - mc); s[sb][kb][j] = p; ps += p; }
                lrun[sb] += ps;
#pragma unroll
                for (int kp2 = 0; kp2 < 2; ++kp2) {
                    u32x4 w; w.x = pk2(s[sb][2 * kp2][0], s[sb][2 * kp2][1]); w.y = pk2(s[sb][2 * kp2][2], s[sb][2 * kp2][3]);
                    w.z = pk2(s[sb][2 * kp2 + 1][0], s[sb][2 * kp2 + 1][1]); w.w = pk2(s[sb][2 * kp2 + 1][2], s[sb][2 * kp2 + 1][3]);
                    pf[sb][kp2] = __builtin_bit_cast(bf16x8, w);
                }
            }
#pragma unroll
            for (int db = 0; db < 4; ++db)
#pragma unroll
                for (int kp2 = 0; kp2 < 2; ++kp2) {
                    const int d = db * 16 + fr, c0 = kp2 * 4 + (fq >> 1);
                    const LAS unsigned char* vb = sbp + AT_VT + d * 128 + (fq & 1) * 8;
                    const u32x2 lo = *(const LAS u32x2*)(vb + ((c0 ^ sw7) * 16)), hi = *(const LAS u32x2*)(vb + (((c0 + 2) ^ sw7) * 16));
                    u32x4 w; w.x = lo.x; w.y = lo.y; w.z = hi.x; w.w = hi.y;
                    const bf16x8 vf = __builtin_bit_cast(bf16x8, w);
                    oacc[0][db] = __builtin_amdgcn_mfma_f32_16x16x32_bf16(vf, pf[0][kp2], oacc[0][db], 0, 0, 0);
                    oacc[1][db] = __builtin_amdgcn_mfma_f32_16x16x32_bf16(vf, pf[1][kp2], oacc[1][db], 0, 0, 0);
                }
            stg = (stg == NST - 1) ? 0 : stg + 1;
        }
        asm volatile("s_waitcnt vmcnt(0)" ::: "memory");
#pragma unroll
        for (int sb = 0; sb < 2; ++sb) {
            float l = lrun[sb]; l += __shfl_xor(l, 16); l += __shfl_xor(l, 32);
            const float il = 1.f / l;
#pragma unroll
            for (int db = 0; db < 4; ++db) {
                u32x2 w; w.x = pk2(oacc[sb][db][0] * il, oacc[sb][db][1] * il); w.y = pk2(oacc[sb][db][2] * il, oacc[sb][db][3] * il);
                *(u32x2*)(O + (size_t)(qrow + 16 * sb) * 512 + h * 64 + db * 16 + fq * 4) = w;
            }
        }
#undef F_ISSUE
}

constexpr int F_RING = 0, F_WL = 61440, F_RAW = 83456, F_NB = 32;
__device__ __forceinline__ void p7_fused(const Args& a, LAS unsigned char* lds, int blk) {
    const int tid = threadIdx.x, lane = tid & 63, wave = __builtin_amdgcn_readfirstlane(tid >> 6), fr = lane & 15, fq = lane >> 4;
    unsigned char* ws = a.ws;
#define F_BAR() do { asm volatile("s_waitcnt lgkmcnt(0)" ::: "memory"); __builtin_amdgcn_s_barrier(); asm volatile("" ::: "memory"); } while (0)
    const bool ctx = blk < 128;
    int hb, hh, hseg = 0, hrow0;
    if (ctx) { hb = blk >> 3; hh = blk & 7; hrow0 = hb * 256; }
    else { const int it = blk - 128; hseg = it & 7; hh = (it >> 3) & 7; hb = it >> 6; hrow0 = NCTX + hb * 2048 + hseg * 256; }
    if (wave < 4) {
        attn_group_item<3>(a, lds, F_RING, wave, 16 + (blk >> 7), (blk >> 4) & 7, blk & 15);
    } else if (wave >= 6) {
        const int lt = tid - 384;
        const bf16_t* HQ = (const bf16_t*)(ws + WS_HQ); const bf16_t* HV = (const bf16_t*)(ws + WS_HV);
        const char* lsrc[8]; int ldst[8];
#pragma unroll
        for (int j = 0; j < 8; ++j) {
            const int d = j >> 2, ty = j & 3;
            int row, dst, rowbytes, tokbytes; const char* s;
            if (ty < 2) { const int r = ty * 128 + lt; row = r >> 4; const int ch = r & 15; s = (const char*)((const float*)(ws + (d ? WS_FB : WS_FF)) + (size_t)hrow0 * 512 + hh * 64 + ch * 4); dst = ch * 16; rowbytes = 256; tokbytes = 2048; }
            else { row = lt >> 3; const int ch = lt & 7; s = (const char*)((ty == 2 ? HQ : HV) + (size_t)hrow0 * 512 + hh * 64 + ch * 8); dst = (ty == 2 ? 4096 : 6144) + ch * 16; rowbytes = 128; tokbytes = 1024; }
            lsrc[j] = s + (size_t)((d ? 240 : 0) + row) * tokbytes;
            ldst[j] = F_RAW + d * 8192 + dst + (d ? 15 - row : row) * rowbytes;
        }
        u32x4 lnxt[8];
#pragma unroll
        for (int j = 0; j < 8; ++j) lnxt[j] = *(const u32x4*)lsrc[j];
#pragma unroll
        for (int j = 0; j < 8; ++j) *(LAS u32x4*)(lds + ldst[j]) = lnxt[j];
#pragma unroll
        for (int j = 0; j < 8; ++j) { const int d = j >> 2, tokbytes = (j & 3) < 2 ? 2048 : 1024; lnxt[j] = *(const u32x4*)(lsrc[j] + (ptrdiff_t)((d ? -16 : 16) * tokbytes)); }
        for (int n = 0; n < F_NB; ++n) {
            F_BAR();
            const int c = n >> 1;
            if ((n & 1) == 0 && c + 1 < 16) {
                asm volatile("s_waitcnt vmcnt(0)" ::: "memory");
#pragma unroll
                for (int j = 0; j < 8; ++j) *(LAS u32x4*)(lds + ((c + 1) & 1) * 16384 + ldst[j]) = lnxt[j];
                if (c + 2 < 16) {
#pragma unroll
                    for (int j = 0; j < 8; ++j) { const int d = j >> 2, tokbytes = (j & 3) < 2 ? 2048 : 1024; lnxt[j] = *(const u32x4*)(lsrc[j] + (ptrdiff_t)(c + 2) * ((d ? -16 : 16) * tokbytes)); }
                }
            }
        }
        attn_group_item<2>(a, lds, F_WL, wave - 4, blk >> 4, (blk >> 1) & 7, blk & 1);
    } else {
        const int dir = wave & 1, quad = fq;
        f32x4 S[4][4];
#pragma unroll
        for (int kb = 0; kb < 4; ++kb)
#pragma unroll
            for (int vb = 0; vb < 4; ++vb) S[kb][vb] = (f32x4){0.f, 0.f, 0.f, 0.f};
        if (!ctx) {
            const int it2 = ((hb * 8 + hh) * 8 + hseg) * 2 + dir;
            const float* s0 = (const float*)(ws + WS_SENT) + (size_t)it2 * 4096 + quad * 256 + fr;
#pragma unroll
            for (int kb = 0; kb < 4; ++kb) {
                const float* pk = s0 + kb * 1024; asm volatile("" : "+v"(pk));
#pragma unroll
                for (int vb = 0; vb < 4; ++vb)
#pragma unroll
                    for (int r = 0; r < 4; ++r) S[kb][vb][r] = pk[r * 64 + vb * 16];
            }
        }
        LAS unsigned char* wl = lds + F_WL + dir * HW_BYTES;
        LAS unsigned char* qe = wl + HW_QE; LAS unsigned char* ke = wl + HW_KE; LAS unsigned char* kgT = wl + HW_KGT; LAS unsigned char* vT = wl + HW_VT;
        LAS float* eg = (LAS float*)(wl + HW_EG);
        bf16_t* OX = (bf16_t*)(ws + (dir ? WS_OBW : WS_OFW));
        for (int n = 0; n < F_NB; ++n) {
            F_BAR();
            const int c = n >> 1;
            if (n < 32 && (n & 1) == 0) {
                const LAS unsigned char* rb = lds + F_RAW + (c & 1) * 16384 + dir * 8192;
                float b2 = 0.f; float kreg[16];
                float fin[16]; unsigned qin[16];
#pragma unroll
                for (int s = 0; s < 16; ++s) { fin[s] = *(const LAS float*)(rb + s * 256 + lane * 4); qin[s] = *(const LAS bf16_t*)(rb + 4096 + s * 128 + lane * 2); }
#pragma unroll
                for (int s = 0; s < 16; ++s) {
                    const float fv = fin[s];
                    b2 += __log2f(fv);
                    const float kin = (1.f - fv) * __builtin_amdgcn_exp2f(-b2);
                    kreg[s] = kin;
                    *(LAS bf16_t*)(ke + s * 144 + lane * 2) = f2bf(kin);
                    const float qv = __uint_as_float(qin[s] << 16) * __builtin_amdgcn_exp2f(b2);
                    *(LAS bf16_t*)(qe + s * 144 + lane * 2) = f2bf(qv);
                }
                const float egv = __builtin_amdgcn_exp2f(b2);
                eg[lane] = egv;
                {
                    u32x4 w0, w1;
                    w0.x = pk2(kreg[0] * egv, kreg[1] * egv); w0.y = pk2(kreg[2] * egv, kreg[3] * egv); w0.z = pk2(kreg[4] * egv, kreg[5] * egv); w0.w = pk2(kreg[6] * egv, kreg[7] * egv);
                    w1.x = pk2(kreg[8] * egv, kreg[9] * egv); w1.y = pk2(kreg[10] * egv, kreg[11] * egv); w1.z = pk2(kreg[12] * egv, kreg[13] * egv); w1.w = pk2(kreg[14] * egv, kreg[15] * egv);
                    *(LAS u32x4*)(kgT + lane * 48) = w0; *(LAS u32x4*)(kgT + lane * 48 + 16) = w1;
                    unsigned vv[16];
#pragma unroll
                    for (int s = 0; s < 16; ++s) vv[s] = *(const LAS bf16_t*)(rb + 6144 + s * 128 + lane * 2);
                    u32x4 x0, x1;
                    x0.x = vv[0] | (vv[1] << 16); x0.y = vv[2] | (vv[3] << 16); x0.z = vv[4] | (vv[5] << 16); x0.w = vv[6] | (vv[7] << 16);
                    x1.x = vv[8] | (vv[9] << 16); x1.y = vv[10] | (vv[11] << 16); x1.z = vv[12] | (vv[13] << 16); x1.w = vv[14] | (vv[15] << 16);
                    *(LAS u32x4*)(vT + lane * 48) = x0; *(LAS u32x4*)(vT + lane * 48 + 16) = x1;
                }
            }
            if (n < 32 && (n & 1) == 1) {
                s16x4 bv[4];
#pragma unroll
                for (int vb = 0; vb < 4; ++vb) bv[vb] = *(const LAS s16x4*)(vT + (vb * 16 + fr) * 48 + quad * 8);
                f32x4 at = (f32x4){0.f, 0.f, 0.f, 0.f};
#pragma unroll
                for (int kp = 0; kp < 2; ++kp) {
                    const bf16x8 ak = *(const LAS bf16x8*)(ke + fr * 144 + kp * 64 + quad * 16);
                    const bf16x8 bq = *(const LAS bf16x8*)(qe + fr * 144 + kp * 64 + quad * 16);
                    at = __builtin_amdgcn_mfma_f32_16x16x32_bf16(ak, bq, at, 0, 0, 0);
                }
#pragma unroll
                for (int r = 0; r < 4; ++r) at[r] = (quad * 4 + r <= fr) ? at[r] : 0.f;
                u32x2 pw; pw.x = pk2(at[0], at[1]); pw.y = pk2(at[2], at[3]);
                const s16x4 pa = __builtin_bit_cast(s16x4, pw);
                f32x4 o[4];
#pragma unroll
                for (int vb = 0; vb < 4; ++vb) o[vb] = __builtin_amdgcn_mfma_f32_16x16x16bf16_1k(pa, bv[vb], (f32x4){0.f, 0.f, 0.f, 0.f}, 0, 0, 0);
#pragma unroll
                for (int kb = 0; kb < 4; ++kb) {
                    const s16x4 aq = *(const LAS s16x4*)(qe + fr * 144 + kb * 32 + quad * 8);
#pragma unroll
                    for (int vb = 0; vb < 4; ++vb) {
                        u32x2 sw; sw.x = pk2(S[kb][vb][0], S[kb][vb][1]); sw.y = pk2(S[kb][vb][2], S[kb][vb][3]);
                        o[vb] = __builtin_amdgcn_mfma_f32_16x16x16bf16_1k(aq, __builtin_bit_cast(s16x4, sw), o[vb], 0, 0, 0);
                    }
                }
                {
                    const int tl0 = dir == 0 ? 16 * c + quad * 4 : 255 - 16 * c - quad * 4;
                    bf16_t* op = OX + (size_t)(hrow0 + tl0) * 512 + hh * 64 + fr;
                    const ptrdiff_t rs = dir == 0 ? 512 : -512;
#pragma unroll
                    for (int r = 0; r < 4; ++r)
#pragma unroll
                        for (int vb = 0; vb < 4; ++vb) op[r * rs + vb * 16] = f2bf(o[vb][r]);
                }
#pragma unroll
                for (int kb = 0; kb < 4; ++kb) {
                    const f32x4 ev = *(const LAS f32x4*)(eg + kb * 16 + quad * 4);
                    const s16x4 akg = *(const LAS s16x4*)(kgT + (kb * 16 + fr) * 48 + quad * 8);
#pragma unroll
                    for (int vb = 0; vb < 4; ++vb) S[kb][vb] = __builtin_amdgcn_mfma_f32_16x16x16bf16_1k(akg, bv[vb], S[kb][vb] * ev, 0, 0, 0);
                }
                if (n == 31 && ctx) {
                    float* so = a.out + OST + (size_t)((hb * 2 + dir) * 8 + hh) * 4096 + quad * 256 + fr;
#pragma unroll
                    for (int kb = 0; kb < 4; ++kb) {
                        float* pk = so + kb * 1024; asm volatile("" : "+v"(pk));
#pragma unroll
                        for (int vb = 0; vb < 4; ++vb)
#pragma unroll
                            for (int r = 0; r < 4; ++r) pk[r * 64 + vb * 16] = S[kb][vb][r];
                    }
                }
            }
        }
        attn_group_item<2>(a, lds, F_WL, wave - 4, blk >> 4, (blk >> 1) & 7, blk & 1);
    }
#undef F_BAR
    __syncthreads();
}

__device__ __forceinline__ void phase_hgfin(const Args& a, int G) {
    const int tid = threadIdx.x, lane = tid & 63, wave = tid >> 6;
    unsigned char* ws = a.ws;
    const bf16_t* OF = (const bf16_t*)(ws + WS_OFW); const bf16_t* OB = (const bf16_t*)(ws + WS_OBW); const bf16_t* HG = (const bf16_t*)(ws + WS_HG);
    bf16_t* OR = (bf16_t*)(ws + WS_O) + (size_t)NTOK * 512;
    const f32x4 g0 = *(const f32x4*)(a.in[I_HGNG] + (lane & 7) * 8), g1 = *(const f32x4*)(a.in[I_HGNG] + (lane & 7) * 8 + 4);
#pragma unroll 4
    for (int row = blockIdx.x * 8 + wave; row < NTOK; row += G * 8) {
        const size_t off = (size_t)row * 512 + lane * 8;
        const u32x4 wf = *(const u32x4*)(OF + off), wb = *(const u32x4*)(OB + off), wg = *(const u32x4*)(HG + off);
        float v[8] = {bflo(wf.x) + bflo(wb.x), bfhi(wf.x) + bfhi(wb.x), bflo(wf.y) + bflo(wb.y), bfhi(wf.y) + bfhi(wb.y),
                      bflo(wf.z) + bflo(wb.z), bfhi(wf.z) + bfhi(wb.z), bflo(wf.w) + bflo(wb.w), bfhi(wf.w) + bfhi(wb.w)};
        float ss = 0.f;
#pragma unroll
        for (int i = 0; i < 8; ++i) ss += v[i] * v[i];
        ss += __shfl_xor(ss, 1); ss += __shfl_xor(ss, 2); ss += __shfl_xor(ss, 4);
        const float ri = rsqrtf(ss * (1.f / 64.f) + EPS);
        u32x4 o;
        o.x = pk2(v[0] * ri * g0.x * bflo(wg.x), v[1] * ri * g0.y * bfhi(wg.x)); o.y = pk2(v[2] * ri * g0.z * bflo(wg.y), v[3] * ri * g0.w * bfhi(wg.y));
        o.z = pk2(v[4] * ri * g1.x * bflo(wg.z), v[5] * ri * g1.y * bfhi(wg.z)); o.w = pk2(v[6] * ri * g1.z * bflo(wg.w), v[7] * ri * g1.w * bfhi(wg.w));
        *(u32x4*)(OR + off) = o;
    }
}


#define XB_TMO      128
#define XB_XCNT(j)  (256  + 64 * (j))
#define XB_XSUB(j)  (1280 + 64 * (j))
#define XB_XGEN(j)  (2304 + 64 * (j))
#define XB_TOP      3328
#define XB_TOPGEN   3392
#define XCD_BAR_WORDS 3456
#define XB_SPIN_CAP (1u << 18)
__device__ __forceinline__ unsigned xb_ld(unsigned* p)              { return __hip_atomic_load(p, __ATOMIC_RELAXED, __HIP_MEMORY_SCOPE_AGENT); }
__device__ __forceinline__ unsigned xb_add(unsigned* p, unsigned v) { return __hip_atomic_fetch_add(p, v, __ATOMIC_RELAXED, __HIP_MEMORY_SCOPE_AGENT); }
__device__ __forceinline__ unsigned xb_xcc_id() { return (unsigned)__builtin_amdgcn_s_getreg((3 << 11) | 20) & 0xFu; }
#define XB_SPIN(cond, bar) do { unsigned _sp = 0; while (cond) { __builtin_amdgcn_s_sleep(1); \
    if ((++_sp & 255u) == 0u) { if (xb_ld(&(bar)[XB_TMO])) break; if (_sp > XB_SPIN_CAP) { atomicAdd(&(bar)[XB_TMO], 1u); break; } } } } while (0)
struct XcdBarrier { unsigned* bar; unsigned x; volatile LAS unsigned* st; };
__device__ __forceinline__ XcdBarrier xcd_barrier_post(unsigned* bar, volatile LAS unsigned* st) {
    XcdBarrier b; b.bar = bar; b.x = xb_xcc_id(); b.st = st;
    if (threadIdx.x == 0) (void)xb_add(&bar[XB_XCNT(b.x)], 1u);
    return b;
}
__device__ __forceinline__ void xcd_barrier_complete(unsigned* bar, unsigned x, unsigned& nloc, unsigned& nx) {
    const unsigned G = gridDim.x * gridDim.y * gridDim.z;
    unsigned sum, cnt, mine, sp = 0u;
    for (;;) {
        sum = 0u; cnt = 0u; mine = 0u;
#pragma unroll
        for (unsigned j = 0; j < 16; ++j) { const unsigned c = xb_ld(&bar[XB_XCNT(j)]); sum += c; cnt += (c > 0u) ? 1u : 0u; mine = (j == x) ? c : mine; }
        if (sum == G) break;
        __builtin_amdgcn_s_sleep(1);
        if ((++sp & 255u) == 0u) { if (xb_ld(&bar[XB_TMO])) break; if (sp > XB_SPIN_CAP) { atomicAdd(&bar[XB_TMO], 1u); break; } }
    }
    nloc = mine > 0u ? mine : 1u; nx = cnt > 0u ? cnt : 1u;
}
__device__ __forceinline__ void xcd_barrier(const XcdBarrier& b) {
    asm volatile("s_waitcnt vmcnt(0)" ::: "memory");
    __syncthreads();
    if (threadIdx.x == 0) {
        unsigned* bar = b.bar;
        __builtin_amdgcn_s_waitcnt(0);
        unsigned nloc = b.st[0], nx = b.st[1];
        if (nloc == 0u) { xcd_barrier_complete(bar, b.x, nloc, nx); b.st[0] = nloc; b.st[1] = nx; }
        const unsigned old = xb_add(&bar[XB_XSUB(b.x)], 1u);
        const unsigned gen = old / nloc;
        if (old + 1u == (gen + 1u) * nloc) {
            __builtin_amdgcn_fence(__ATOMIC_RELEASE, "agent");
            asm volatile("s_waitcnt vmcnt(0)" ::: "memory");
            const unsigned og = xb_add(&bar[XB_TOP], 1u);
            const unsigned tg = og / nx;
            if (og + 1u == (tg + 1u) * nx) xb_add(&bar[XB_TOPGEN], 1u);
            else XB_SPIN(xb_ld(&bar[XB_TOPGEN]) == tg, bar);
            __builtin_amdgcn_fence(__ATOMIC_ACQUIRE, "agent");
            xb_add(&bar[XB_XGEN(b.x)], 1u);
            asm volatile("s_waitcnt vmcnt(0)" ::: "memory");
        } else {
            XB_SPIN(xb_ld(&bar[XB_XGEN(b.x)]) == gen, bar);
            __builtin_amdgcn_fence(__ATOMIC_ACQUIRE, "agent");
            asm volatile("s_waitcnt vmcnt(0)" ::: "memory");
        }
    }
    __syncthreads();
}

#ifndef PHMASK
#define PHMASK 0xFFFFF
#endif
#define PH(n) ((PHMASK >> (n)) & 1)
__global__ void __launch_bounds__(NTHR, 2) fwd_megakernel(Args a) {
    extern __shared__ __attribute__((aligned(16))) unsigned char lds_raw[];
    LAS unsigned char* lds = (LAS unsigned char*)lds_raw;
    volatile LAS unsigned* bar_st = (volatile LAS unsigned*)(lds + LDS_BYTES - 16);
    if (threadIdx.x < 4) bar_st[threadIdx.x] = 0u;
    __syncthreads();
    XcdBarrier gbar = xcd_barrier_post((unsigned*)(a.ws + WS_BAR), bar_st);
    const int G = gridDim.x, tid = threadIdx.x;
    unsigned char* ws = a.ws;
    using namespace pg8;

    if (PH(0)) {
    phase_prep(a, lds, G);
    }
    xcd_barrier(gbar);
    if (PH(1)) {
    phase_norm<1>(a, G);
    }
    xcd_barrier(gbar);
    if (PH(2)) {
    { Gemm g{(const bf16_t*)(ws + WS_XN), (const bf16_t*)(ws + WS_W1A), D, D, D, 0, 0}; GridOrder S{32, 22, 1, G, (int)blockIdx.x, 0}; EpiSwiGLU E{(bf16_t*)(ws + WS_HFF)};
      gemm_phase(lds, g, S, E); }
    tr_in_tail(a, lds, 32 * 22, TR_B0, TR_B1, G);
    }
    xcd_barrier(gbar);
    if (PH(3)) {
    { Gemm g{(const bf16_t*)(ws + WS_HFF), (const bf16_t*)(ws + WS_W1B), DFF, DFF, DFF / 2, (size_t)DFF, (size_t)DFF}; GridOrder S{32, 4, 2, G, (int)blockIdx.x, 0}; EpiPart E{(bf16_t*)(ws + WS_PART)};
      gemm_phase(lds, g, S, E); }
    }
    xcd_barrier(gbar);
    if (PH(4)) {
    phase_norm<2>(a, G);
    }
    xcd_barrier(gbar);
    if (PH(5)) {
    { Gemm g{(const bf16_t*)(ws + WS_XN), (const bf16_t*)(ws + WS_WIN), D, D, D, 0, 0}; GridOrder S{32, 21, 1, G, (int)blockIdx.x, 0};
      EpiIn E{(bf16_t*)(ws + WS_QC), (bf16_t*)(ws + WS_KVC), (bf16_t*)(ws + WS_HQ), (bf16_t*)(ws + WS_HV), (bf16_t*)(ws + WS_HG), (bf16_t*)(ws + WS_GATE), (bf16_t*)(ws + WS_KRP),
              (float*)(ws + WS_FF), (float*)(ws + WS_FB), a.out + OKR, (const float*)(ws + WS_LB)};
      gemm_phase(lds, g, S, E); }
    tr_in_tail(a, lds, 32 * 21, TR_C0, TR_C1, G);
    }
    xcd_barrier(gbar);
    if (PH(6)) {
        const int lane = tid & 63, wave = tid >> 6;
        float* RQ = (float*)(ws + WS_RQ); float* RKV = (float*)(ws + WS_RKV);
        const int nsk = G >= 192 ? 128 : 0;
        for (int rb = ((int)blockIdx.x - nsk) * 8 + wave; rb >= 0 && rb < NTOK / 4; rb += (G - nsk) * 8) {
            const int row0 = rb * 4;
            u32x4 wq[4], wk[4];
#pragma unroll
            for (int i = 0; i < 4; ++i) {
                wq[i] = (u32x4){0u, 0u, 0u, 0u}; wk[i] = (u32x4){0u, 0u, 0u, 0u};
                if (lane < 48) wq[i] = *(const u32x4*)((const bf16_t*)(ws + WS_QC) + (size_t)(row0 + i) * 384 + lane * 8);
                if (lane < 32) wk[i] = *(const u32x4*)((const bf16_t*)(ws + WS_KVC) + (size_t)(row0 + i) * 256 + lane * 8);
            }
            float sq[4], sk[4];
#pragma unroll
            for (int i = 0; i < 4; ++i) {
                { const u32x4 w = wq[i]; const float e0 = bflo(w.x), e1 = bfhi(w.x), e2 = bflo(w.y), e3 = bfhi(w.y), e4 = bflo(w.z), e5 = bfhi(w.z), e6 = bflo(w.w), e7 = bfhi(w.w);
                  sq[i] = (e0 * e0 + e1 * e1) + (e2 * e2 + e3 * e3) + (e4 * e4 + e5 * e5) + (e6 * e6 + e7 * e7); }
                { const u32x4 w = wk[i]; const float e0 = bflo(w.x), e1 = bfhi(w.x), e2 = bflo(w.y), e3 = bfhi(w.y), e4 = bflo(w.z), e5 = bfhi(w.z), e6 = bflo(w.w), e7 = bfhi(w.w);
                  sk[i] = (e0 * e0 + e1 * e1) + (e2 * e2 + e3 * e3) + (e4 * e4 + e5 * e5) + (e6 * e6 + e7 * e7); }
            }
#pragma unroll
            for (int o = 1; o < 64; o <<= 1) {
#pragma unroll
                for (int i = 0; i < 4; ++i) { sq[i] += __shfl_xor(sq[i], o); sk[i] += __shfl_xor(sk[i], o); }
            }
#pragma unroll
            for (int i = 0; i < 4; ++i) {
                const int row = row0 + i;
                const float ri = rsqrtf(sk[i] * (1.f / 256.f) + EPS);
                if (lane == 0) { RQ[row] = rsqrtf(sq[i] * (1.f / 384.f) + EPS); RKV[row] = ri; }
                if (row < NCTX && lane < 32) {
                    const u32x4 w = wk[i];
                    const f32x4 g0 = *(const f32x4*)(a.in[I_KVNG] + lane * 8), g1 = *(const f32x4*)(a.in[I_KVNG] + lane * 8 + 4);
                    f32x4 o0, o1; o0.x = bflo(w.x) * ri * g0.x; o0.y = bfhi(w.x) * ri * g0.y; o0.z = bflo(w.y) * ri * g0.z; o0.w = bfhi(w.y) * ri * g0.w;
                    o1.x = bflo(w.z) * ri * g1.x; o1.y = bfhi(w.z) * ri * g1.y; o1.z = bflo(w.w) * ri * g1.z; o1.w = bfhi(w.w) * ri * g1.w;
                    float* op = a.out + OCKV + (size_t)row * 256 + lane * 8;
                    *(f32x4*)op = o0; *(f32x4*)(op + 4) = o1;
                }
            }
        }
        for (int i = blockIdx.x * NTHR + tid; i < 512; i += G * NTHR) RKV[NTOK + i] = 1.f;
        for (int i = blockIdx.x * NTHR + tid; i < 512 * 256 / 2; i += G * NTHR) { const f32x2 v = *(const f32x2*)(a.in[I_CCKV] + 2 * (size_t)i); ((unsigned*)(ws + WS_KVC) + (size_t)NTOK * 256 / 2)[i] = pk2(v.x, v.y); }
        __syncthreads();
        for (int it = blockIdx.x; it < 128; it += G) hgrn_pass1(a, lds, it);
    }
    xcd_barrier(gbar);
    if (PH(6)) {
        { Gemm g{(const bf16_t*)(ws + WS_QC), (const bf16_t*)(ws + WS_WQB), 384, 384, 384, 0, 0}; GridOrder S{32, 3, 1, G, (int)blockIdx.x, 0}; EpiQ E{(bf16_t*)(ws + WS_Q), (const float*)(ws + WS_RQ)};
          gemm_phase(lds, g, S, E); }
        { Gemm g{(const bf16_t*)(ws + WS_KVC), (const bf16_t*)(ws + WS_WKVB), 256, 256, 256, 0, (size_t)1024 * 256 * 2}; GridOrder S{34, 4, 1, G, (int)((blockIdx.x + G - 96 % G) % G), 32}; EpiKV E{(bf16_t*)(ws + WS_KN), (bf16_t*)(ws + WS_VT), (const float*)(ws + WS_RKV)};
          gemm_phase(lds, g, S, E); }
        __syncthreads();
        for (int it = blockIdx.x; it < 256; it += G) {
            const int dir = it & 1, seg = (it >> 1) & 7, bh = it >> 4;
            const float* s0 = a.in[I_ST] + (size_t)(((bh >> 3) * 2 + dir) * 8 + (bh & 7)) * 4096;
            f32x4 e0 = *(const f32x4*)(s0 + tid * 4), e1 = *(const f32x4*)(s0 + 2048 + tid * 4);
            const int k0 = tid >> 4, k1 = 32 + (tid >> 4);
            const int nsteps = dir == 0 ? seg : 7 - seg;
            for (int st = 0; st < nsteps; ++st) {
                const int sj = dir == 0 ? st : 7 - st;
                const int pit = (bh * 8 + sj) * 2 + dir;
                const float* sl = (const float*)(ws + WS_SLOC) + (size_t)pit * 4096;
                const float* gd = (const float*)(ws + WS_GDEC) + (size_t)pit * 64;
                const f32x4 l0 = *(const f32x4*)(sl + tid * 4), l1 = *(const f32x4*)(sl + 2048 + tid * 4);
                const float g0 = gd[k0], g1 = gd[k1];
                e0 = g0 * e0 + l0; e1 = g1 * e1 + l1;
            }
            float* se = (float*)(ws + WS_SENT) + (size_t)it * 4096;
            *(f32x4*)(se + tid * 4) = e0; *(f32x4*)(se + 2048 + tid * 4) = e1;
        }
    }
    xcd_barrier(gbar);
    if (PH(7)) {
        p7_fused(a, lds, (int)blockIdx.x);
    }
    xcd_barrier(gbar);
    if (PH(7)) {
        phase_hgfin(a, G);
    }
    xcd_barrier(gbar);
    if (PH(8)) {
    { Gemm g{(const bf16_t*)(ws + WS_O), (const bf16_t*)(ws + WS_WUP), 512, 512, 512, (size_t)NTOK * 512 * 2, (size_t)1024 * 512 * 2}; GridOrder S{32, 4, 2, G, (int)blockIdx.x, 0};
      EpiUp E{(bf16_t*)(ws + WS_T), (const bf16_t*)(ws + WS_GATE)};
      gemm_phase(lds, g, S, E); }
    }
    xcd_barrier(gbar);
    if (PH(9)) {
    { Gemm g{(const bf16_t*)(ws + WS_T), (const bf16_t*)(ws + WS_WOUT), D, D, D, (size_t)NTOK * D * 2, 0}; GridOrder S{32, 4, 2, G, (int)blockIdx.x, 0}; EpiPart E{(bf16_t*)(ws + WS_PART)};
      gemm_phase(lds, g, S, E); }
    }
    xcd_barrier(gbar);
    if (PH(10)) {
    phase_norm<3>(a, G);
    }
    xcd_barrier(gbar);
    if (PH(11)) {
    { Gemm g{(const bf16_t*)(ws + WS_XN), (const bf16_t*)(ws + WS_W2A), D, D, D, 0, 0}; GridOrder S{32, 22, 1, G, (int)blockIdx.x, 0}; EpiSwiGLU E{(bf16_t*)(ws + WS_HFF)};
      gemm_phase(lds, g, S, E); }
    }
    xcd_barrier(gbar);
    if (PH(12)) {
    { Gemm g{(const bf16_t*)(ws + WS_HFF), (const bf16_t*)(ws + WS_W2B), DFF, DFF, DFF / 2, (size_t)DFF, (size_t)DFF}; GridOrder S{32, 4, 2, G, (int)blockIdx.x, 0}; EpiPart E{(bf16_t*)(ws + WS_PART)};
      gemm_phase(lds, g, S, E); }
    }
    xcd_barrier(gbar);
    if (PH(13)) {
    phase_norm<4>(a, G);
    }
}

extern "C" void kernel_launch(void* const* d_in, const int* in_sizes, int n_in, void* d_out, int out_size, void* d_ws, size_t ws_size, hipStream_t stream) {
    static int grid = 0;
    if (grid == 0) {
        int dev = 0, cus = 0, per_cu = 0;
        if (n_in != 27 || ws_size < WS_END) { fprintf(stderr, "kernel_launch: unexpected n_in %d / ws_size %zu\n", n_in, ws_size); grid = -1; return; }
        hipGetDevice(&dev);
        hipDeviceGetAttribute(&cus, hipDeviceAttributeMultiprocessorCount, dev);
        if (hipFuncSetAttribute((const void*)fwd_megakernel, hipFuncAttributeMaxDynamicSharedMemorySize, LDS_BYTES) != hipSuccess) { fprintf(stderr, "kernel_launch: hipFuncSetAttribute failed\n"); grid = -1; return; }
        if (hipOccupancyMaxActiveBlocksPerMultiprocessor(&per_cu, (const void*)fwd_megakernel, NTHR, LDS_BYTES) != hipSuccess || per_cu < 1) { fprintf(stderr, "kernel_launch: occupancy query says %d blocks/CU\n", per_cu); grid = -1; return; }
        grid = cus;
    }
    if (grid < 0) return;
    if (hipMemsetAsync((char*)d_ws + WS_BAR, 0, 16384, stream) != hipSuccess) { fprintf(stderr, "kernel_launch: memset of barrier words failed\n"); return; }
    Args a{};
    for (int i = 0; i < 27; ++i) a.in[i] = (const float*)d_in[i];
    a.out = (float*)d_out; a.ws = (unsigned char*)d_ws;
    void* args[] = {&a};
    hipError_t e = hipLaunchCooperativeKernel((const void*)fwd_megakernel, dim3(grid), dim3(NTHR), args, LDS_BYTES, stream);
    if (e != hipSuccess) fprintf(stderr, "cooperative launch failed: %s (grid %d)\n", hipGetErrorString(e), grid);
}
```
